# Optimizing an MI355X kernel written in HIP

```python
import math
import jax, jax.numpy as jnp
from jax import lax
import numpy as np


D_MODEL = 1024
BATCH = 2
SEQ = 8192
DEPTH = 1

CHUNK = 128
A_GROUPS = 8
A_GROUP_DIM = 128
A_WIDTH = A_GROUPS * A_GROUP_DIM
N_HEADS = 8
QK_NOPE = 128
QK_ROPE = 64
QK_DIM = QK_NOPE + QK_ROPE
V_HEAD = 128
Q_LORA = 384
KV_LORA = 256
ROPE_THETA = 10000.0
Q_BLOCK = 128
N_EXPERTS = 256
TOP_K = 8
N_GROUPS = 8
TOPK_GROUPS = 4
D_EXPERT = 256
ROUTED_SCALE = 2.5
MOE_BLOCK = 128
DN_ALPHA = (2 * DEPTH) ** 0.25
DN_BETA = (8 * DEPTH) ** -0.25
LN_EPS = 1e-5
RMS_EPS = 1e-6

IN_WIDTHS = (A_WIDTH, A_WIDTH, Q_LORA, KV_LORA, QK_ROPE, D_MODEL, D_MODEL)
IN_TOTAL = sum(IN_WIDTHS)
SPLIT_POINTS = tuple(int(s) for s in np.cumsum(IN_WIDTHS)[:-1])

kernel_name = 'hybrid_gmlp_mla_moe_deepnorm'


def layer_norm(x, g, b):
    xf = x.astype(jnp.float32)
    mu = xf.mean(-1, keepdims=True)
    var = jnp.square(xf - mu).mean(-1, keepdims=True)
    return ((xf - mu) * lax.rsqrt(var + LN_EPS) * g.astype(jnp.float32) + b.astype(jnp.float32)).astype(x.dtype)


def rms_norm(x, g):
    xf = x.astype(jnp.float32)
    return (xf * lax.rsqrt(jnp.mean(xf * xf, -1, keepdims=True) + RMS_EPS) * g.astype(jnp.float32)).astype(x.dtype)


def rope_tables(positions):
    freq = ROPE_THETA ** (-jnp.arange(0, QK_ROPE // 2, dtype=jnp.float32) * 2.0 / QK_ROPE)
    ang = positions.astype(jnp.float32)[..., None] * freq
    return jnp.cos(ang), jnp.sin(ang)


def apply_rope(x, cos, sin):
    x1, x2 = jnp.split(x.astype(jnp.float32), 2, axis=-1)
    return jnp.concatenate([x1 * cos - x2 * sin, x1 * sin + x2 * cos], axis=-1).astype(x.dtype)


def spatial_gating(u, v, ln_g, ln_b, w_s, b_s):
    B, S, _ = u.shape
    n_chunks = S // CHUNK
    u = jax.nn.gelu(u)
    v = jax.nn.gelu(v).reshape(B, n_chunks, CHUNK, A_GROUPS, A_GROUP_DIM)
    v = layer_norm(v, ln_g.reshape(A_GROUPS, A_GROUP_DIM), ln_b.reshape(A_GROUPS, A_GROUP_DIM))
    mixed = jnp.einsum('hpq,bcqhd->bcphd', w_s, v) + b_s.T[:, :, None]
    return u * mixed.reshape(B, S, A_WIDTH)


def latent_attention(c_q, c_kv, k_r, cos, sin, q_norm_g, w_uq, kv_norm_g, w_uk, w_uv):
    B, S, _ = c_q.shape
    q = jnp.einsum('bsr,rhd->bshd', rms_norm(c_q, q_norm_g), w_uq)
    q_rope = apply_rope(q[..., QK_NOPE:], cos[:, :, None], sin[:, :, None])
    q = jnp.concatenate([q[..., :QK_NOPE], q_rope], axis=-1) * (1.0 / math.sqrt(QK_DIM))
    c_kv = rms_norm(c_kv, kv_norm_g)
    k_nope = jnp.einsum('bsr,rhd->bshd', c_kv, w_uk)
    v = jnp.einsum('bsr,rhd->bshd', c_kv, w_uv)
    k_rope = apply_rope(k_r, cos, sin)
    k = jnp.concatenate([k_nope, jnp.broadcast_to(k_rope[:, :, None, :], (B, S, N_HEADS, QK_ROPE))], axis=-1)
    q_blocks = q.reshape(B, S // Q_BLOCK, Q_BLOCK, N_HEADS, QK_DIM).transpose(1, 0, 2, 3, 4)

    def attend(q_blk):
        s = jnp.einsum('bqhd,bkhd->bhqk', q_blk, k).astype(jnp.float32)
        p = jax.nn.softmax(s, axis=-1).astype(v.dtype)
        return jnp.einsum('bhqk,bkhd->bqhd', p, v)

    o = lax.map(attend, q_blocks)
    return o.transpose(1, 0, 2, 3, 4).reshape(B, S, N_HEADS * V_HEAD)


def route(x_flat, w_router, router_bias):
    T = x_flat.shape[0]
    scores = jax.nn.sigmoid((x_flat @ w_router).astype(jnp.float32))
    biased = scores + router_bias.astype(jnp.float32)
    per_group = N_EXPERTS // N_GROUPS
    group_score = lax.top_k(biased.reshape(T, N_GROUPS, per_group), 2)[0].sum(-1)
    _, top_groups = lax.top_k(group_score, TOPK_GROUPS)
    group_mask = jnp.any(top_groups[..., None] == jnp.arange(N_GROUPS), axis=-2)
    masked = jnp.where(jnp.repeat(group_mask, per_group, axis=-1), biased, -jnp.inf)
    _, idx = lax.top_k(masked, TOP_K)
    w = jnp.take_along_axis(scores, idx, axis=-1)
    w = w / jnp.sum(w, -1, keepdims=True) * ROUTED_SCALE
    return idx, w.astype(x_flat.dtype)


def routed_experts(x_flat, idx, gate_w, w_gate, w_up, w_down):
    T, D = x_flat.shape
    N = T * TOP_K
    e_flat = idx.reshape(N)
    tok_flat = jnp.arange(N, dtype=jnp.int32) // TOP_K
    w_flat = gate_w.reshape(N)
    order = jnp.argsort(e_flat)
    e_sorted = e_flat[order]
    counts = jnp.bincount(e_flat, length=N_EXPERTS)
    starts = jnp.cumsum(counts) - counts
    padded = (counts + MOE_BLOCK - 1) // MOE_BLOCK * MOE_BLOCK
    pad_end = jnp.cumsum(padded)
    pad_start = pad_end - padded
    dest = pad_start[e_sorted] + (jnp.arange(N, dtype=jnp.int32) - starts[e_sorted])
    P = ((N + MOE_BLOCK - 1) // MOE_BLOCK + N_EXPERTS) * MOE_BLOCK
    NB = P // MOE_BLOCK
    buf_tok = jnp.zeros((P,), jnp.int32).at[dest].set(tok_flat[order])
    buf_w = jnp.zeros((P,), x_flat.dtype).at[dest].set(w_flat[order])
    block_e = jnp.minimum(jnp.searchsorted(pad_end, jnp.arange(NB) * MOE_BLOCK, side='right'), N_EXPERTS - 1)

    def expert_block(args):
        e, tok, gw = args
        xb = x_flat[tok]
        h = jax.nn.silu(xb @ w_gate[e]) * (xb @ w_up[e])
        return ((h @ w_down[e]) * gw[:, None]).astype(x_flat.dtype)

    ys = lax.map(expert_block, (block_e, buf_tok.reshape(NB, MOE_BLOCK), buf_w.reshape(NB, MOE_BLOCK)))
    return jnp.zeros_like(x_flat).at[buf_tok].add(ys.reshape(P, D))


def swiglu(x, w_g, w_u, w_d):
    return (jax.nn.silu(x @ w_g) * (x @ w_u)) @ w_d


def setup_inputs(seed: int = 0) -> dict:
    key = jax.random.key(seed)
    ks = jax.random.split(key, 32)
    f32 = jnp.float32
    L = DEPTH

    def nrm(k, shape, scale):
        return jax.random.normal(k, shape, f32) * scale

    x = jax.random.normal(ks[0], (BATCH, SEQ, D_MODEL), f32)
    positions = (jnp.arange(SEQ, dtype=jnp.int32)[None, :] + jax.random.randint(ks[1], (BATCH, 1), 0, SEQ, dtype=jnp.int32)).astype(jnp.int32)
    return {
        'x': x,
        'positions': positions,
        'w_in': nrm(ks[2], (L, D_MODEL, IN_TOTAL), D_MODEL ** -0.5),
        'gmlp_ln_g': 1.0 + nrm(ks[3], (L, A_WIDTH), 0.01),
        'gmlp_ln_b': nrm(ks[4], (L, A_WIDTH), 0.01),
        'w_spatial': nrm(ks[5], (L, A_GROUPS, CHUNK, CHUNK), 0.5 * CHUNK ** -0.5),
        'b_spatial': 1.0 + nrm(ks[6], (L, A_GROUPS, CHUNK), 0.01),
        'w_a_proj': nrm(ks[7], (L, A_WIDTH, D_MODEL), DN_BETA * A_WIDTH ** -0.5),
        'q_norm_g': 1.0 + nrm(ks[8], (L, Q_LORA), 0.01),
        'w_uq': nrm(ks[9], (L, Q_LORA, N_HEADS, QK_DIM), Q_LORA ** -0.5),
        'kv_norm_g': 1.0 + nrm(ks[10], (L, KV_LORA), 0.01),
        'w_uk': nrm(ks[11], (L, KV_LORA, N_HEADS, QK_NOPE), KV_LORA ** -0.5),
        'w_uv': nrm(ks[12], (L, KV_LORA, N_HEADS, V_HEAD), KV_LORA ** -0.5),
        'w_b_proj': nrm(ks[13], (L, N_HEADS * V_HEAD, D_MODEL), DN_BETA * (N_HEADS * V_HEAD) ** -0.5),
        'w_out': nrm(ks[14], (L, D_MODEL, D_MODEL), DN_BETA * D_MODEL ** -0.5),
        'ln1_g': 1.0 + nrm(ks[15], (L, D_MODEL), 0.01),
        'ln1_b': nrm(ks[16], (L, D_MODEL), 0.01),
        'w_router': nrm(ks[17], (L, D_MODEL, N_EXPERTS), D_MODEL ** -0.5),
        'router_bias': nrm(ks[18], (L, N_EXPERTS), 0.01),
        'w_gate': nrm(ks[19], (L, N_EXPERTS, D_MODEL, D_EXPERT), D_MODEL ** -0.5),
        'w_up': nrm(ks[20], (L, N_EXPERTS, D_MODEL, D_EXPERT), D_MODEL ** -0.5),
        'w_down': nrm(ks[21], (L, N_EXPERTS, D_EXPERT, D_MODEL), DN_BETA * D_EXPERT ** -0.5),
        'w_sh_gate': nrm(ks[22], (L, D_MODEL, D_EXPERT), D_MODEL ** -0.5),
        'w_sh_up': nrm(ks[23], (L, D_MODEL, D_EXPERT), D_MODEL ** -0.5),
        'w_sh_down': nrm(ks[24], (L, D_EXPERT, D_MODEL), DN_BETA * D_EXPERT ** -0.5),
        'ln2_g': 1.0 + nrm(ks[25], (L, D_MODEL), 0.01),
        'ln2_b': nrm(ks[26], (L, D_MODEL), 0.01),
    }


def reference(x, positions, w_in, gmlp_ln_g, gmlp_ln_b, w_spatial, b_spatial, w_a_proj, q_norm_g, w_uq, kv_norm_g, w_uk, w_uv, w_b_proj, w_out, ln1_g, ln1_b, w_router, router_bias, w_gate, w_up, w_down, w_sh_gate, w_sh_up, w_sh_down, ln2_g, ln2_b):
    B, S, D = x.shape
    cos, sin = rope_tables(positions)
    h = x
    for l in range(DEPTH):
        proj = h @ w_in[l]
        u, v, c_q, c_kv, k_r, g_a, g_b = jnp.split(proj, SPLIT_POINTS, axis=-1)
        y_a = spatial_gating(u, v, gmlp_ln_g[l], gmlp_ln_b[l], w_spatial[l], b_spatial[l]) @ w_a_proj[l]
        y_b = latent_attention(c_q, c_kv, k_r, cos, sin, q_norm_g[l], w_uq[l], kv_norm_g[l], w_uk[l], w_uv[l]) @ w_b_proj[l]
        mixed = (jax.nn.sigmoid(g_a) * y_a + jax.nn.sigmoid(g_b) * y_b) @ w_out[l]
        h = layer_norm(DN_ALPHA * h + mixed, ln1_g[l], ln1_b[l])
        hf = h.reshape(B * S, D)
        idx, gw = route(hf, w_router[l], router_bias[l])
        moe = routed_experts(hf, idx, gw, w_gate[l], w_up[l], w_down[l]) + swiglu(hf, w_sh_gate[l], w_sh_up[l], w_sh_down[l])
        h = layer_norm(DN_ALPHA * h + moe.reshape(B, S, D), ln2_g[l], ln2_b[l])
    return h
```

```cpp
#include <hip/hip_runtime.h>
#include <hip/hip_bf16.h>
#include <cstdio>
#include <cstdint>

#ifndef MK_N_LAUNCHES
#define MK_N_LAUNCHES 1
#endif

#define LAS __attribute__((address_space(3)))
#define GAS __attribute__((address_space(1)))
typedef unsigned short bf16_t;
typedef short bf16x8 __attribute__((ext_vector_type(8)));
typedef short s16x4 __attribute__((ext_vector_type(4)));
typedef float f32x4 __attribute__((ext_vector_type(4)));
typedef float f32x2 __attribute__((ext_vector_type(2)));
typedef float f32x16 __attribute__((ext_vector_type(16)));
typedef unsigned u32x4 __attribute__((ext_vector_type(4)));
typedef unsigned u32x2 __attribute__((ext_vector_type(2)));

constexpr int T = 16384, DM = 1024, SEQ = 8192, NBATCH = 2;
constexpr int NH = 8, QK_NOPE = 128, QK_ROPE = 64, VH = 128, QLORA = 384, KVLORA = 256;
constexpr int NE = 256, TOPK = 8, DE = 256;
constexpr int IN_TOTAL = 4800, IN_PAD = 4864;
constexpr float DN_ALPHA = 1.189207115002721f;
constexpr float LN_EPS = 1e-5f, RMS_EPS = 1e-6f;
constexpr float LOG2E = 1.4426950408889634f;
constexpr float QSCALE = 0.07216878364870322f * LOG2E;
constexpr int NWAVES = 8;

__device__ __forceinline__ unsigned cvt_pk_bf16(float lo, float hi) { unsigned r; asm volatile("v_cvt_pk_bf16_f32 %0, %1, %2" : "=v"(r) : "v"(lo), "v"(hi)); return r; }
__device__ __forceinline__ float bf_lo(unsigned w) { return __uint_as_float(w << 16); }
__device__ __forceinline__ float bf_hi(unsigned w) { return __uint_as_float(w & 0xffff0000u); }
__device__ __forceinline__ float sigmoid_f(float x) { return __builtin_amdgcn_rcpf(1.0f + __builtin_amdgcn_exp2f(-x * LOG2E)); }
__device__ __forceinline__ float gelu_tanh(float x) { const float u = 1.5957691216057308f * (x + 0.044715f * x * x * x); return x * __builtin_amdgcn_rcpf(1.0f + __builtin_amdgcn_exp2f(-u * LOG2E)); }
#ifndef MOE_FP8
#define MOE_FP8 1
#endif
constexpr float W8MUL = 64.0f;
#ifndef INP_FP8
#define INP_FP8 1
#endif
#ifndef OB_FP8
#define OB_FP8 1
#endif
constexpr float O8MUL = 64.0f;
#ifndef ATT_FP8
#define ATT_FP8 3
#endif
constexpr float Y8MUL = 16.0f;
constexpr float K8MUL = (ATT_FP8 == 3) ? 0.125f : 1.0f;
constexpr float Q8MUL = 8.0f;
__device__ __forceinline__ u32x2 pack8_fp8(const f32x4 v0, const f32x4 v1) { int a = __builtin_amdgcn_cvt_pk_fp8_f32(v0[0], v0[1], 0, false); a = __builtin_amdgcn_cvt_pk_fp8_f32(v0[2], v0[3], a, true);
    int b = __builtin_amdgcn_cvt_pk_fp8_f32(v1[0], v1[1], 0, false); b = __builtin_amdgcn_cvt_pk_fp8_f32(v1[2], v1[3], b, true); u32x2 w; w.x = (unsigned)a; w.y = (unsigned)b; return w; }
__host__ __device__ __forceinline__ int rope_orig(int p) { return 16 * (p >> 5) + 4 * ((p >> 3) & 3) + (p & 3) + 32 * ((p >> 2) & 1); }

namespace pg8 {
typedef int v8i_t __attribute__((ext_vector_type(8)));
typedef int i4_t __attribute__((ext_vector_type(4)));
constexpr int BM = 256, BK = 64, HALF = 128, HTB = HALF * BK * 2, STAGE_BYTES = 8 * HTB, NXCD = 8, WGM = 2;
__host__ __device__ __forceinline__ int lds_byte(int r, int c) { const int st = (r >> 4) * 2 + (c >> 5), rr = r & 15, cc = c & 31, ob = rr * 64 + cc * 2; return st * 1024 + (ob ^ (((ob >> 9) & 1) << 5)); }
__host__ __device__ __forceinline__ void stage_rc(int b, int& R, int& C) { const int st = b / 1024, sb = b % 1024, swz = sb ^ (((sb >> 9) & 1) << 5); R = (st >> 1) * 16 + swz / 64; C = (st & 1) * 32 + (swz % 64) / 2; }
__host__ __device__ __forceinline__ int perm32(int rho) { const int n = rho >> 4, i = rho & 15; return 8 * (i >> 2) + 4 * n + (i & 3); }

struct Unit { const char* a; const char* b; int pm, pn, e, cnt, r0; };

__device__ __forceinline__ int xcd_remap(int wgid, int nwg) { const int q = nwg / NXCD, r = nwg % NXCD, xcd = wgid % NXCD, off = wgid / NXCD; return (xcd < r ? xcd * (q + 1) : r * (q + 1) + (xcd - r) * q) + off; }

struct DenseSched {
    static constexpr bool GATHER = false;
    const char* A; const char* Bt; size_t atile, btile; int nM, nN, nwg, G, c, rep;
    __device__ __forceinline__ void init(const void* A_, int lda, const void* B_, int ldb, int M, int N, int G_, int c_, int rep_ = 1) {
        A = (const char*)A_; Bt = (const char*)B_; atile = (size_t)BM * lda * 2; btile = (size_t)BM * ldb * 2; nM = M / BM; nN = N / BM; nwg = nM * nN; G = G_; c = c_; rep = rep_; }
    __device__ __forceinline__ bool next(int i, Unit& u) const {
        long L = (long)i * G + c; if (L >= (long)nwg * rep) return false; if (L >= nwg) L -= nwg;
        const int wgid = xcd_remap((int)L, nwg);
        const int nig = WGM * nN, gid = wgid / nig, fm = gid * WGM, gsz = (nM - fm) < WGM ? (nM - fm) : WGM;
        u.pm = fm + ((wgid % nig) % gsz); u.pn = (wgid % nig) / gsz; u.e = 0; u.cnt = BM; u.r0 = 0;
        u.a = A + (size_t)u.pm * atile; u.b = Bt + (size_t)u.pn * btile; return true; }
    __device__ __forceinline__ void aoffs(const Unit&, const int (&)[2], const int (&)[2], int, unsigned (&)[2][2]) const {}
};

template <class Epi, class Sched, bool ALIGN_EPI, bool F8 = false>
__device__ __forceinline__ void gemm_phase(LAS unsigned char* lds, const int K, const int lda, const int ldb, const Sched& S, const Epi& E) {
    const int tid = threadIdx.x, wid = __builtin_amdgcn_readfirstlane(tid >> 6), lane = tid & 63, wr = wid >> 2, wc = wid & 3, fr = lane & 15, fq = lane >> 4;
    const int nt = K / BK;
    constexpr bool GA_ = Sched::GATHER;
    int Rr[2], Cc[2]; unsigned voffA[2][2], nvoffA[2][2], voffB[2];
#pragma unroll
    for (int i = 0; i < 2; ++i) { int R, C; stage_rc(tid * 16 + i * 8192, R, C); Rr[i] = R; Cc[i] = C; const int Rb = Epi::PERM ? ((R & ~31) + perm32(R & 31)) : R;
        voffB[i] = (unsigned)(Rb * ldb + C) * 2u;
#pragma unroll
        for (int h = 0; h < 2; ++h) { voffA[h][i] = (unsigned)(((GA_ ? h * HALF : 0) + R) * lda + C) * 2u; nvoffA[h][i] = voffA[h][i]; } }
    const size_t kstep = (size_t)(BK * 2);
    const size_t hsA = GA_ ? (size_t)0 : (size_t)HALF * lda * 2, hsB = (size_t)HALF * ldb * 2;
    const unsigned ldsw = (unsigned)wid * 1024u;
    const int aoff = lds_byte(wr * 64 + fr, fq * 8), boff = lds_byte(wc * 32 + fr, fq * 8);
#define PG8_SA(b, h) (((b) * 2 + (h)) * HTB)
#define PG8_SB(b, h) ((4 + (b) * 2 + (h)) * HTB)
    const unsigned ldsb_ = (unsigned)__builtin_amdgcn_readfirstlane((int)((unsigned)(uintptr_t)lds + ldsw));
#define PG8_STAGE(bufoff, gbase, voff) do { _Pragma("unroll") for (int _i = 0; _i < 2; ++_i) { unsigned keep_; \
        asm volatile("s_mov_b32 %0, m0\n\ts_mov_b32 m0, %3\n\ts_nop 4\n\tglobal_load_lds_dwordx4 %1, %2\n\ts_mov_b32 m0, %0" : "=&s"(keep_) : "v"((voff)[_i]), "s"((const char*)(gbase)), "s"(ldsb_ + (unsigned)((bufoff) + _i * 8192)) : "memory"); } } while (0)
#define PG8_LDA(dst, b, h) do { if constexpr (F8) { _Pragma("unroll") for (int m = 0; m < 4; ++m) dst##8[m] = __builtin_shufflevector(*(const LAS i4_t*)(lds + PG8_SA(b, h) + aoff + m * 2048), *(const LAS i4_t*)(lds + PG8_SA(b, h) + aoff + m * 2048 + 1024), 0, 1, 2, 3, 4, 5, 6, 7); } \
        else { _Pragma("unroll") for (int m = 0; m < 4; ++m) _Pragma("unroll") for (int k = 0; k < 2; ++k) dst[m][k] = *(const LAS bf16x8*)(lds + PG8_SA(b, h) + aoff + m * 2048 + k * 1024); } } while (0)
#define PG8_LDB(dst, b, h) do { if constexpr (F8) { _Pragma("unroll") for (int n = 0; n < 2; ++n) dst##8[n] = __builtin_shufflevector(*(const LAS i4_t*)(lds + PG8_SB(b, h) + boff + n * 2048), *(const LAS i4_t*)(lds + PG8_SB(b, h) + boff + n * 2048 + 1024), 0, 1, 2, 3, 4, 5, 6, 7); } \
        else { _Pragma("unroll") for (int n = 0; n < 2; ++n) _Pragma("unroll") for (int k = 0; k < 2; ++k) dst[n][k] = *(const LAS bf16x8*)(lds + PG8_SB(b, h) + boff + n * 2048 + k * 1024); } } while (0)
#define PG8_MMA(ai, bj, At, Bt) do { __builtin_amdgcn_s_setprio(1); if constexpr (F8) { _Pragma("unroll") for (int m = 0; m < 4; ++m) _Pragma("unroll") for (int n = 0; n < 2; ++n) \
            asm volatile("v_mfma_f32_16x16x128_f8f6f4 %0, %1, %2, %0" : "+v"(acc[ai][bj][m][n]) : "v"(Bt##8[n]), "v"(At##8[m])); } \
        else { _Pragma("unroll") for (int m = 0; m < 4; ++m) _Pragma("unroll") for (int n = 0; n < 2; ++n) _Pragma("unroll") for (int k = 0; k < 2; ++k) \
        acc[ai][bj][m][n] = __builtin_amdgcn_mfma_f32_16x16x32_bf16(Bt[n][k], At[m][k], acc[ai][bj][m][n], 0, 0, 0); } __builtin_amdgcn_s_setprio(0); } while (0)
#define PG8_WAIT_V(n) asm volatile("s_waitcnt vmcnt(" #n ")" ::: "memory")
#define PG8_WAIT_L(n) asm volatile("s_waitcnt lgkmcnt(" #n ")" ::: "memory")
#define PG8_BAR __builtin_amdgcn_s_barrier()
#define PG8_SCHED __builtin_amdgcn_sched_barrier(0)
    Unit cur, nxt; int ui = 0;
    if (!S.next(0, cur)) return;
    if constexpr (Sched::GATHER) S.aoffs(cur, Rr, Cc, lda, voffA);
    f32x4 acc[2][2][4][2];
    bf16x8 At[4][2], B0[2][2], B1[2][2]; v8i_t At8[4], B08[2], B18[2];
    const char* cA = cur.a; const char* cB = cur.b;
    PG8_STAGE(PG8_SB(0, 0), cB, voffB); PG8_STAGE(PG8_SB(0, 1), cB + hsB, voffB); PG8_STAGE(PG8_SA(0, 0), cA, voffA[0]); PG8_STAGE(PG8_SA(0, 1), cA + hsA, voffA[1]);
    if (wr == 1) PG8_BAR;
    PG8_WAIT_V(2); PG8_BAR;
    PG8_STAGE(PG8_SB(1, 0), cB + kstep, voffB); PG8_STAGE(PG8_SA(1, 0), cA + kstep, voffA[0]); PG8_STAGE(PG8_SB(1, 1), cB + hsB + kstep, voffB);
    PG8_WAIT_V(6); PG8_BAR;
    for (;;) {
        const bool has_next = S.next(ui + 1, nxt);
        if constexpr (Sched::GATHER) { if (has_next) S.aoffs(nxt, Rr, Cc, lda, nvoffA); else {
#pragma unroll
            for (int h = 0; h < 2; ++h)
#pragma unroll
                for (int i = 0; i < 2; ++i) nvoffA[h][i] = voffA[h][i]; } }
        const char* nA = has_next ? nxt.a : cA; const char* nB = has_next ? nxt.b : cB;
#pragma unroll
        for (int a = 0; a < 2; ++a)
#pragma unroll
            for (int b = 0; b < 2; ++b)
#pragma unroll
                for (int m = 0; m < 4; ++m)
#pragma unroll
                    for (int n = 0; n < 2; ++n) acc[a][b][m][n] = (f32x4){0.f, 0.f, 0.f, 0.f};
#pragma unroll 1
        for (int t = 0; t < nt; t += 2) {
            const bool last = (t == nt - 2);
            const char* a1 = cA + (size_t)(t + 1) * kstep;
            const char* a2 = last ? nA : cA + (size_t)(t + 2) * kstep; const char* b2 = last ? nB : cB + (size_t)(t + 2) * kstep;
            const char* a3 = a2 + kstep; const char* b3 = b2 + kstep;
            unsigned vA2[2][2];
#pragma unroll
            for (int h = 0; h < 2; ++h)
#pragma unroll
                for (int i = 0; i < 2; ++i) vA2[h][i] = (Sched::GATHER && last) ? nvoffA[h][i] : voffA[h][i];
            PG8_LDB(B0, 0, 0); PG8_LDB(B1, 0, 1); PG8_SCHED; PG8_LDA(At, 0, 0); PG8_STAGE(PG8_SA(1, 1), a1 + hsA, voffA[1]);
            PG8_WAIT_V(8); PG8_WAIT_L(0); PG8_BAR; PG8_MMA(0, 0, At, B0); PG8_MMA(0, 1, At, B1); PG8_BAR; PG8_SCHED;
            PG8_LDA(At, 0, 1); PG8_STAGE(PG8_SB(0, 0), b2, voffB); PG8_STAGE(PG8_SB(0, 1), b2 + hsB, voffB); PG8_STAGE(PG8_SA(0, 0), a2, vA2[0]);
            PG8_WAIT_V(8); PG8_WAIT_L(0); PG8_BAR; PG8_MMA(1, 0, At, B0); PG8_MMA(1, 1, At, B1); PG8_BAR; PG8_SCHED;
            PG8_LDB(B0, 1, 0); PG8_LDB(B1, 1, 1); PG8_SCHED; PG8_LDA(At, 1, 0); PG8_STAGE(PG8_SA(0, 1), a2 + hsA, vA2[1]);
            PG8_WAIT_V(8); PG8_WAIT_L(0); PG8_BAR; PG8_MMA(0, 0, At, B0); PG8_MMA(0, 1, At, B1); PG8_BAR; PG8_SCHED;
            PG8_LDA(At, 1, 1); PG8_STAGE(PG8_SB(1, 0), b3, voffB); PG8_STAGE(PG8_SB(1, 1), b3 + hsB, voffB); PG8_STAGE(PG8_SA(1, 0), a3, vA2[0]);
            PG8_WAIT_V(8); PG8_WAIT_L(0); PG8_BAR; PG8_MMA(1, 0, At, B0); PG8_MMA(1, 1, At, B1); PG8_BAR; PG8_SCHED;
        }
        if constexpr (ALIGN_EPI) { if (wr == 0) PG8_BAR; }
        if constexpr (F8) asm volatile("s_nop 15\n\ts_nop 15" ::: "memory");
        E(acc, cur, wr, wc, fr, fq);
        if (!has_next) break;
        cur = nxt; cA = nA; cB = nB; ++ui;
        if constexpr (Sched::GATHER) {
#pragma unroll
            for (int h = 0; h < 2; ++h)
#pragma unroll
                for (int i = 0; i < 2; ++i) voffA[h][i] = nvoffA[h][i]; }
        if constexpr (ALIGN_EPI) { if (wr == 1) PG8_BAR; }
    }
    PG8_WAIT_V(0);
    if constexpr (!ALIGN_EPI) { if (wr == 0) PG8_BAR; }
    PG8_BAR;
#undef PG8_SA
#undef PG8_SB
#undef PG8_STAGE
#undef PG8_LDA
#undef PG8_LDB
#undef PG8_MMA
#undef PG8_WAIT_V
#undef PG8_WAIT_L
#undef PG8_BAR
#undef PG8_SCHED
}

typedef f32x4 AccT[2][2][4][2];
__device__ __forceinline__ u32x4 pack8(const f32x4 v0, const f32x4 v1) { u32x4 w; w.x = cvt_pk_bf16(v0[0], v0[1]); w.y = cvt_pk_bf16(v0[2], v0[3]); w.z = cvt_pk_bf16(v1[0], v1[1]); w.w = cvt_pk_bf16(v1[2], v1[3]); return w; }

struct EpiInProj {
    static constexpr bool PERM = true;
    bf16_t *U, *Vg, *C3, *KR, *GA, *GB; float* RS; const float* COS; const float* SIN; int pmode; float ascale;
    __device__ __forceinline__ void operator()(const AccT& acc, const Unit& u, int wr, int wc, int fr, int fq) const {
        const int row0 = u.pm * BM + wr * 64 + fr, pn = pmode == 0 ? u.pn : pmode == 1 ? (u.pn < 8 ? u.pn : u.pn + 3) : (u.pn < 3 ? u.pn + 8 : u.pn + 12), cw = wc * 32 + 8 * fq;
        if (pn < 8 || pn >= 11) {
            bf16_t* base; int ct; bool gel;
            if (pn < 4) { base = U; ct = pn; gel = true; } else if (pn < 8) { base = Vg; ct = pn - 4; gel = true; } else if (pn < 15) { base = GA; ct = pn - 11; gel = false; } else { base = GB; ct = pn - 15; gel = false; }
#pragma unroll
            for (int ai = 0; ai < 2; ++ai)
#pragma unroll
                for (int m = 0; m < 4; ++m) { bf16_t* rowp = base + (size_t)(row0 + ai * HALF + m * 16) * DM + ct * BM + cw;
#pragma unroll
                    for (int bj = 0; bj < 2; ++bj) { f32x4 v0 = acc[ai][bj][m][0] * ascale, v1 = acc[ai][bj][m][1] * ascale;
#pragma unroll
                        for (int i = 0; i < 4; ++i) { v0[i] = gel ? gelu_tanh(v0[i]) : sigmoid_f(v0[i]); v1[i] = gel ? gelu_tanh(v1[i]) : sigmoid_f(v1[i]); }
                        *(u32x4*)(rowp + bj * HALF) = pack8(v0, v1); } }
        } else {
            const int ct = pn - 8;
#pragma unroll
            for (int ai = 0; ai < 2; ++ai)
#pragma unroll
                for (int m = 0; m < 4; ++m) { const int row = row0 + ai * HALF + m * 16;
#pragma unroll
                    for (int bj = 0; bj < 2; ++bj) { const f32x4 v0 = acc[ai][bj][m][0] * ascale, v1 = acc[ai][bj][m][1] * ascale;
                        if (ct == 2 && bj == 1) {
                            if (wc < 2) { const int j0 = 16 * wc + 4 * fq; const f32x4 cs = *(const f32x4*)(COS + (size_t)row * 32 + j0), sn = *(const f32x4*)(SIN + (size_t)row * 32 + j0);
                                const f32x4 o0 = v0 * cs - v1 * sn, o1 = v0 * sn + v1 * cs;
                                if (ATT_FP8) *(u32x2*)((unsigned char*)KR + (size_t)row * 64 + cw) = pack8_fp8(o0 * K8MUL, o1 * K8MUL); else *(u32x4*)(KR + (size_t)row * 64 + cw) = pack8(o0, o1); }
                        } else {
                            *(u32x4*)(C3 + (size_t)row * 768 + ct * BM + bj * HALF + cw) = pack8(v0, v1);
                            float s = (v0[0] * v0[0] + v0[1] * v0[1]) + (v0[2] * v0[2] + v0[3] * v0[3]) + (v1[0] * v1[0] + v1[1] * v1[1]) + (v1[2] * v1[2] + v1[3] * v1[3]);
                            s += __shfl_xor(s, 16); s += __shfl_xor(s, 32);
                            if (fq == 0) RS[(size_t)row * 24 + ct * 8 + bj * 4 + wc] = s; } }
                    asm volatile("" ::: "memory"); }
        }
    }
};
struct EpiQ {
    static constexpr bool PERM = true;
    bf16_t *Qn, *Qr; const float* RS; const float* COS; const float* SIN;
    __device__ __forceinline__ void operator()(const AccT& acc, const Unit& u, int wr, int wc, int fr, int fq) const {
        const unsigned row0 = u.pm * BM + wr * 64 + fr, pn = u.pn, cw = wc * 32 + 8 * fq;
#pragma unroll
        for (int ai = 0; ai < 2; ++ai) {
            float scv[4];
#pragma unroll
            for (int m = 0; m < 4; ++m) { const float* rs = RS + (row0 + ai * HALF + m * 16) * 24u;
                const f32x4 r0 = *(const f32x4*)(rs), r1 = *(const f32x4*)(rs + 4), r2 = *(const f32x4*)(rs + 8);
                const float ss = ((r0[0] + r0[1]) + (r0[2] + r0[3])) + ((r1[0] + r1[1]) + (r1[2] + r1[3])) + ((r2[0] + r2[1]) + (r2[2] + r2[3]));
                scv[m] = (ATT_FP8 ? QSCALE * Q8MUL : QSCALE) * __builtin_amdgcn_rsqf(ss * (1.0f / QLORA) + RMS_EPS); }
            f32x4 csv[4], snv[4];
            if (pn >= 4) {
#pragma unroll
                for (int m = 0; m < 4; ++m) { const unsigned j0 = (row0 + ai * HALF + m * 16) * 32u + 16 * (wc & 1) + 4 * fq; csv[m] = *(const f32x4*)(COS + j0); snv[m] = *(const f32x4*)(SIN + j0); } }
#pragma unroll
            for (int m = 0; m < 4; ++m) { const unsigned row = row0 + ai * HALF + m * 16; const float sc = scv[m];
                if (pn < 4) { const unsigned eo = row * 1024u + pn * BM + cw;
#pragma unroll
                    for (int bj = 0; bj < 2; ++bj) { if (ATT_FP8) *(u32x2*)((unsigned char*)Qn + eo + bj * HALF) = pack8_fp8(acc[ai][bj][m][0] * sc, acc[ai][bj][m][1] * sc); else *(u32x4*)(Qn + eo + bj * HALF) = pack8(acc[ai][bj][m][0] * sc, acc[ai][bj][m][1] * sc); }
                } else { const f32x4 cs = csv[m] * sc, sn = snv[m] * sc;
                    const unsigned eo = row * 512u + (pn - 4) * BM + cw;
#pragma unroll
                    for (int bj = 0; bj < 2; ++bj) { const f32x4 v0 = acc[ai][bj][m][0], v1 = acc[ai][bj][m][1];
                        if (ATT_FP8) *(u32x2*)((unsigned char*)Qr + eo + bj * HALF) = pack8_fp8(v0 * cs - v1 * sn, v0 * sn + v1 * cs); else *(u32x4*)(Qr + eo + bj * HALF) = pack8(v0 * cs - v1 * sn, v0 * sn + v1 * cs); } }
            }
            asm volatile("" ::: "memory");
        }
    }
};
struct EpiKV {
    static constexpr bool PERM = true;
    bf16_t *Kn, *Vv; const float* RS;
    __device__ __forceinline__ void operator()(const AccT& acc, const Unit& u, int wr, int wc, int fr, int fq) const {
        const unsigned row0 = u.pm * BM + wr * 64 + fr, pn = u.pn, cw = wc * 32 + 8 * fq;
        bf16_t* base = pn < 4 ? Kn : Vv; const unsigned ct = pn & 3;
        float scv[8];
#pragma unroll
        for (int q = 0; q < 8; ++q) { const float* rs = RS + (row0 + (q >> 2) * HALF + (q & 3) * 16) * 24u;
            const f32x4 r0 = *(const f32x4*)(rs + 12), r1 = *(const f32x4*)(rs + 16);
            scv[q] = __builtin_amdgcn_rsqf((((r0[0] + r0[1]) + (r0[2] + r0[3])) + ((r1[0] + r1[1]) + (r1[2] + r1[3]))) * (1.0f / KVLORA) + RMS_EPS); }
        asm volatile("" ::: "memory");
#pragma unroll
        for (int ai = 0; ai < 2; ++ai)
#pragma unroll
            for (int m = 0; m < 4; ++m) { const unsigned row = row0 + ai * HALF + m * 16; const float sc = scv[ai * 4 + m] * ((ATT_FP8 && pn < 4) ? K8MUL : 1.0f);
                const unsigned eo = row * 1024u + ct * BM + cw;
#pragma unroll
                for (int bj = 0; bj < 2; ++bj) { if (ATT_FP8 && pn < 4) *(u32x2*)((unsigned char*)Kn + eo + bj * HALF) = pack8_fp8(acc[ai][bj][m][0] * sc, acc[ai][bj][m][1] * sc); else *(u32x4*)(base + eo + bj * HALF) = pack8(acc[ai][bj][m][0] * sc, acc[ai][bj][m][1] * sc); }
                if (m & 1) asm volatile("" ::: "memory");
            }
    }
};
struct EpiVT {
    static constexpr bool PERM = true;
    unsigned char* VT; const float* RS;
    __device__ __forceinline__ void operator()(const AccT& acc, const Unit& u, int wr, int wc, int fr, int fq) const {
        const unsigned hd0 = u.pm * BM + wr * 64 + fr;
#pragma unroll
        for (int bj = 0; bj < 2; ++bj) { const unsigned tb = u.pn * BM + bj * HALF + wc * 32 + 8 * fq;
            float rs[8];
#pragma unroll
            for (int i = 0; i < 8; ++i) { const float* p = RS + (tb + i) * 24u + 12; const f32x4 r0 = *(const f32x4*)p, r1 = *(const f32x4*)(p + 4);
                rs[i] = __builtin_amdgcn_rsqf((((r0[0] + r0[1]) + (r0[2] + r0[3])) + ((r1[0] + r1[1]) + (r1[2] + r1[3]))) * (1.0f / KVLORA) + RMS_EPS); }
            const unsigned b = tb >> 13, s0 = tb & 8191u, k0 = s0 & 63u;
            const unsigned cbase = (s0 & ~63u) + 16u * (k0 >> 5) + 4u * ((k0 >> 3) & 3u);
#pragma unroll
            for (int ai = 0; ai < 2; ++ai)
#pragma unroll
                for (int m = 0; m < 4; ++m) { const unsigned hd = hd0 + ai * HALF + m * 16; unsigned char* dst = VT + ((size_t)(b * 1024u + hd) * 8192u + cbase);
                    const f32x4 v0 = acc[ai][bj][m][0], v1 = acc[ai][bj][m][1];
                    int a = __builtin_amdgcn_cvt_pk_fp8_f32(v0[0] * rs[0], v0[1] * rs[1], 0, false); a = __builtin_amdgcn_cvt_pk_fp8_f32(v0[2] * rs[2], v0[3] * rs[3], a, true);
                    int c = __builtin_amdgcn_cvt_pk_fp8_f32(v1[0] * rs[4], v1[1] * rs[5], 0, false); c = __builtin_amdgcn_cvt_pk_fp8_f32(v1[2] * rs[6], v1[3] * rs[7], c, true);
                    *(unsigned*)dst = (unsigned)a; *(unsigned*)(dst + 32) = (unsigned)c; }
            asm volatile("" ::: "memory"); }
    }
};
template <bool ADD> struct EpiGate {
    static constexpr bool PERM = true;
    bf16_t* O; const bf16_t* G; const bf16_t* Y; float ascale;
    __device__ __forceinline__ void operator()(const AccT& acc, const Unit& u, int wr, int wc, int fr, int fq) const {
        const unsigned row0 = u.pm * BM + wr * 64 + fr, cw = u.pn * BM + wc * 32 + 8 * fq;
#pragma unroll
        for (int ai = 0; ai < 2; ++ai) {
            u32x4 gv[4][2], yv[4][2];
#pragma unroll
            for (int m = 0; m < 4; ++m)
#pragma unroll
                for (int bj = 0; bj < 2; ++bj) { const unsigned ro = (row0 + ai * HALF + m * 16) * DM + cw + bj * HALF; gv[m][bj] = *(const u32x4*)(G + ro); if (ADD) yv[m][bj] = *(const u32x4*)(Y + ro); }
#pragma unroll
            for (int m = 0; m < 4; ++m)
#pragma unroll
                for (int bj = 0; bj < 2; ++bj) { const unsigned ro = (row0 + ai * HALF + m * 16) * DM + cw + bj * HALF; const u32x4 g = gv[m][bj]; f32x4 v0 = acc[ai][bj][m][0] * ascale, v1 = acc[ai][bj][m][1] * ascale;
                    v0[0] *= bf_lo(g.x); v0[1] *= bf_hi(g.x); v0[2] *= bf_lo(g.y); v0[3] *= bf_hi(g.y); v1[0] *= bf_lo(g.z); v1[1] *= bf_hi(g.z); v1[2] *= bf_lo(g.w); v1[3] *= bf_hi(g.w);
                    if (ADD) { const u32x4 y = yv[m][bj];
                        v0[0] += bf_lo(y.x); v0[1] += bf_hi(y.x); v0[2] += bf_lo(y.y); v0[3] += bf_hi(y.y); v1[0] += bf_lo(y.z); v1[1] += bf_hi(y.z); v1[2] += bf_lo(y.w); v1[3] += bf_hi(y.w); }
                    *(u32x4*)(O + ro) = pack8(v0, v1); }
            asm volatile("" ::: "memory");
        }
    }
};
struct EpiPre {
    static constexpr bool PERM = false;
    float* P; const float* X;
    __device__ __forceinline__ void operator()(const AccT& acc, const Unit& u, int wr, int wc, int fr, int fq) const {
        const int row0 = u.pm * BM + wr * 64 + fr, col0 = u.pn * BM + wc * 32 + 4 * fq;
#pragma unroll
        for (int ai = 0; ai < 2; ++ai)
#pragma unroll
            for (int m = 0; m < 4; ++m) { const size_t ro = (size_t)(row0 + ai * HALF + m * 16) * DM + col0;
#pragma unroll
                for (int bj = 0; bj < 2; ++bj)
#pragma unroll
                    for (int n = 0; n < 2; ++n) { const f32x4 xv = *(const f32x4*)(X + ro + bj * HALF + n * 16); *(f32x4*)(P + ro + bj * HALF + n * 16) = xv * DN_ALPHA + acc[ai][bj][m][n]; }
                if (m & 1) asm volatile("" ::: "memory"); }
    }
};
struct EpiF32 {
    static constexpr bool PERM = false;
    float* C; int ldc;
    __device__ __forceinline__ void operator()(const AccT& acc, const Unit& u, int wr, int wc, int fr, int fq) const {
        const int row0 = u.pm * BM + wr * 64 + fr, col0 = u.pn * BM + wc * 32 + 4 * fq;
#pragma unroll
        for (int ai = 0; ai < 2; ++ai)
#pragma unroll
            for (int m = 0; m < 4; ++m) { float* rowp = C + (size_t)(row0 + ai * HALF + m * 16) * ldc + col0;
#pragma unroll
                for (int bj = 0; bj < 2; ++bj)
#pragma unroll
                    for (int n = 0; n < 2; ++n) *(f32x4*)(rowp + bj * HALF + n * 16) = acc[ai][bj][m][n]; }
    }
};
template <bool GATH> struct MoeSched {
    static constexpr bool GATHER = GATH;
    const char* A; const char* Bt; size_t atile, bexp, btile; int npn, ntm, nwg, G, c, rep;
    const LAS int* tile2e; const LAS int* tbase; const LAS int* cntL; const int* list;
    __device__ __forceinline__ bool next(int i, Unit& u) const {
        long L = (long)i * G + c; if (L >= (long)nwg * rep) return false; if (L >= nwg) L -= nwg;
        const int wgid = xcd_remap((int)L, nwg);
        const int tile = wgid / npn, pn = wgid - tile * npn;
        int e, r0, cnt;
        if (tile < ntm) { e = __builtin_amdgcn_readfirstlane(tile2e[tile]); r0 = (tile - __builtin_amdgcn_readfirstlane(tbase[e])) * BM; cnt = __builtin_amdgcn_readfirstlane(cntL[e]) - r0; cnt = cnt > BM ? BM : cnt; u.a = GATH ? A : A + (size_t)tile * atile; }
        else { e = NE; r0 = 0; cnt = BM; u.a = A + (size_t)(GATH ? (tile - ntm) : tile) * atile; }
        u.b = Bt + (size_t)e * bexp + (size_t)pn * btile; u.pm = tile; u.pn = pn; u.e = e; u.cnt = cnt; u.r0 = r0; return true; }
    __device__ __forceinline__ void aoffs(const Unit& u, const int (&R)[2], const int (&C)[2], int lda, unsigned (&off)[2][2]) const {
#pragma unroll
        for (int h = 0; h < 2; ++h)
#pragma unroll
            for (int i = 0; i < 2; ++i) { const int row = h * HALF + R[i];
                if (u.e == NE) off[h][i] = (unsigned)(row * lda + C[i]) * 2u;
                else { const int rr = row < u.cnt ? row : 0; const int pair = list[(size_t)u.e * T + u.r0 + rr]; off[h][i] = (unsigned)((pair >> 3) * lda + C[i]) * 2u; } }
    }
};
struct EpiGU {
    static constexpr bool PERM = true;
    bf16_t* ACT;
    __device__ __forceinline__ void operator()(const AccT& acc, const Unit& u, int wr, int wc, int fr, int fq) const {
        const int row0 = u.pm * BM + wr * 64 + fr, cw = u.pn * HALF + wc * 32 + 8 * fq;
#pragma unroll
        for (int ai = 0; ai < 2; ++ai)
#pragma unroll
            for (int m = 0; m < 4; ++m) { f32x4 g0 = acc[ai][0][m][0], g1 = acc[ai][0][m][1]; const f32x4 u0 = acc[ai][1][m][0], u1 = acc[ai][1][m][1];
#pragma unroll
                for (int i = 0; i < 4; ++i) { const float ws_ = MOE_FP8 ? 1.0f / W8MUL : 1.0f; const float ga = g0[i] * ws_, gb = g1[i] * ws_; g0[i] = ga * sigmoid_f(ga) * (u0[i] * ws_); g1[i] = gb * sigmoid_f(gb) * (u1[i] * ws_); }
                if (MOE_FP8) *(u32x2*)((unsigned char*)ACT + (size_t)(row0 + ai * HALF + m * 16) * DE + cw) = pack8_fp8(g0, g1); else *(u32x4*)(ACT + (size_t)(row0 + ai * HALF + m * 16) * DE + cw) = pack8(g0, g1); }
    }
};
struct EpiDown {
    static constexpr bool PERM = true;
    unsigned char *YP, *YS; const int* list; const float* TOPW; int ntm;
    __device__ __forceinline__ void operator()(const AccT& acc, const Unit& u, int wr, int wc, int fr, int fq) const {
        const unsigned cw = u.pn * BM + wc * 32 + 8 * fq;
        const bool shared = (u.e == NE);
        unsigned char* base = shared ? YS + (size_t)(u.pm - ntm) * BM * DM : YP;
        const int* lst = list + (shared ? 0u : (unsigned)u.e * (unsigned)T + (unsigned)u.r0);
        unsigned drow[8]; float wv[8];
#pragma unroll
        for (int q = 0; q < 8; ++q) { const unsigned r = (q >> 2) * HALF + wr * 64 + (q & 3) * 16 + fr; drow[q] = r; if (!shared) drow[q] = (unsigned)lst[(int)r < u.cnt ? r : 0u]; }
        const float* lw = TOPW + (shared ? 0u : (unsigned)u.e * (unsigned)T + (unsigned)u.r0);
#pragma unroll
        for (int q = 0; q < 8; ++q) { const unsigned r = (q >> 2) * HALF + wr * 64 + (q & 3) * 16 + fr; wv[q] = (shared ? 1.0f : lw[(int)r < u.cnt ? r : 0u]) * (MOE_FP8 ? Y8MUL / W8MUL : Y8MUL); }
#pragma unroll
        for (int ai = 0; ai < 2; ++ai)
#pragma unroll
            for (int m = 0; m < 4; ++m) { const unsigned r = ai * HALF + wr * 64 + m * 16 + fr; const float w = wv[ai * 4 + m];
                if (shared || (int)r < u.cnt) { unsigned char* dst = base + (drow[ai * 4 + m] * 1024u + cw);
#pragma unroll
                    for (int bj = 0; bj < 2; ++bj) *(u32x2*)(dst + bj * HALF) = pack8_fp8(acc[ai][bj][m][0] * w, acc[ai][bj][m][1] * w); }
                if (m & 1) asm volatile("" ::: "memory"); }
    }
};
}

namespace att {
constexpr int NW = 8, QBLK = 32, KVBLK = 64;
constexpr int SHM_V = 16384, SHM_KN = 16384, SHM_KR = 8192;
constexpr int OFF_V = 0, OFF_KN = 2 * SHM_V, OFF_KR = OFF_KN + 2 * SHM_KN, OFF_WS = OFF_KR + 2 * SHM_KR, OFF_QR = OFF_WS + NW * 64 * 4, LDS_BYTES = OFF_QR + NW * 4096;
constexpr float THRL = 8.0f * LOG2E;
constexpr float THRL8 = 6.0f;
#define KSW(row, colB) ((row) * 256 + ((colB) ^ (((row) & 15) << 4)))
#define KRSW(row, ch) ((row) * 128 + ((((ch) ^ (((row) >> 1) & 7))) << 4))
#define SBAR() __builtin_amdgcn_sched_barrier(0)
__device__ __forceinline__ int crow(int r, int hi) { return (r & 3) + 8 * (r >> 2) + 4 * hi; }
__device__ __forceinline__ unsigned cvtpk(float lo, float hi) { unsigned r; asm volatile("v_cvt_pk_bf16_f32 %0, %1, %2" : "=v"(r) : "v"(lo), "v"(hi)); return r; }
__device__ __forceinline__ void partialSM(f32x16& p0, f32x16& p1, float& m_reg, float& mn, float& alpha) {
    float pmax = p0[0];
#pragma unroll
    for (int r = 1; r < 16; ++r) pmax = fmaxf(pmax, p0[r]);
#pragma unroll
    for (int r = 0; r < 16; ++r) pmax = fmaxf(pmax, p1[r]);
    { auto rr = __builtin_amdgcn_permlane32_swap(__float_as_uint(pmax), __float_as_uint(pmax), false, false); pmax = fmaxf(__uint_as_float(rr[0]), __uint_as_float(rr[1])); }
    if (__builtin_expect(__all(pmax - m_reg <= THRL), 1)) { mn = m_reg; alpha = 1.f; }
    else { mn = fmaxf(m_reg, pmax); alpha = __builtin_amdgcn_exp2f(m_reg - mn); m_reg = mn; }
#pragma unroll
    for (int r = 0; r < 16; ++r) p0[r] = p0[r] - mn;
#pragma unroll
    for (int r = 0; r < 16; ++r) p1[r] = p1[r] - mn;
#pragma unroll
    for (int r = 0; r < 16; ++r) p0[r] = __builtin_amdgcn_exp2f(p0[r]);
}
__device__ __forceinline__ void finishSM(f32x16& p0, f32x16& p1, float alpha, float& l_reg, bf16x8& pa0, bf16x8& pa1, bf16x8& pa2, bf16x8& pa3) {
#pragma unroll
    for (int r = 0; r < 16; ++r) p1[r] = __builtin_amdgcn_exp2f(p1[r]);
    float ps = 0;
#pragma unroll
    for (int r = 0; r < 16; ++r) ps += p0[r];
#pragma unroll
    for (int r = 0; r < 16; ++r) ps += p1[r];
    { auto rr = __builtin_amdgcn_permlane32_swap(__float_as_uint(ps), __float_as_uint(ps), false, false); ps = __uint_as_float(rr[0]) + __uint_as_float(rr[1]); }
    l_reg = l_reg * alpha + ps;
#define PK4(P, BASE, OUT) do { unsigned a0 = cvtpk(P[BASE + 0], P[BASE + 1]), a1 = cvtpk(P[BASE + 2], P[BASE + 3]);   \
    unsigned b0 = cvtpk(P[BASE + 4], P[BASE + 5]), b1 = cvtpk(P[BASE + 6], P[BASE + 7]);                              \
    auto r0 = __builtin_amdgcn_permlane32_swap(a0, b0, false, false); auto r1 = __builtin_amdgcn_permlane32_swap(a1, b1, false, false); \
    u32x4 w = {r0[0], r1[0], r0[1], r1[1]}; OUT = *reinterpret_cast<bf16x8*>(&w); } while (0)
    PK4(p0, 0, pa0); PK4(p0, 8, pa1); PK4(p1, 0, pa2); PK4(p1, 8, pa3);
#undef PK4
}
__device__ __forceinline__ void qkt(f32x16& p0, f32x16& p1, const char* Kn, const char* Kr, const bf16x8* qr, const char* qrl, int r32, int hi) {
    p0 = f32x16{}; p1 = f32x16{};
#pragma unroll
    for (int d0 = 0; d0 < 8; ++d0) { const int cb = (d0 * 16 + hi * 8) * 2;
        const bf16x8 b0 = *reinterpret_cast<const bf16x8*>(Kn + KSW(r32, cb));
        const bf16x8 b1 = *reinterpret_cast<const bf16x8*>(Kn + KSW(32 + r32, cb));
        p0 = __builtin_amdgcn_mfma_f32_32x32x16_bf16(b0, qr[d0], p0, 0, 0, 0);
        p1 = __builtin_amdgcn_mfma_f32_32x32x16_bf16(b1, qr[d0], p1, 0, 0, 0); }
#pragma unroll
    for (int d0 = 0; d0 < 4; ++d0) { const int ch = d0 * 2 + hi;
        const bf16x8 b0 = *reinterpret_cast<const bf16x8*>(Kr + KRSW(r32, ch));
        const bf16x8 b1 = *reinterpret_cast<const bf16x8*>(Kr + KRSW(32 + r32, ch));
        const bf16x8 qv = *reinterpret_cast<const bf16x8*>(qrl + d0 * 1024);
        p0 = __builtin_amdgcn_mfma_f32_32x32x16_bf16(b0, qv, p0, 0, 0, 0);
        p1 = __builtin_amdgcn_mfma_f32_32x32x16_bf16(b1, qv, p1, 0, 0, 0); }
}
__device__ __forceinline__ int v_st(int k, int c) { const int kk = (k & ~0xC) | ((k & 4) << 1) | ((k & 8) >> 1); return ((kk >> 3) * 4 + (c >> 5)) * 512 + ((kk & 7) * 32 + (c & 31)) * 2; }
__device__ __forceinline__ int v_rd_base(int lane) { return ((lane & 3) << 3) | (((lane >> 2) & 3) << 6) | (((lane >> 4) & 1) << 5) | (((lane >> 5) & 1) << 8); }
constexpr int v_rd_off(int d0, int ks, int half) { return d0 * 512 + ks * 4096 + half * 2048; }
template <int OFF> __device__ __forceinline__ s16x4 tr_read(int vb) { s16x4 r; asm volatile("ds_read_b64_tr_b16 %0, %1 offset:%2" : "=&v"(r) : "v"(vb), "i"(OFF) : "memory"); return r; }
template <int D0> __device__ __forceinline__ void pv_one(f32x16& od, int vb, bf16x8 pa0, bf16x8 pa1, bf16x8 pa2, bf16x8 pa3) {
    const s16x4 l0 = tr_read<v_rd_off(D0, 0, 0)>(vb), h0 = tr_read<v_rd_off(D0, 0, 1)>(vb), l1 = tr_read<v_rd_off(D0, 1, 0)>(vb), h1 = tr_read<v_rd_off(D0, 1, 1)>(vb);
    const s16x4 l2 = tr_read<v_rd_off(D0, 2, 0)>(vb), h2 = tr_read<v_rd_off(D0, 2, 1)>(vb), l3 = tr_read<v_rd_off(D0, 3, 0)>(vb), h3 = tr_read<v_rd_off(D0, 3, 1)>(vb);
    asm volatile("s_waitcnt lgkmcnt(0)" ::: "memory"); SBAR();
#define PK(L, H) (bf16x8){L[0], L[1], L[2], L[3], H[0], H[1], H[2], H[3]}
    od = __builtin_amdgcn_mfma_f32_32x32x16_bf16(pa0, PK(l0, h0), od, 0, 0, 0);
    od = __builtin_amdgcn_mfma_f32_32x32x16_bf16(pa1, PK(l1, h1), od, 0, 0, 0);
    od = __builtin_amdgcn_mfma_f32_32x32x16_bf16(pa2, PK(l2, h2), od, 0, 0, 0);
    od = __builtin_amdgcn_mfma_f32_32x32x16_bf16(pa3, PK(l3, h3), od, 0, 0, 0);
#undef PK
}
__device__ __forceinline__ void pv_d0(f32x16* o, int vb, bf16x8 pa0, bf16x8 pa1, bf16x8 pa2, bf16x8 pa3) {
    pv_one<0>(o[0], vb, pa0, pa1, pa2, pa3); pv_one<1>(o[1], vb, pa0, pa1, pa2, pa3); pv_one<2>(o[2], vb, pa0, pa1, pa2, pa3); pv_one<3>(o[3], vb, pa0, pa1, pa2, pa3);
}
typedef short v4i16_t __attribute__((ext_vector_type(4)));
typedef __attribute__((address_space(3))) const char* lcp;
#ifndef ATT_SD
#define ATT_SD 5
#endif
#ifndef ATT_PRIO_MFMA
#define ATT_PRIO_MFMA 1
#endif
#ifndef ATT_PRIO_VALU
#define ATT_PRIO_VALU 0
#endif
constexpr int SD = ATT_SD, NSL = ATT_SD + 1;
struct Seg1Regs { bf16x8 fa[NSL]; bf16x8 fq[2]; };
template <int I, bool PV, int VAR> __device__ __forceinline__ void seg1_read(Seg1Regs& R, lcp kn, lcp kr, lcp ql, lcp vp, unsigned kx, unsigned krx, int hi) {
    if constexpr (VAR == 3) { asm volatile("" : "=v"(R.fa[I % NSL])); if constexpr (I >= 16 && I < 24 && ((I & 1) == 0)) asm volatile("" : "=v"(R.fq[((I - 16) >> 1) & 1])); }
    else if constexpr (I < 16) { constexpr int d0 = I >> 1, wh = I & 1; R.fa[I % NSL] = *(const __attribute__((address_space(3))) bf16x8*)(kn + wh * 8192 + (((unsigned)(d0 * 32 + hi * 16)) ^ kx)); }
    else if constexpr (I < 24) { constexpr int d0 = (I - 16) >> 1, wh = (I - 16) & 1; R.fa[I % NSL] = *(const __attribute__((address_space(3))) bf16x8*)(kr + wh * 4096 + ((((unsigned)(d0 * 2 + hi)) ^ krx) << 4));
        if constexpr (wh == 0) R.fq[d0 & 1] = *(const __attribute__((address_space(3))) bf16x8*)(ql + d0 * 1024); }
    else if constexpr (I < 40) { if constexpr (PV) { constexpr int d0 = (I - 24) >> 2, ks = (I - 24) & 3;
        const s16x4 lo = __builtin_bit_cast(s16x4, __builtin_amdgcn_ds_read_tr16_b64_v4i16((__attribute__((address_space(3))) v4i16_t*)(vp + v_rd_off(d0, ks, 0))));
        const s16x4 hh = __builtin_bit_cast(s16x4, __builtin_amdgcn_ds_read_tr16_b64_v4i16((__attribute__((address_space(3))) v4i16_t*)(vp + v_rd_off(d0, ks, 1))));
        R.fa[I % NSL] = (bf16x8){lo[0], lo[1], lo[2], lo[3], hh[0], hh[1], hh[2], hh[3]}; } }
}
template <int I, bool PV, int VAR> __device__ __forceinline__ void seg1_mfma(Seg1Regs& R, f32x16& p0, f32x16& p1, f32x16* o, const bf16x8* qr, const bf16x8 (&pa)[4]) {
    if constexpr (VAR == 2) { asm volatile("" :: "v"(R.fa[I % NSL])); if constexpr (I >= 16 && I < 24) asm volatile("" :: "v"(R.fq[((I - 16) >> 1) & 1])); }
    else if constexpr (I < 16) { constexpr int d0 = I >> 1; if constexpr (I & 1) p1 = __builtin_amdgcn_mfma_f32_32x32x16_bf16(R.fa[I % NSL], qr[d0], p1, 0, 0, 0); else p0 = __builtin_amdgcn_mfma_f32_32x32x16_bf16(R.fa[I % NSL], qr[d0], p0, 0, 0, 0); }
    else if constexpr (I < 24) { constexpr int d0 = (I - 16) >> 1; if constexpr (I & 1) p1 = __builtin_amdgcn_mfma_f32_32x32x16_bf16(R.fa[I % NSL], R.fq[d0 & 1], p1, 0, 0, 0); else p0 = __builtin_amdgcn_mfma_f32_32x32x16_bf16(R.fa[I % NSL], R.fq[d0 & 1], p0, 0, 0, 0); }
    else if constexpr (PV) { constexpr int d0 = (I - 24) >> 2, ks = (I - 24) & 3; o[d0] = __builtin_amdgcn_mfma_f32_32x32x16_bf16(pa[ks], R.fa[I % NSL], o[d0], 0, 0, 0); }
}
template <int I, bool PV, int VAR> __device__ __forceinline__ void seg1_steps(Seg1Regs& R, f32x16& p0, f32x16& p1, f32x16* o, const bf16x8* qr, const bf16x8 (&pa)[4], lcp kn, lcp kr, lcp ql, lcp vp, unsigned kx, unsigned krx, int hi) {
    constexpr int NOPS = PV ? 40 : 24;
    if constexpr (I < NOPS) {
        if constexpr (I + SD < NOPS) seg1_read<I + SD, PV, VAR>(R, kn, kr, ql, vp, kx, krx, hi);
        seg1_mfma<I, PV, VAR>(R, p0, p1, o, qr, pa);
        SBAR();
        seg1_steps<I + 1, PV, VAR>(R, p0, p1, o, qr, pa, kn, kr, ql, vp, kx, krx, hi);
    }
}
template <bool PV, int VAR> __device__ __forceinline__ void seg1(f32x16& p0, f32x16& p1, f32x16* o, const bf16x8* qr, const bf16x8 (&pa)[4], lcp kn, lcp kr, lcp ql, lcp vp, unsigned kx, unsigned krx, int hi) {
    Seg1Regs R; p0 = f32x16{}; p1 = f32x16{};
    seg1_read<0, PV, VAR>(R, kn, kr, ql, vp, kx, krx, hi); seg1_read<1, PV, VAR>(R, kn, kr, ql, vp, kx, krx, hi); seg1_read<2, PV, VAR>(R, kn, kr, ql, vp, kx, krx, hi);
    if constexpr (SD > 3) seg1_read<3, PV, VAR>(R, kn, kr, ql, vp, kx, krx, hi); if constexpr (SD > 4) seg1_read<4, PV, VAR>(R, kn, kr, ql, vp, kx, krx, hi); if constexpr (SD > 5) seg1_read<5, PV, VAR>(R, kn, kr, ql, vp, kx, krx, hi);
    SBAR();
    seg1_steps<0, PV, VAR>(R, p0, p1, o, qr, pa, kn, kr, ql, vp, kx, krx, hi);
}
__device__ __forceinline__ void seg1_pv_only(f32x16* o, const bf16x8 (&pa)[4], lcp vp) {
#pragma unroll
    for (int d0 = 0; d0 < 4; ++d0) { bf16x8 vf[4];
#pragma unroll
        for (int ks = 0; ks < 4; ++ks) { const s16x4 lo = __builtin_bit_cast(s16x4, __builtin_amdgcn_ds_read_tr16_b64_v4i16((__attribute__((address_space(3))) v4i16_t*)(vp + v_rd_off(d0, ks, 0))));
            const s16x4 hh = __builtin_bit_cast(s16x4, __builtin_amdgcn_ds_read_tr16_b64_v4i16((__attribute__((address_space(3))) v4i16_t*)(vp + v_rd_off(d0, ks, 1))));
            vf[ks] = (bf16x8){lo[0], lo[1], lo[2], lo[3], hh[0], hh[1], hh[2], hh[3]}; }
#pragma unroll
        for (int ks = 0; ks < 4; ++ks) o[d0] = __builtin_amdgcn_mfma_f32_32x32x16_bf16(pa[ks], vf[ks], o[d0], 0, 0, 0); }
}
__device__ __forceinline__ void glds16(const void* gsrc, unsigned lds_dst) { unsigned keep;
    asm volatile("s_mov_b32 %0, m0\n\ts_mov_b32 m0, %2\n\ts_nop 0\n\tglobal_load_lds_dwordx4 %1, off\n\ts_mov_b32 m0, %0" : "=&s"(keep) : "v"(gsrc), "s"(lds_dst) : "memory"); }
__device__ __forceinline__ void glds16s(const char* sbase, unsigned voff, unsigned lds_dst) { unsigned keep;
    asm volatile("s_mov_b32 %0, m0\n\ts_mov_b32 m0, %3\n\ts_nop 0\n\tglobal_load_lds_dwordx4 %1, %2\n\ts_mov_b32 m0, %0" : "=&s"(keep) : "v"(voff), "s"(sbase), "s"(lds_dst) : "memory"); }
#define ABAR() asm volatile("s_waitcnt lgkmcnt(0)\n\ts_barrier" ::: "memory")
template <int VAR> __device__ __forceinline__ void softmax_tile(f32x16& p0, f32x16& p1, float& m_reg, float& l_reg, f32x16* o, float* al_l, int r32, int hi, bf16x8 (&pa)[4]) {
    float pm0 = fmaxf(p0[0], p0[1]), pm1 = fmaxf(p0[2], p0[3]);
#pragma unroll
    for (int r = 4; r < 16; r += 2) { pm0 = fmaxf(pm0, p0[r]); pm1 = fmaxf(pm1, p0[r + 1]); }
#pragma unroll
    for (int r = 0; r < 16; r += 2) { pm0 = fmaxf(pm0, p1[r]); pm1 = fmaxf(pm1, p1[r + 1]); }
    float pmax = fmaxf(pm0, pm1);
    { auto rr = __builtin_amdgcn_permlane32_swap(__float_as_uint(pmax), __float_as_uint(pmax), false, false); pmax = fmaxf(__uint_as_float(rr[0]), __uint_as_float(rr[1])); }
    float mn = m_reg, alpha = 1.f;
    if (!__builtin_expect(__all(pmax - m_reg <= THRL), 1)) { mn = fmaxf(m_reg, pmax); alpha = __builtin_amdgcn_exp2f(m_reg - mn); m_reg = mn; }
#pragma unroll
    for (int r = 0; r < 16; ++r) { if constexpr (VAR == 1) { p0[r] = p0[r] - mn; p1[r] = p1[r] - mn; } else { p0[r] = __builtin_amdgcn_exp2f(p0[r] - mn); p1[r] = __builtin_amdgcn_exp2f(p1[r] - mn); } }
    float s0 = p0[0] + p1[0], s1 = p0[1] + p1[1], s2 = p0[2] + p1[2], s3 = p0[3] + p1[3];
#pragma unroll
    for (int r = 4; r < 16; r += 4) { s0 += p0[r] + p1[r]; s1 += p0[r + 1] + p1[r + 1]; s2 += p0[r + 2] + p1[r + 2]; s3 += p0[r + 3] + p1[r + 3]; }
    float ps = (s0 + s1) + (s2 + s3);
    { auto rr = __builtin_amdgcn_permlane32_swap(__float_as_uint(ps), __float_as_uint(ps), false, false); ps = __uint_as_float(rr[0]) + __uint_as_float(rr[1]); }
    l_reg = l_reg * alpha + ps;
#define PK4(P, BASE, OUT) do { unsigned a0 = cvtpk(P[BASE + 0], P[BASE + 1]), a1 = cvtpk(P[BASE + 2], P[BASE + 3]);   \
    unsigned b0 = cvtpk(P[BASE + 4], P[BASE + 5]), b1 = cvtpk(P[BASE + 6], P[BASE + 7]);                              \
    auto r0 = __builtin_amdgcn_permlane32_swap(a0, b0, false, false); auto r1 = __builtin_amdgcn_permlane32_swap(a1, b1, false, false); \
    u32x4 w = {r0[0], r1[0], r0[1], r1[1]}; OUT = *reinterpret_cast<bf16x8*>(&w); } while (0)
    PK4(p0, 0, pa[0]); PK4(p0, 8, pa[1]); PK4(p1, 0, pa[2]); PK4(p1, 8, pa[3]);
#undef PK4
    if (__any(alpha < 1.f)) { if (hi == 0) al_l[r32] = alpha; asm volatile("s_waitcnt lgkmcnt(0)" ::: "memory");
#pragma unroll
        for (int d = 0; d < 4; ++d)
#pragma unroll
            for (int r = 0; r < 16; ++r) o[d][r] *= al_l[crow(r, hi)]; }
}
template <int VAR> __device__ __forceinline__ void attn_unit(const bf16_t* __restrict__ Qn, const bf16_t* __restrict__ Qr, const bf16_t* __restrict__ Kn, const bf16_t* __restrict__ KR, const bf16_t* __restrict__ Vv,
                                          bf16_t* __restrict__ O, long qrow0, long krow0, int h, int seq, LAS unsigned char* ldsl) {
    char* lds = (char*)ldsl;
    const int tid = threadIdx.x, wid = __builtin_amdgcn_readfirstlane(tid >> 6), lane = tid & 63, r32 = lane & 31, hi = lane >> 5;
    const int half = wid >> 2;
    char* V_lds = lds + OFF_V; char* Kn_lds = lds + OFF_KN; char* Kr_lds = lds + OFF_KR;
    float* ws = (float*)(lds + OFF_WS) + wid * 64; float* li_l = ws; float* al_l = ws + 32;
    float m_reg = -1e30f, l_reg = 0; f32x16 o[4] = {}; bf16x8 qr[8]; char* qrl = lds + OFF_QR + wid * 4096 + lane * 16;
    { const bf16_t* qn = Qn + (qrow0 + wid * QBLK + r32) * 1024 + h * 128 + hi * 8; const bf16_t* qp = Qr + (qrow0 + wid * QBLK + r32) * 512 + h * 64 + hi * 8;
#pragma unroll
      for (int d0 = 0; d0 < 8; ++d0) qr[d0] = *reinterpret_cast<const bf16x8*>(qn + d0 * 16);
#pragma unroll
      for (int d0 = 0; d0 < 4; ++d0) *reinterpret_cast<bf16x8*>(qrl + d0 * 1024) = *reinterpret_cast<const bf16x8*>(qp + d0 * 16);
#pragma unroll
      for (int d0 = 0; d0 < 8; ++d0) asm volatile("" :: "v"(qr[d0]));
    }
    const bf16_t* Kh = Kn + krow0 * 1024 + h * 128; const bf16_t* Vh = Vv + krow0 * 1024 + h * 128; const bf16_t* Rh = KR + krow0 * 64;
    unsigned kn_so[2], v_so[2], kr_so;
#pragma unroll
    for (int i = 0; i < 2; ++i) { const int p = 2 * wid + i;
        { const int row = 4 * p + (lane >> 4), pc = lane & 15, lc = pc ^ (row & 15); kn_so[i] = (unsigned)(row * 1024 + lc * 8); }
        { const int st = 2 * p + (lane >> 5), kk = (st >> 2) * 8 + ((lane & 31) >> 2), c = (st & 3) * 32 + (lane & 3) * 8; const int k = (kk & ~0xC) | ((kk & 4) << 1) | ((kk & 8) >> 1); v_so[i] = (unsigned)(k * 1024 + c); } }
    { const int row = 8 * wid + (lane >> 3), pc = lane & 7, lc = pc ^ ((row >> 1) & 7); kr_so = (unsigned)(row * 64 + lc * 8); }
    const int NT = seq / KVBLK;
    const unsigned lds0 = (unsigned)(uintptr_t)ldsl;
    const unsigned dk_ = (unsigned)__builtin_amdgcn_readfirstlane((int)(lds0 + OFF_KN + (2 * wid) * 1024)), dr_ = (unsigned)__builtin_amdgcn_readfirstlane((int)(lds0 + OFF_KR + wid * 1024)), dv_ = (unsigned)__builtin_amdgcn_readfirstlane((int)(lds0 + OFF_V + (2 * wid) * 1024));
#define DMA_K(t, b) do { const bf16_t* Kt_ = Kh + (size_t)(t) * (KVBLK * 1024); const bf16_t* Rt_ = Rh + (size_t)(t) * (KVBLK * 64); \
    glds16(Kt_ + kn_so[0], dk_ + (b) * SHM_KN); glds16(Kt_ + kn_so[1], dk_ + (b) * SHM_KN + 1024); glds16(Rt_ + kr_so, dr_ + (b) * SHM_KR); } while (0)
#define DMA_V(t, b) do { const bf16_t* Vt_ = Vh + (size_t)(t) * (KVBLK * 1024); \
    glds16(Vt_ + v_so[0], dv_ + (b) * SHM_V); glds16(Vt_ + v_so[1], dv_ + (b) * SHM_V + 1024); } while (0)
#define VMW() asm volatile("s_waitcnt vmcnt(0)" ::: "memory")
    f32x16 p0, p1; bf16x8 pa[4] = {};
    { const bf16x8 z = {}; *(bf16x8*)(V_lds + SHM_V + tid * 32) = z; *(bf16x8*)(V_lds + SHM_V + tid * 32 + 16) = z; }
    const lcp kn_l = (lcp)Kn_lds + r32 * 256, kr_l = (lcp)Kr_lds + r32 * 128, ql_l = (lcp)qrl, vp_l = (lcp)V_lds + v_rd_base(lane);
    const unsigned kx = (unsigned)(r32 & 15) << 4, krx = (unsigned)((r32 >> 1) & 7);
    DMA_K(0, 0); VMW();
    ABAR();
    if (half) { DMA_K(1, 1); DMA_V(0, 0); ABAR(); }
    for (int j = 0; j < NT; j += 2) {
        if constexpr (VAR != 4) { if (!half) { DMA_K(j + 1, 1); DMA_V(j, 0); } }
        SBAR(); __builtin_amdgcn_s_setprio(ATT_PRIO_MFMA);
        seg1<true, VAR>(p0, p1, o, qr, pa, kn_l, kr_l, ql_l, vp_l + SHM_V, kx, krx, hi);
        __builtin_amdgcn_s_setprio(ATT_PRIO_VALU); SBAR();
        if (half) VMW();
        ABAR();
        if constexpr (VAR != 4) { if (half) { if (j + 2 < NT) DMA_K(j + 2, 0); DMA_V(j + 1, 1); } }
        softmax_tile<VAR>(p0, p1, m_reg, l_reg, o, al_l, r32, hi, pa);
        if (!half) VMW();
        ABAR();
        if constexpr (VAR != 4) { if (!half) { if (j + 2 < NT) DMA_K(j + 2, 0); DMA_V(j + 1, 1); } }
        SBAR(); __builtin_amdgcn_s_setprio(ATT_PRIO_MFMA);
        seg1<true, VAR>(p0, p1, o, qr, pa, kn_l + SHM_KN, kr_l + SHM_KR, ql_l, vp_l, kx, krx, hi);
        __builtin_amdgcn_s_setprio(ATT_PRIO_VALU); SBAR();
        if (half) VMW();
        ABAR();
        if constexpr (VAR != 4) { if (half) { if (j + 3 < NT) DMA_K(j + 3, 1); if (j + 2 < NT) DMA_V(j + 2, 0); } }
        softmax_tile<VAR>(p0, p1, m_reg, l_reg, o, al_l, r32, hi, pa);
        if (!half) VMW();
        ABAR();
    }
    SBAR(); seg1_pv_only(o, pa, vp_l + SHM_V); SBAR();
    if (!half) ABAR();
    if (hi == 0) li_l[r32] = l_reg; asm volatile("s_waitcnt lgkmcnt(0)" ::: "memory");
    float rli[16];
#pragma unroll
    for (int r = 0; r < 16; ++r) rli[r] = __builtin_amdgcn_rcpf(li_l[crow(r, hi)]);
    bf16_t* Ow = O + (qrow0 + wid * QBLK) * 1024 + h * 128;
#pragma unroll
    for (int r = 0; r < 16; ++r) { const int orow = crow(r, hi);
#pragma unroll
        for (int d0 = 0; d0 < 4; ++d0) Ow[(long)orow * 1024 + d0 * 32 + r32] = (bf16_t)(cvtpk(o[d0][r] * rli[r], 0.f) & 0xffffu); }
    asm volatile("s_waitcnt vmcnt(0)" ::: "memory");
    __syncthreads();
#undef DMA_K
#undef DMA_V
#undef VMW
}
typedef int v8i __attribute__((ext_vector_type(8)));
constexpr int F_SHM_K = 12288, F_SHM_V = 8192, F_OFF_V = 0, F_OFF_K = 2 * F_SHM_V, F_OFF_WS = F_OFF_K + 2 * F_SHM_K, F_LDS_BYTES = F_OFF_WS + NW * 64 * 4;
constexpr int FOPS = 10;
#ifndef ATT_FD
#define ATT_FD 3
#endif
constexpr int FD = ATT_FD, FSL = ATT_FD + 1;
struct Seg1F { v8i fk[FSL]; };
template <int I> __device__ __forceinline__ void seg1f_read(Seg1F& R, lcp k8, lcp vp, unsigned x0, unsigned x1) {
    if constexpr (I < 6) { constexpr int c = I >> 1, wh = I & 1; const lcp b = k8 + c * 4096 + wh * 2048;
        const u32x4 lo = *(const __attribute__((address_space(3))) u32x4*)(b + x0), hh = *(const __attribute__((address_space(3))) u32x4*)(b + x1);
        R.fk[I % FSL] = (v8i){(int)lo.x, (int)lo.y, (int)lo.z, (int)lo.w, (int)hh.x, (int)hh.y, (int)hh.z, (int)hh.w}; }
    else if constexpr (I < FOPS) { constexpr int d0 = I - 6; const lcp b = vp + d0 * 2048;
        const u32x4 lo = *(const __attribute__((address_space(3))) u32x4*)(b + x0), hh = *(const __attribute__((address_space(3))) u32x4*)(b + x1);
        R.fk[I % FSL] = (v8i){(int)lo.x, (int)lo.y, (int)lo.z, (int)lo.w, (int)hh.x, (int)hh.y, (int)hh.z, (int)hh.w}; }
}
template <int I> __device__ __forceinline__ void seg1f_mfma(Seg1F& R, f32x16& p0, f32x16& p1, f32x16* o, const v8i (&q8)[3], const v8i& pa) {
    if constexpr (I == 0) asm volatile("v_mfma_f32_32x32x64_f8f6f4 %0, %1, %2, 0" : "=v"(p0) : "v"(R.fk[I % FSL]), "v"(q8[0]));
    else if constexpr (I == 1) asm volatile("v_mfma_f32_32x32x64_f8f6f4 %0, %1, %2, 0" : "=v"(p1) : "v"(R.fk[I % FSL]), "v"(q8[0]));
    else if constexpr (I < 6) { constexpr int c = I >> 1;
        if constexpr (I & 1) asm volatile("v_mfma_f32_32x32x64_f8f6f4 %0, %1, %2, %0" : "+v"(p1) : "v"(R.fk[I % FSL]), "v"(q8[c]));
        else asm volatile("v_mfma_f32_32x32x64_f8f6f4 %0, %1, %2, %0" : "+v"(p0) : "v"(R.fk[I % FSL]), "v"(q8[c])); }
    else { constexpr int d0 = I - 6; asm volatile("v_mfma_f32_32x32x64_f8f6f4 %0, %1, %2, %0" : "+v"(o[d0]) : "v"(pa), "v"(R.fk[I % FSL])); }
}
template <int I> __device__ __forceinline__ void seg1f_steps(Seg1F& R, f32x16& p0, f32x16& p1, f32x16* o, const v8i (&q8)[3], const v8i& pa, lcp k8, lcp vp, unsigned x0, unsigned x1) {
    if constexpr (I < FOPS) {
        if constexpr (I + FD < FOPS) seg1f_read<I + FD>(R, k8, vp, x0, x1);
        seg1f_mfma<I>(R, p0, p1, o, q8, pa);
        SBAR();
        seg1f_steps<I + 1>(R, p0, p1, o, q8, pa, k8, vp, x0, x1);
    }
}
__device__ __forceinline__ void seg1f(f32x16& p0, f32x16& p1, f32x16* o, const v8i (&q8)[3], const v8i& pa, lcp k8, lcp vp, unsigned x0, unsigned x1) {
    Seg1F R; p0 = f32x16{}; p1 = f32x16{};
    seg1f_read<0>(R, k8, vp, x0, x1); if constexpr (FD > 1) seg1f_read<1>(R, k8, vp, x0, x1); if constexpr (FD > 2) seg1f_read<2>(R, k8, vp, x0, x1); if constexpr (FD > 3) seg1f_read<3>(R, k8, vp, x0, x1); if constexpr (FD > 4) seg1f_read<4>(R, k8, vp, x0, x1); if constexpr (FD > 5) seg1f_read<5>(R, k8, vp, x0, x1);
    SBAR();
    seg1f_steps<0>(R, p0, p1, o, q8, pa, k8, vp, x0, x1);
}
template <int SINV8> __device__ __forceinline__ void softmax_tile_s(f32x16& p0, f32x16& p1, float& m_reg, float& l_reg, f32x16* o, float* al_l, int r32, int hi, v8i& pa) {
    constexpr float C = 1.0f / Q8MUL;
    float pm0 = fmaxf(p0[0], p0[1]), pm1 = fmaxf(p0[2], p0[3]);
#pragma unroll
    for (int r = 4; r < 16; r += 2) { pm0 = fmaxf(pm0, p0[r]); pm1 = fmaxf(pm1, p0[r + 1]); }
#pragma unroll
    for (int r = 0; r < 16; r += 2) { pm0 = fmaxf(pm0, p1[r]); pm1 = fmaxf(pm1, p1[r + 1]); }
    float pmax = fmaxf(pm0, pm1);
    { auto rr = __builtin_amdgcn_permlane32_swap(__float_as_uint(pmax), __float_as_uint(pmax), false, false); pmax = fmaxf(__uint_as_float(rr[0]), __uint_as_float(rr[1])); }
    float mn = m_reg, alpha = 1.f;
    if (!__builtin_expect(__all(pmax - m_reg <= THRL8 * Q8MUL), 1)) { mn = fmaxf(m_reg, pmax); alpha = __builtin_amdgcn_exp2f((m_reg - mn) * C); m_reg = mn; }
    const float mc = -mn * C;
#pragma unroll
    for (int r = 0; r < 16; ++r) { if constexpr (SINV8 == 2) { p0[r] = fmaf(p0[r], C, mc); p1[r] = fmaf(p1[r], C, mc); } else if constexpr (SINV8 == 3) { p0[r] = __builtin_amdgcn_exp2f(p0[r]); p1[r] = __builtin_amdgcn_exp2f(p1[r]); } else { p0[r] = __builtin_amdgcn_exp2f(fmaf(p0[r], C, mc)); p1[r] = __builtin_amdgcn_exp2f(fmaf(p1[r], C, mc)); } }
    float s0 = p0[0] + p1[0], s1 = p0[1] + p1[1], s2 = p0[2] + p1[2], s3 = p0[3] + p1[3];
#pragma unroll
    for (int r = 4; r < 16; r += 4) { s0 += p0[r] + p1[r]; s1 += p0[r + 1] + p1[r + 1]; s2 += p0[r + 2] + p1[r + 2]; s3 += p0[r + 3] + p1[r + 3]; }
    float ps = (s0 + s1) + (s2 + s3);
    { auto rr = __builtin_amdgcn_permlane32_swap(__float_as_uint(ps), __float_as_uint(ps), false, false); ps = __uint_as_float(rr[0]) + __uint_as_float(rr[1]); }
    l_reg = l_reg * alpha + ps;
#pragma unroll
    for (int j = 0; j < 4; ++j) { int a = __builtin_amdgcn_cvt_pk_fp8_f32(p0[4 * j], p0[4 * j + 1], 0, false); a = __builtin_amdgcn_cvt_pk_fp8_f32(p0[4 * j + 2], p0[4 * j + 3], a, true); pa[j] = a;
        int c = __builtin_amdgcn_cvt_pk_fp8_f32(p1[4 * j], p1[4 * j + 1], 0, false); c = __builtin_amdgcn_cvt_pk_fp8_f32(p1[4 * j + 2], p1[4 * j + 3], c, true); pa[4 + j] = c; }
    if (__any(alpha < 1.f)) { if (hi == 0) al_l[r32] = alpha; asm volatile("s_waitcnt lgkmcnt(0)" ::: "memory");
#pragma unroll
        for (int d = 0; d < 4; ++d)
#pragma unroll
            for (int r = 0; r < 16; ++r) o[d][r] *= al_l[crow(r, hi)]; }
}
template <int VARF> __device__ __forceinline__ void attn_unit_f8(const unsigned char* __restrict__ Qn8, const unsigned char* __restrict__ Qr8, const unsigned char* __restrict__ Kn8, const unsigned char* __restrict__ KR8, const unsigned char* __restrict__ VT8,
                                             bf16_t* __restrict__ O, long qrow0, long krow0, int h, int seq, LAS unsigned char* ldsl) {
    char* lds = (char*)ldsl;
    const int tid = threadIdx.x, wid = __builtin_amdgcn_readfirstlane(tid >> 6), lane = tid & 63, r32 = lane & 31, hi = lane >> 5;
    const int half = wid >> 2;
    char* V_lds = lds + F_OFF_V; char* K_lds = lds + F_OFF_K;
    float* ws = (float*)(lds + F_OFF_WS) + wid * 64; float* li_l = ws; float* al_l = ws + 32;
    float m_reg = -1e30f, l_reg = 0; f32x16 o[4] = {}; v8i q8[3];
    { const unsigned char* qn = Qn8 + (qrow0 + wid * QBLK + r32) * 1024 + h * 128 + hi * 32; const unsigned char* qp = Qr8 + (qrow0 + wid * QBLK + r32) * 512 + h * 64 + hi * 32;
#pragma unroll
      for (int c = 0; c < 3; ++c) { const unsigned char* s = c < 2 ? qn + c * 64 : qp; const u32x4 lo = *(const u32x4*)s, hh = *(const u32x4*)(s + 16);
          q8[c] = (v8i){(int)lo.x, (int)lo.y, (int)lo.z, (int)lo.w, (int)hh.x, (int)hh.y, (int)hh.z, (int)hh.w}; }
#pragma unroll
      for (int c = 0; c < 3; ++c) asm volatile("" :: "v"(q8[c]));
    }
    const unsigned char* Kh = Kn8 + krow0 * 1024 + h * 128; const unsigned char* Vh = VT8 + ((size_t)(krow0 >> 13) * 1024 + h * 128) * 8192; const unsigned char* Rh = KR8 + krow0 * 64;
    unsigned kso0, kso1, vso;
    { const int key = 16 * (wid & 3) + (lane >> 2), pc = lane & 3, lc = pc ^ ((key >> 2) & 3); kso0 = (unsigned)(key * 1024 + (wid >> 2) * 64 + lc * 16); kso1 = (unsigned)(key * 64 + lc * 16); }
    { const int d = 16 * wid + (lane >> 2), pc = lane & 3, lc = pc ^ ((d >> 2) & 3); vso = (unsigned)(d * 8192 + lc * 16); }
    const int NT = seq / KVBLK;
    const unsigned lds0 = (unsigned)(uintptr_t)ldsl;
    const unsigned dk_ = (unsigned)__builtin_amdgcn_readfirstlane((int)(lds0 + F_OFF_K + wid * 1024)), dv_ = (unsigned)__builtin_amdgcn_readfirstlane((int)(lds0 + F_OFF_V + wid * 1024));
#define DMA_K(t, b) do { glds16(Kh + (size_t)(t) * (KVBLK * 1024) + kso0, dk_ + (b) * F_SHM_K); if (wid < 4) glds16(Rh + (size_t)(t) * (KVBLK * 64) + kso1, dk_ + (b) * F_SHM_K + 8192); } while (0)
#define DMA_V(t, b) do { glds16(Vh + (size_t)(t) * KVBLK + vso, dv_ + (b) * F_SHM_V); } while (0)
#define VMW() asm volatile("s_waitcnt vmcnt(0)" ::: "memory")
    f32x16 p0, p1; v8i pa = {};
    { const bf16x8 z = {}; *(bf16x8*)(V_lds + F_SHM_V + tid * 16) = z; }
    const lcp k8_l = (lcp)K_lds + r32 * 64, vp_l = (lcp)V_lds + r32 * 64;
    const unsigned sw = (unsigned)((r32 >> 2) & 3), x0 = ((2u * hi) ^ sw) << 4, x1 = ((2u * hi + 1u) ^ sw) << 4;
    DMA_K(0, 0); VMW();
    ABAR();
    if (half) { DMA_K(1, 1); DMA_V(0, 0); ABAR(); }
    for (int j = 0; j < NT; j += 2) {
        if (!half) { DMA_K(j + 1, 1); DMA_V(j, 0); }
        SBAR(); __builtin_amdgcn_s_setprio(ATT_PRIO_MFMA);
        seg1f(p0, p1, o, q8, pa, k8_l, vp_l + F_SHM_V, x0, x1);
        __builtin_amdgcn_s_setprio(ATT_PRIO_VALU); SBAR();
        if (half) VMW();
        ABAR();
        if (half) { if (j + 2 < NT) DMA_K(j + 2, 0); DMA_V(j + 1, 1); }
        softmax_tile_s<VARF>(p0, p1, m_reg, l_reg, o, al_l, r32, hi, pa);
        if (!half) VMW();
        ABAR();
        if (!half) { if (j + 2 < NT) DMA_K(j + 2, 0); DMA_V(j + 1, 1); }
        SBAR(); __builtin_amdgcn_s_setprio(ATT_PRIO_MFMA);
        seg1f(p0, p1, o, q8, pa, k8_l + F_SHM_K, vp_l, x0, x1);
        __builtin_amdgcn_s_setprio(ATT_PRIO_VALU); SBAR();
        if (half) VMW();
        ABAR();
        if (half) { if (j + 3 < NT) DMA_K(j + 3, 1); if (j + 2 < NT) DMA_V(j + 2, 0); }
        softmax_tile_s<VARF>(p0, p1, m_reg, l_reg, o, al_l, r32, hi, pa);
        if (!half) VMW();
        ABAR();
    }
    SBAR();
#pragma unroll
    for (int d0 = 0; d0 < 4; ++d0) { const lcp b = vp_l + F_SHM_V + d0 * 2048; const u32x4 lo = *(const __attribute__((address_space(3))) u32x4*)(b + x0), hh = *(const __attribute__((address_space(3))) u32x4*)(b + x1);
        const v8i vf = (v8i){(int)lo.x, (int)lo.y, (int)lo.z, (int)lo.w, (int)hh.x, (int)hh.y, (int)hh.z, (int)hh.w}; o[d0] = __builtin_amdgcn_mfma_scale_f32_32x32x64_f8f6f4(pa, vf, o[d0], 0, 0, 0, 0, 0, 0); }
    SBAR();
    if (!half) ABAR();
    if (hi == 0) li_l[r32] = l_reg; asm volatile("s_waitcnt lgkmcnt(0)" ::: "memory");
    float rli[16];
#pragma unroll
    for (int r = 0; r < 16; ++r) rli[r] = __builtin_amdgcn_rcpf(li_l[crow(r, hi)]);
    bf16_t* Ow = O + (qrow0 + wid * QBLK) * 1024 + h * 128;
#pragma unroll
    for (int r = 0; r < 16; ++r) { const int orow = crow(r, hi);
#pragma unroll
        for (int d0 = 0; d0 < 4; ++d0) { if (OB_FP8) ((unsigned char*)O)[((qrow0 + wid * QBLK + orow) * 1024 + h * 128) + d0 * 32 + r32] = (unsigned char)(__builtin_amdgcn_cvt_pk_fp8_f32(o[d0][r] * rli[r] * O8MUL, 0.f, 0, false) & 0xff); else Ow[(long)orow * 1024 + d0 * 32 + r32] = (bf16_t)(cvtpk(o[d0][r] * rli[r], 0.f) & 0xffffu); } }
    asm volatile("s_waitcnt vmcnt(0)" ::: "memory");
    __syncthreads();
#undef DMA_K
#undef DMA_V
#undef VMW
}
constexpr int W_SHM_K = 2 * F_SHM_K, W_SHM_V = 2 * F_SHM_V, W_OFF_V = 0, W_OFF_K = 2 * W_SHM_V, W_OFF_WS = W_OFF_K + 2 * W_SHM_K, W_LDS_BYTES = W_OFF_WS + NW * 64 * 4;
constexpr int X_OFF_V = 0, X_OFF_K = 3 * W_SHM_V, X_OFF_WS = X_OFF_K + 3 * W_SHM_K, X_LDS_BYTES = X_OFF_WS + NW * 64 * 4;
constexpr int WOPS = 20;
template <int I> __device__ __forceinline__ void seg1w_read(Seg1F& R, lcp k8, lcp vp, unsigned x0, unsigned x1) {
    if constexpr (I < 12) { constexpr int sub = I / 6, c = (I % 6) >> 1, wh = I & 1; const lcp b = k8 + sub * F_SHM_K + c * 4096 + wh * 2048;
        const u32x4 lo = *(const __attribute__((address_space(3))) u32x4*)(b + x0), hh = *(const __attribute__((address_space(3))) u32x4*)(b + x1);
        R.fk[I % FSL] = (v8i){(int)lo.x, (int)lo.y, (int)lo.z, (int)lo.w, (int)hh.x, (int)hh.y, (int)hh.z, (int)hh.w}; }
    else if constexpr (I < WOPS) { constexpr int sub = (I - 12) >> 2, d0 = (I - 12) & 3; const lcp b = vp + sub * F_SHM_V + d0 * 2048;
        const u32x4 lo = *(const __attribute__((address_space(3))) u32x4*)(b + x0), hh = *(const __attribute__((address_space(3))) u32x4*)(b + x1);
        R.fk[I % FSL] = (v8i){(int)lo.x, (int)lo.y, (int)lo.z, (int)lo.w, (int)hh.x, (int)hh.y, (int)hh.z, (int)hh.w}; }
}
template <int I> __device__ __forceinline__ void seg1w_mfma(Seg1F& R, f32x16 (&s)[4], f32x16* o, const v8i (&q8)[3], const v8i (&pa)[2]) {
    if constexpr (I < 12) { constexpr int sub = I / 6, c = (I % 6) >> 1, wh = I & 1;
        if constexpr (c == 0) asm volatile("v_mfma_f32_32x32x64_f8f6f4 %0, %1, %2, 0" : "=v"(s[2 * sub + wh]) : "v"(R.fk[I % FSL]), "v"(q8[0]));
        else asm volatile("v_mfma_f32_32x32x64_f8f6f4 %0, %1, %2, %0" : "+v"(s[2 * sub + wh]) : "v"(R.fk[I % FSL]), "v"(q8[c])); }
    else { constexpr int sub = (I - 12) >> 2, d0 = (I - 12) & 3; asm volatile("v_mfma_f32_32x32x64_f8f6f4 %0, %1, %2, %0" : "+v"(o[d0]) : "v"(pa[sub]), "v"(R.fk[I % FSL])); }
}
template <int I> __device__ __forceinline__ void seg1w_steps(Seg1F& R, f32x16 (&s)[4], f32x16* o, const v8i (&q8)[3], const v8i (&pa)[2], lcp k8, lcp vp, unsigned x0, unsigned x1) {
    if constexpr (I < WOPS) {
        if constexpr (I + FD < WOPS) seg1w_read<I + FD>(R, k8, vp, x0, x1);
        seg1w_mfma<I>(R, s, o, q8, pa);
        SBAR();
        seg1w_steps<I + 1>(R, s, o, q8, pa, k8, vp, x0, x1);
    }
}
__device__ __forceinline__ void seg1w(f32x16 (&s)[4], f32x16* o, const v8i (&q8)[3], const v8i (&pa)[2], lcp k8, lcp vp, unsigned x0, unsigned x1) {
    Seg1F R;
    seg1w_read<0>(R, k8, vp, x0, x1); if constexpr (FD > 1) seg1w_read<1>(R, k8, vp, x0, x1); if constexpr (FD > 2) seg1w_read<2>(R, k8, vp, x0, x1); if constexpr (FD > 3) seg1w_read<3>(R, k8, vp, x0, x1); if constexpr (FD > 4) seg1w_read<4>(R, k8, vp, x0, x1); if constexpr (FD > 5) seg1w_read<5>(R, k8, vp, x0, x1);
    SBAR();
    seg1w_steps<0>(R, s, o, q8, pa, k8, vp, x0, x1);
}
typedef short v2s_t __attribute__((ext_vector_type(2)));
__device__ __forceinline__ int cvt4_scale(float a, float b, float c, float d, float scale) {
    v2s_t x = {0, 0}; x = __builtin_amdgcn_cvt_scalef32_pk_fp8_f32(x, a, b, scale, false); x = __builtin_amdgcn_cvt_scalef32_pk_fp8_f32(x, c, d, scale, true);
    return __builtin_bit_cast(int, x); }
__device__ __forceinline__ void softmax_tile_w(f32x16 (&s)[4], float& m_reg, float& l_reg, f32x16* o, float* al_l, int r32, int hi, v8i (&pa)[2]) {
    float pm0 = fmaxf(s[0][0], s[0][1]), pm1 = fmaxf(s[0][2], s[0][3]);
#pragma unroll
    for (int r = 4; r < 16; r += 2) { pm0 = fmaxf(pm0, s[0][r]); pm1 = fmaxf(pm1, s[0][r + 1]); }
#pragma unroll
    for (int v = 1; v < 4; ++v)
#pragma unroll
        for (int r = 0; r < 16; r += 2) { pm0 = fmaxf(pm0, s[v][r]); pm1 = fmaxf(pm1, s[v][r + 1]); }
    float pmax = fmaxf(pm0, pm1);
    { auto rr = __builtin_amdgcn_permlane32_swap(__float_as_uint(pmax), __float_as_uint(pmax), false, false); pmax = fmaxf(__uint_as_float(rr[0]), __uint_as_float(rr[1])); }
    float alpha = 1.f;
    if (!__builtin_expect(__all(pmax - m_reg <= THRL8), 1)) { const float mn = fmaxf(m_reg, __builtin_ceilf(pmax)); alpha = __builtin_amdgcn_exp2f(m_reg - mn); m_reg = mn; }
    float M = m_reg;
    if (!__builtin_expect(__all(fabsf(M) <= 90.f), 1)) {
#pragma unroll
        for (int v = 0; v < 4; ++v)
#pragma unroll
            for (int r = 0; r < 16; ++r) s[v][r] -= M;
        M = 0.f; }
    const int Mi = (int)M; const float scale = __uint_as_float((unsigned)(Mi + 127) << 23), iscale = __uint_as_float((unsigned)(127 - Mi) << 23);
#pragma unroll
    for (int v = 0; v < 4; ++v)
#pragma unroll
        for (int r = 0; r < 16; ++r) s[v][r] = __builtin_amdgcn_exp2f(s[v][r]);
    float s0 = 0.f, s1 = 0.f, s2 = 0.f, s3 = 0.f;
#pragma unroll
    for (int v = 0; v < 4; ++v)
#pragma unroll
        for (int r = 0; r < 16; r += 4) { s0 += s[v][r]; s1 += s[v][r + 1]; s2 += s[v][r + 2]; s3 += s[v][r + 3]; }
    float ps = ((s0 + s1) + (s2 + s3)) * iscale;
#pragma unroll
    for (int sub = 0; sub < 2; ++sub)
#pragma unroll
        for (int j = 0; j < 4; ++j) { const f32x16& a = s[2 * sub]; const f32x16& b = s[2 * sub + 1];
            pa[sub][j] = cvt4_scale(a[4 * j], a[4 * j + 1], a[4 * j + 2], a[4 * j + 3], scale); pa[sub][4 + j] = cvt4_scale(b[4 * j], b[4 * j + 1], b[4 * j + 2], b[4 * j + 3], scale); }
    { auto rr = __builtin_amdgcn_permlane32_swap(__float_as_uint(ps), __float_as_uint(ps), false, false); ps = __uint_as_float(rr[0]) + __uint_as_float(rr[1]); }
    l_reg = l_reg * alpha + ps;
    if (__any(alpha < 1.f)) { if (hi == 0) al_l[r32] = alpha; asm volatile("s_nop 15\n\ts_nop 15\n\ts_waitcnt lgkmcnt(0)" ::: "memory");
#pragma unroll
        for (int d = 0; d < 4; ++d)
#pragma unroll
            for (int r = 0; r < 16; ++r) o[d][r] *= al_l[crow(r, hi)]; }
}
__device__ __forceinline__ void attn_unit_f8w(const unsigned char* __restrict__ Qn8, const unsigned char* __restrict__ Qr8, const unsigned char* __restrict__ Kn8, const unsigned char* __restrict__ KR8, const unsigned char* __restrict__ VT8,
                                              bf16_t* __restrict__ O, long qrow0, long krow0, int h, int seq, LAS unsigned char* ldsl) {
    char* lds = (char*)ldsl;
    const int tid = threadIdx.x, wid = __builtin_amdgcn_readfirstlane(tid >> 6), lane = tid & 63, r32 = lane & 31, hi = lane >> 5;
    const int half = wid >> 2;
    char* V_lds = lds + X_OFF_V; char* K_lds = lds + X_OFF_K;
    float* ws = (float*)(lds + X_OFF_WS) + wid * 64; float* li_l = ws; float* al_l = ws + 32;
    float m_reg = -1e30f, l_reg = 0; f32x16 o[4] = {}; v8i q8[3];
    { const unsigned char* qn = Qn8 + (qrow0 + wid * QBLK + r32) * 1024 + h * 128 + hi * 32; const unsigned char* qp = Qr8 + (qrow0 + wid * QBLK + r32) * 512 + h * 64 + hi * 32;
#pragma unroll
      for (int c = 0; c < 3; ++c) { const unsigned char* s = c < 2 ? qn + c * 64 : qp; const u32x4 lo = *(const u32x4*)s, hh = *(const u32x4*)(s + 16);
          q8[c] = (v8i){(int)lo.x, (int)lo.y, (int)lo.z, (int)lo.w, (int)hh.x, (int)hh.y, (int)hh.z, (int)hh.w}; }
#pragma unroll
      for (int c = 0; c < 3; ++c) asm volatile("" :: "v"(q8[c]));
    }
    const unsigned char* Kh = Kn8 + krow0 * 1024 + h * 128; const unsigned char* Vh = VT8 + ((size_t)(krow0 >> 13) * 1024 + h * 128) * 8192; const unsigned char* Rh = KR8 + krow0 * 64;
    unsigned kso0, kso1, vso;
    { const int key = 16 * (wid & 3) + (lane >> 2), pc = lane & 3, lc = pc ^ ((key >> 2) & 3); kso0 = (unsigned)(key * 1024 + (wid >> 2) * 64 + lc * 16); kso1 = (unsigned)(key * 64 + lc * 16); }
    { const int d = 16 * wid + (lane >> 2), pc = lane & 3, lc = pc ^ ((d >> 2) & 3); vso = (unsigned)(d * 8192 + lc * 16); }
    const int NT = seq / (2 * KVBLK);
    const unsigned lds0 = (unsigned)(uintptr_t)ldsl;
    const unsigned dr_ = (unsigned)__builtin_amdgcn_readfirstlane((int)(lds0 + X_OFF_K + 8192 + (wid & 3) * 1024));
    const unsigned dk_ = (unsigned)__builtin_amdgcn_readfirstlane((int)(lds0 + X_OFF_K + wid * 1024)), dv_ = (unsigned)__builtin_amdgcn_readfirstlane((int)(lds0 + X_OFF_V + wid * 1024));
#define DMA_K(t, sl) do { _Pragma("unroll") for (int sb_ = 0; sb_ < 2; ++sb_) { glds16s((const char*)Kh + (size_t)(2 * (t) + sb_) * (KVBLK * 1024), kso0, dk_ + (sl) * W_SHM_K + sb_ * F_SHM_K); if ((wid >> 2) == sb_) glds16s((const char*)Rh + (size_t)(2 * (t) + sb_) * (KVBLK * 64), kso1, dr_ + (sl) * W_SHM_K + sb_ * F_SHM_K); } } while (0)
#define DMA_V(t, sl) do { _Pragma("unroll") for (int sb_ = 0; sb_ < 2; ++sb_) glds16s((const char*)Vh + (size_t)(2 * (t) + sb_) * KVBLK, vso, dv_ + (sl) * W_SHM_V + sb_ * F_SHM_V); } while (0)
    f32x16 s[4]; v8i pa[2] = {};
    { const bf16x8 z = {}; *(bf16x8*)(V_lds + 2 * W_SHM_V + tid * 32) = z; *(bf16x8*)(V_lds + 2 * W_SHM_V + tid * 32 + 16) = z; }
    const lcp k8_l = (lcp)K_lds + r32 * 64, vp_l = (lcp)V_lds + r32 * 64;
    const unsigned sw = (unsigned)((r32 >> 2) & 3), x0 = ((2u * hi) ^ sw) << 4, x1 = ((2u * hi + 1u) ^ sw) << 4;
    DMA_K(0, 0); DMA_K(1, 1); DMA_V(0, 0);
    asm volatile("s_waitcnt vmcnt(0)" ::: "memory");
    ABAR();
    if (half) ABAR();
    const int nkp = 3;
    int ks = 0, vs = 2;
    if (!half) __builtin_amdgcn_s_setprio(1);
    for (int j = 0; j < NT; ++j) {
        SBAR();
        seg1w(s, o, q8, pa, k8_l + ks * W_SHM_K, vp_l + vs * W_SHM_V, x0, x1);
        SBAR();
        if (half) asm volatile("s_waitcnt vmcnt(0)" ::: "memory");
        ABAR();
        { int k2 = ks + 2; k2 = k2 >= 3 ? k2 - 3 : k2; int v2 = vs + 2; v2 = v2 >= 3 ? v2 - 3 : v2;
          const bool ik = j + 2 < NT, iv = j + 1 < NT;
          if (ik) DMA_K(j + 2, k2); if (iv) DMA_V(j + 1, v2);
          softmax_tile_w(s, m_reg, l_reg, o, al_l, r32, hi, pa);
          if (!half) { const int n = (ik ? nkp : 0) + (iv ? 2 : 0);
              if (n == 5) asm volatile("s_waitcnt vmcnt(5)" ::: "memory"); else if (n == 3) asm volatile("s_waitcnt vmcnt(3)" ::: "memory"); else if (n == 2) asm volatile("s_waitcnt vmcnt(2)" ::: "memory"); else asm volatile("s_waitcnt vmcnt(0)" ::: "memory"); } }
        ABAR();
        ks = ks + 1 >= 3 ? 0 : ks + 1; vs = vs + 1 >= 3 ? 0 : vs + 1;
    }
    __builtin_amdgcn_s_setprio(0);
    SBAR();
#pragma unroll
    for (int sub = 0; sub < 2; ++sub)
#pragma unroll
        for (int d0 = 0; d0 < 4; ++d0) { const lcp b = vp_l + vs * W_SHM_V + sub * F_SHM_V + d0 * 2048; const u32x4 lo = *(const __attribute__((address_space(3))) u32x4*)(b + x0), hh = *(const __attribute__((address_space(3))) u32x4*)(b + x1);
            const v8i vf = (v8i){(int)lo.x, (int)lo.y, (int)lo.z, (int)lo.w, (int)hh.x, (int)hh.y, (int)hh.z, (int)hh.w}; o[d0] = __builtin_amdgcn_mfma_scale_f32_32x32x64_f8f6f4(pa[sub], vf, o[d0], 0, 0, 0, 0, 0, 0); }
    SBAR();
    if (!half) ABAR();
    if (hi == 0) li_l[r32] = l_reg; asm volatile("s_waitcnt lgkmcnt(0)" ::: "memory");
    float rli[16];
#pragma unroll
    for (int r = 0; r < 16; ++r) rli[r] = __builtin_amdgcn_rcpf(li_l[crow(r, hi)]);
    bf16_t* Ow = O + (qrow0 + wid * QBLK) * 1024 + h * 128;
#pragma unroll
    for (int r = 0; r < 16; ++r) { const int orow = crow(r, hi);
#pragma unroll
        for (int d0 = 0; d0 < 4; ++d0) { if (OB_FP8) ((unsigned char*)O)[((qrow0 + wid * QBLK + orow) * 1024 + h * 128) + d0 * 32 + r32] = (unsigned char)(__builtin_amdgcn_cvt_pk_fp8_f32(o[d0][r] * rli[r] * O8MUL, 0.f, 0, false) & 0xff); else Ow[(long)orow * 1024 + d0 * 32 + r32] = (bf16_t)(cvtpk(o[d0][r] * rli[r], 0.f) & 0xffffu); } }
    asm volatile("s_waitcnt vmcnt(0)" ::: "memory");
    __syncthreads();
#undef DMA_K
#undef DMA_V
}
#undef ABAR
#undef SBAR
}

constexpr size_t MiB = 1u << 20;
constexpr size_t WS_CTL = 0, CTL_ZERO_BYTES = 1 * MiB;
constexpr size_t WS_WIN = 1 * MiB;
constexpr size_t WS_WA = 11 * MiB, WS_WB = 13 * MiB, WS_WO = 15 * MiB;
constexpr size_t WS_WUQ = 17 * MiB;
constexpr size_t WS_WUKV = 19 * MiB;
constexpr size_t WS_WR = 20 * MiB;
constexpr size_t WS_WS = 21 * MiB;
constexpr size_t WS_COS = 22 * MiB, WS_SIN = 24 * MiB;
constexpr size_t WS_RS = 26 * MiB;
constexpr size_t WS_TOPW = 28 * MiB;
constexpr size_t WS_LIST = 29 * MiB;
constexpr size_t WS_WGU = 45 * MiB;
constexpr size_t WS_WD = 302 * MiB;
constexpr size_t WS_PRE = 431 * MiB;
constexpr size_t WS_H1B = 495 * MiB;
constexpr size_t WS_LOG = 527 * MiB;
constexpr size_t WS_RB = 543 * MiB;
constexpr size_t WS_YA = WS_RB, WS_O = WS_RB + 32 * MiB, WS_M = WS_RB + 64 * MiB, WS_ACT = WS_RB;
constexpr size_t WS_RA = 647 * MiB;
constexpr size_t WS_XB = WS_RA, WS_U = WS_RA + 32 * MiB, WS_VG = WS_RA + 64 * MiB, WS_GA = WS_RA + 96 * MiB, WS_GB = WS_RA + 128 * MiB;
constexpr size_t WS_C3 = WS_RA + 160 * MiB, WS_KR = WS_RA + 184 * MiB, WS_QN = WS_RA + 186 * MiB, WS_QR = WS_RA + 218 * MiB;
constexpr size_t WS_KN = WS_RA + 234 * MiB, WS_VV = WS_RA + 266 * MiB, WS_SG = WS_RA + 298 * MiB;
constexpr size_t WS_YP = WS_RA, WS_YS = WS_RA + 256 * MiB;
constexpr size_t WS_END = WS_RA + 330 * MiB;
static_assert(WS_END <= 1024 * MiB, "d_ws map");
constexpr int CW_CNT = 65536, CNT_STRIDE = 64;
constexpr int CW_BAR = 4096;

constexpr int RING_BYTES = 131072;
constexpr int LDSCTL_OFF = RING_BYTES, MISC_OFF = LDSCTL_OFF + 320;
constexpr int TAB_OFF = RING_BYTES + 512;
constexpr int LDS_BYTES = 147456;

typedef GAS unsigned gu32;
#define RLX_AGENT __ATOMIC_RELAXED, __HIP_MEMORY_SCOPE_AGENT

#define XB_TMO      128
#define XB_XCNT(j)  (256  + 64 * (j))
#define XB_XSUB(j)  (1280 + 64 * (j))
#define XB_XGEN(j)  (2304 + 64 * (j))
#define XB_TOP      3328
#define XB_TOPGEN   3392
#define XCD_BAR_WORDS 3456
#define XB_SPIN_CAP (1u << 22)
__device__ __forceinline__ unsigned xb_ld(unsigned* p)              { return __hip_atomic_load(p, __ATOMIC_RELAXED, __HIP_MEMORY_SCOPE_AGENT); }
__device__ __forceinline__ unsigned xb_add(unsigned* p, unsigned v) { return __hip_atomic_fetch_add(p, v, __ATOMIC_RELAXED, __HIP_MEMORY_SCOPE_AGENT); }
__device__ __forceinline__ unsigned xb_xcc_id() { return (unsigned)__builtin_amdgcn_s_getreg((3 << 11) | 20) & 0xFu; }
#define XB_SPIN(cond, bar) do { unsigned _sp = 0; while (cond) { __builtin_amdgcn_s_sleep(1); \
    if ((++_sp & 255u) == 0u) { if (xb_ld(&(bar)[XB_TMO])) break; if (_sp > XB_SPIN_CAP) { atomicAdd(&(bar)[XB_TMO], 1u); break; } } } } while (0)
struct XcdBarrier { unsigned* bar; unsigned x; volatile LAS unsigned* st; };
__device__ __forceinline__ XcdBarrier xcd_barrier_post(unsigned* bar, volatile LAS unsigned* st) {
    XcdBarrier b; b.bar = bar; b.x = xb_xcc_id(); b.st = st;
    if (threadIdx.x == 0) (void)xb_add(&bar[XB_XCNT(b.x)], 1u);
    return b;
}
__device__ __forceinline__ void xcd_barrier_complete(unsigned* bar, unsigned x, unsigned& nloc, unsigned& nx) {
    const unsigned G = gridDim.x * gridDim.y * gridDim.z;
    unsigned sum, cnt, mine, sp = 0u;
    for (;;) {
        sum = 0u; cnt = 0u; mine = 0u;
#pragma unroll
        for (unsigned j = 0; j < 16; ++j) { const unsigned c = xb_ld(&bar[XB_XCNT(j)]); sum += c; cnt += (c > 0u) ? 1u : 0u; mine = (j == x) ? c : mine; }
        if (sum == G) break;
        __builtin_amdgcn_s_sleep(1);
        if ((++sp & 255u) == 0u) { if (xb_ld(&bar[XB_TMO])) break; if (sp > XB_SPIN_CAP) { atomicAdd(&bar[XB_TMO], 1u); break; } }
    }
    nloc = mine > 0u ? mine : 1u; nx = cnt > 0u ? cnt : 1u;
}
__device__ __forceinline__ void xcd_barrier(const XcdBarrier& b) {
    asm volatile("s_waitcnt vmcnt(0)" ::: "memory");
    __syncthreads();
    if (threadIdx.x == 0) {
        unsigned* bar = b.bar;
        __builtin_amdgcn_s_waitcnt(0);
        unsigned nloc = b.st[0], nx = b.st[1];
        if (nloc == 0u) { xcd_barrier_complete(bar, b.x, nloc, nx); b.st[0] = nloc; b.st[1] = nx; }
        const unsigned old = xb_add(&bar[XB_XSUB(b.x)], 1u);
        const unsigned gen = old / nloc;
        if (old + 1u == (gen + 1u) * nloc) {
            __builtin_amdgcn_fence(__ATOMIC_RELEASE, "agent");
            asm volatile("s_waitcnt vmcnt(0)" ::: "memory");
            const unsigned og = xb_add(&bar[XB_TOP], 1u);
            const unsigned tg = og / nx;
            if (og + 1u == (tg + 1u) * nx) xb_add(&bar[XB_TOPGEN], 1u);
            else XB_SPIN(xb_ld(&bar[XB_TOPGEN]) == tg, bar);
            __builtin_amdgcn_fence(__ATOMIC_ACQUIRE, "agent");
            xb_add(&bar[XB_XGEN(b.x)], 1u);
            asm volatile("s_waitcnt vmcnt(0)" ::: "memory");
        } else {
            XB_SPIN(xb_ld(&bar[XB_XGEN(b.x)]) == gen, bar);
            __builtin_amdgcn_fence(__ATOMIC_ACQUIRE, "agent");
            asm volatile("s_waitcnt vmcnt(0)" ::: "memory");
        }
    }
    __syncthreads();
}

__device__ __forceinline__ float wave_sum(float v) {
#pragma unroll
    for (int o = 1; o < 64; o <<= 1) v += __shfl_xor(v, o);
    return v;
}
__device__ __forceinline__ float half_max(float v) {
#pragma unroll
    for (int o = 1; o < 32; o <<= 1) v = fmaxf(v, __shfl_xor(v, o));
    return v;
}
__device__ __forceinline__ int half_min_i(int v) {
#pragma unroll
    for (int o = 1; o < 32; o <<= 1) { const int w = __shfl_xor(v, o); v = w < v ? w : v; }
    return v;
}
__device__ __forceinline__ void tr_item(const float* W, size_t ldw, int k0, int sc, bf16_t* D, size_t ldd, int n0, const float* kscale, LAS float* scr, int lane) {
    { const float* wp = W + (size_t)(k0 + (lane >> 5)) * ldw + (sc >= 0 ? sc : 0); float v[32];
#pragma unroll
      for (int i = 0; i < 32; ++i) v[i] = wp[(size_t)(2 * i) * ldw];
#pragma unroll
      for (int i = 0; i < 32; ++i) { const int kk = 2 * i + (lane >> 5); float t = sc >= 0 ? v[i] : 0.f; if (kscale) t *= kscale[k0 + kk]; scr[kk * 33 + (lane & 31)] = t; } }
    asm volatile("s_waitcnt lgkmcnt(0)" ::: "memory");
    const int c = lane & 7;
#pragma unroll
    for (int j = 0; j < 4; ++j) { const int n = (lane >> 3) + 8 * j; const LAS float* s = scr + (8 * c) * 33 + n;
        u32x4 o; o.x = cvt_pk_bf16(s[0 * 33], s[1 * 33]); o.y = cvt_pk_bf16(s[2 * 33], s[3 * 33]); o.z = cvt_pk_bf16(s[4 * 33], s[5 * 33]); o.w = cvt_pk_bf16(s[6 * 33], s[7 * 33]);
        *(u32x4*)(D + (size_t)(n0 + n) * ldd + k0 + 8 * c) = o; }
    asm volatile("s_waitcnt lgkmcnt(0)" ::: "memory");
}
__device__ __forceinline__ void tr_item8(const float* W, size_t ldw, int k0, int sc, unsigned char* D, size_t ldd, int n0, float mul, LAS float* scr, int lane) {
    { const float* wp = W + (size_t)(k0 + (lane >> 5)) * ldw + sc; float v[32];
#pragma unroll
      for (int i = 0; i < 32; ++i) v[i] = wp[(size_t)(2 * i) * ldw];
#pragma unroll
      for (int i = 0; i < 32; ++i) { const int kk = 2 * i + (lane >> 5); scr[kk * 33 + (lane & 31)] = v[i] * mul; } }
    asm volatile("s_waitcnt lgkmcnt(0)" ::: "memory");
    const int c = lane & 7;
#pragma unroll
    for (int j = 0; j < 4; ++j) { const int n = (lane >> 3) + 8 * j; const LAS float* s = scr + (8 * c) * 33 + n;
        int a = __builtin_amdgcn_cvt_pk_fp8_f32(s[0 * 33], s[1 * 33], 0, false); a = __builtin_amdgcn_cvt_pk_fp8_f32(s[2 * 33], s[3 * 33], a, true);
        int b = __builtin_amdgcn_cvt_pk_fp8_f32(s[4 * 33], s[5 * 33], 0, false); b = __builtin_amdgcn_cvt_pk_fp8_f32(s[6 * 33], s[7 * 33], b, true);
        u32x2 o; o.x = (unsigned)a; o.y = (unsigned)b; *(u32x2*)(D + (size_t)(n0 + n) * ldd + k0 + 8 * c) = o; }
    asm volatile("s_waitcnt lgkmcnt(0)" ::: "memory");
}
__device__ __forceinline__ void tr_item8w(const float* W, size_t ldw, int k0, int sc4, unsigned char* D, size_t ldd, int n0, float mul, LAS float* scr, int lane) {
    { const float* wp = W + (size_t)(k0 + (lane >> 3)) * ldw + sc4; f32x4 v[16];
#pragma unroll
      for (int i = 0; i < 16; ++i) v[i] = *(const f32x4*)(wp + (size_t)(8 * i) * ldw);
#pragma unroll
      for (int i = 0; i < 16; ++i) { const int kk = 8 * i + (lane >> 3); *(LAS f32x4*)(scr + kk * 32 + ((4 * (lane & 7)) ^ ((kk >> 4) << 2))) = v[i] * mul; } }
    asm volatile("s_waitcnt lgkmcnt(0)" ::: "memory");
    const int c = lane & 7;
#pragma unroll
    for (int j = 0; j < 4; ++j) { const int n = (lane >> 3) + 8 * j; const LAS float* s = scr + (16 * c) * 32 + (n ^ (c << 2));
        u32x4 o;
#pragma unroll
        for (int q = 0; q < 4; ++q) { int a = __builtin_amdgcn_cvt_pk_fp8_f32(s[(4 * q) * 32], s[(4 * q + 1) * 32], 0, false); a = __builtin_amdgcn_cvt_pk_fp8_f32(s[(4 * q + 2) * 32], s[(4 * q + 3) * 32], a, true); o[q] = (unsigned)a; }
        *(u32x4*)(D + (size_t)(n0 + n) * ldd + k0 + 16 * c) = o; }
    asm volatile("s_waitcnt lgkmcnt(0)" ::: "memory");
}
__device__ __forceinline__ int map_in(int n) { if (n < 2688) return n; if (n < 2752) return 2688 + rope_orig(n - 2688); if (n < 2816) return -1; return n - 64; }
__device__ __forceinline__ int map_in2(int n) { if (n < 2048) return n; if (n < 3072) return 2752 + (n - 2048); const int m = n - 3072; if (m < 768) return map_in(2048 + m); return 3776 + (m - 768); }
__device__ __forceinline__ int map_q(int n) { if (n < 1024) return (n >> 7) * 192 + (n & 127); const int q = n - 1024; return (q >> 6) * 192 + 128 + rope_orig(q & 63); }

struct Args { const void* in[27]; float* out; unsigned char* ws; int ph_lo, ph_hi, li, pad; };
constexpr int PER_PHASE = 12;
constexpr int N_LAUNCHES = MK_N_LAUNCHES;

#define WinT ((bf16_t*)(ws + WS_WIN))
#define WaT ((bf16_t*)(ws + WS_WA))
#define WbT ((bf16_t*)(ws + WS_WB))
#define WoT ((bf16_t*)(ws + WS_WO))
#define WuqT ((bf16_t*)(ws + WS_WUQ))
#define WukvT ((bf16_t*)(ws + WS_WUKV))
#define WrT ((bf16_t*)(ws + WS_WR))
#define WsB ((bf16_t*)(ws + WS_WS))
#define COS ((float*)(ws + WS_COS))
#define SIN ((float*)(ws + WS_SIN))
#define RS ((float*)(ws + WS_RS))
#define TOPW ((float*)(ws + WS_TOPW))
#define LIST ((int*)(ws + WS_LIST))
#define WguT ((bf16_t*)(ws + WS_WGU))
#define WdT ((bf16_t*)(ws + WS_WD))
#define PRE ((float*)(ws + WS_PRE))
#define H1b ((bf16_t*)(ws + WS_H1B))
#define LOG ((float*)(ws + WS_LOG))
#define YA ((bf16_t*)(ws + WS_YA))
#define Ob ((bf16_t*)(ws + WS_O))
#define Mb ((bf16_t*)(ws + WS_M))
#define ACT ((bf16_t*)(ws + WS_ACT))
#define Xb ((bf16_t*)(ws + WS_XB))
#define U ((bf16_t*)(ws + WS_U))
#define Vg ((bf16_t*)(ws + WS_VG))
#define GA ((bf16_t*)(ws + WS_GA))
#define GB ((bf16_t*)(ws + WS_GB))
#define C3 ((bf16_t*)(ws + WS_C3))
#define KR ((bf16_t*)(ws + WS_KR))
#define Qn ((bf16_t*)(ws + WS_QN))
#define Qr ((bf16_t*)(ws + WS_QR))
#define Kn ((bf16_t*)(ws + WS_KN))
#define Vv ((bf16_t*)(ws + WS_VV))
#define Sg ((bf16_t*)(ws + WS_SG))
#define YP ((bf16_t*)(ws + WS_YP))
#define YS ((bf16_t*)(ws + WS_YS))
#define CNT ((int*)(ws + WS_CTL))
#define CNT ((int*)(ws + WS_CTL) + CW_CNT)
__global__ void __launch_bounds__(NWAVES * 64, 2) mega_fwd(Args args) {
    extern __shared__ __attribute__((aligned(16))) unsigned char lds[];
    LAS unsigned char* ldsa = (LAS unsigned char*)lds;
    volatile LAS unsigned* MISC = (volatile LAS unsigned*)(ldsa + MISC_OFF);
    const int tid = threadIdx.x, lane = tid & 63, wave = __builtin_amdgcn_readfirstlane(tid >> 6);
    const int G = gridDim.x; const int bx = blockIdx.x; const int vcu = (G % 8 == 0) ? (bx % 8) * (G / 8) + bx / 8 : bx;
    const int gw = vcu * NWAVES + wave, NGW = G * NWAVES;
    unsigned char* ws = args.ws;
    gu32* ctl = (gu32*)(ws + WS_CTL);
    const __attribute__((address_space(4))) char* const kp0 = (const __attribute__((address_space(4))) char*)__builtin_amdgcn_kernarg_segment_ptr();
#define KARG(TYPE, NAME, i) const __attribute__((address_space(4))) char* kp_##NAME = kp0; asm volatile("" : "+s"(kp_##NAME)); TYPE NAME = (TYPE)(*(void* const __attribute__((address_space(4)))*)(kp_##NAME + 8 * (i)))
    for (int u = tid; u < (LDS_BYTES - LDSCTL_OFF) / 4; u += NWAVES * 64) ((LAS unsigned*)(ldsa + LDSCTL_OFF))[u] = 0u;
    __syncthreads();
    XcdBarrier bar; bar.bar = (unsigned*)(ctl + CW_BAR); bar.x = 0; bar.st = nullptr;
    if (N_LAUNCHES != PER_PHASE) bar = xcd_barrier_post((unsigned*)(ctl + CW_BAR), MISC + 8);
#define GRID_BAR() do { if (N_LAUNCHES != PER_PHASE) xcd_barrier(bar); } while (0)
    const int lo = args.ph_lo, hi = args.ph_hi;
#ifndef PH_MASK
#define PH_MASK 0xFFF
#endif
#ifndef REP_MASK
#define REP_MASK 0
#endif
#define IN(k) (((PH_MASK >> (k)) & 1) && lo <= (k) && (k) < hi)
#define REPF(k) ((((REP_MASK) >> (k)) & 1) ? 2 : 1)
#define REPS(k) for (int rep_ = 0; rep_ < (((REP_MASK >> (k)) & 1) ? 2 : 1); ++rep_)
#define BOTH(k) (IN(k) && IN((k) + 1))

    if (IN(0)) REPS(0) {
        KARG(const float*, x, 0); KARG(const int*, positions, 1); KARG(const float*, w_in, 2); KARG(const float*, w_spatial, 5); KARG(const float*, w_a_proj, 7); KARG(const float*, q_norm_g, 8); KARG(const float*, w_uq, 9); KARG(const float*, kv_norm_g, 10);
        KARG(const float*, w_uk, 11); KARG(const float*, w_uv, 12); KARG(const float*, w_b_proj, 13); KARG(const float*, w_out, 14); KARG(const float*, w_router, 17); KARG(const float*, w_gate, 19); KARG(const float*, w_up, 20); KARG(const float*, w_down, 21);
        KARG(const float*, w_sh_gate, 22); KARG(const float*, w_sh_up, 23); KARG(const float*, w_sh_down, 24);
        LAS float* scr = (LAS float*)(ldsa + wave * 16384);
        constexpr int I_IN = 16 * (IN_PAD / 32), I_SQ = 16 * 32, I_UQ = 6 * 48, I_UKV = 4 * 32, I_R = 16 * 8, I_GU1 = MOE_FP8 ? 16 * 8 : 16 * 16, I_D1 = MOE_FP8 ? 2 * 32 : 4 * 32;
        constexpr int I_GU = NE * I_GU1, I_D = NE * I_D1;
        constexpr int NITEMS = I_IN + 3 * I_SQ + I_UQ + 2 * I_UKV + I_R + I_GU + I_D + I_GU1 + I_D1;
        for (int it = gw; it < NITEMS; it += NGW) {
            int r = it; const int l31 = lane & 31;
            if (r < I_IN) { const int nb = r % (IN_PAD / 32), kb = r / (IN_PAD / 32);
                if (!INP_FP8) tr_item(w_in, IN_TOTAL, 64 * kb, map_in(32 * nb + l31), WinT, 1024, 32 * nb, nullptr, scr, lane);
                else if (32 * nb < 3072) tr_item(w_in, IN_TOTAL, 64 * kb, map_in2(32 * nb + l31), WinT, 1024, 32 * nb, nullptr, scr, lane);
                else { const int sc_ = map_in2(32 * nb + l31); const bool zr_ = sc_ < 0; tr_item8(w_in, IN_TOTAL, 64 * kb, zr_ ? 0 : sc_, (unsigned char*)WinT + (size_t)3072 * 2048, 1024, 32 * nb - 3072, zr_ ? 0.f : W8MUL, scr, lane); }
                continue; } r -= I_IN;
            if (r < 3 * I_SQ) { const int which = r / I_SQ; r -= which * I_SQ; const int nb = r % 32, kb = r / 32; const float* W = which == 0 ? w_a_proj : which == 1 ? w_b_proj : w_out; bf16_t* Dd = which == 0 ? WaT : which == 1 ? WbT : WoT;
                if (OB_FP8 && which == 1) tr_item8(W, 1024, 64 * kb, 32 * nb + l31, (unsigned char*)Dd, 1024, 32 * nb, W8MUL, scr, lane); else tr_item(W, 1024, 64 * kb, 32 * nb + l31, Dd, 1024, 32 * nb, nullptr, scr, lane); continue; } r -= 3 * I_SQ;
            if (r < I_UQ) { const int nb = r % 48, kb = r / 48; tr_item(w_uq, 1536, 64 * kb, map_q(32 * nb + l31), WuqT, QLORA, 32 * nb, q_norm_g, scr, lane); continue; } r -= I_UQ;
            if (r < 2 * I_UKV) { const int which = r / I_UKV; r -= which * I_UKV; const int nb = r % 32, kb = r / 32; tr_item(which ? w_uv : w_uk, 1024, 64 * kb, 32 * nb + l31, WukvT + (size_t)which * 1024 * KVLORA, KVLORA, 32 * nb, kv_norm_g, scr, lane); continue; } r -= 2 * I_UKV;
            if (r < I_R) { const int nb = r % 8, kb = r / 8; tr_item(w_router, 256, 64 * kb, 32 * nb + l31, WrT, 1024, 32 * nb, nullptr, scr, lane); continue; } r -= I_R;
            if (r < I_GU + I_GU1) { const int e = r / I_GU1; r -= e * I_GU1; const int nb = r % 16, kb = r / 16; const int n = 32 * nb + l31; const int bj = (n >> 7) & 1, pn = n >> 8, j = n & 127;
                const float* W = e < NE ? ((bj ? w_up : w_gate) + (size_t)e * DM * DE) : (bj ? w_sh_up : w_sh_gate);
                if (MOE_FP8) tr_item8w(W, DE, 128 * kb, 128 * pn + ((32 * nb) & 127) + 4 * (lane & 7), (unsigned char*)WguT + (size_t)e * 512 * DM, DM, 32 * nb, W8MUL, scr, lane); else tr_item(W, DE, 64 * kb, 128 * pn + j, WguT + (size_t)e * 512 * DM, DM, 32 * nb, nullptr, scr, lane); continue; } r -= I_GU + I_GU1;
            { const int e = r / I_D1; r -= e * I_D1; const int nb = r % 32, kb = r / 32; const float* W = e < NE ? (w_down + (size_t)e * DE * DM) : w_sh_down;
                if (MOE_FP8) tr_item8w(W, DM, 128 * kb, 32 * nb + 4 * (lane & 7), (unsigned char*)WdT + (size_t)e * DM * DE, DE, 32 * nb, W8MUL, scr, lane); else tr_item(W, DM, 64 * kb, 32 * nb + l31, WdT + (size_t)e * DM * DE, DE, 32 * nb, nullptr, scr, lane); }
        }
        for (size_t i = (size_t)bx * 512 + tid; i < (size_t)T * DM / 8; i += (size_t)G * 512) { const f32x4 a = *(const f32x4*)(x + i * 8), b = *(const f32x4*)(x + i * 8 + 4); *(u32x4*)(Xb + i * 8) = pg8::pack8(a, b);
            if (INP_FP8) *(u32x2*)((unsigned char*)LOG + i * 8) = pack8_fp8(a, b); }
        for (int i = bx * 512 + tid; i < 8 * 128 * 128 / 8; i += G * 512) { const f32x4 a = *(const f32x4*)(w_spatial + (size_t)i * 8), b = *(const f32x4*)(w_spatial + (size_t)i * 8 + 4); *(u32x4*)(WsB + (size_t)i * 8) = pg8::pack8(a, b); }
        for (int i = bx * 512 + tid; i < T * 32; i += G * 512) { const int t = i >> 5, j = i & 31; const float freq = powf(10000.0f, -(float)j * (1.0f / 32.0f)); const float ang = (float)positions[t] * freq;
            float sv_, cv_; sincosf(ang, &sv_, &cv_); COS[i] = cv_; SIN[i] = sv_; }
        if (BOTH(0)) GRID_BAR();
    }

    if (IN(1)) {
        if (!INP_FP8) { pg8::DenseSched S; S.init(Xb, DM, WinT, DM, T, IN_PAD, G, bx, REPF(1));
          pg8::EpiInProj E{U, Vg, C3, KR, GA, GB, RS, COS, SIN, 0, 1.0f};
          pg8::gemm_phase<pg8::EpiInProj, pg8::DenseSched, true>(ldsa, DM, DM, DM, S, E); }
        else {
          { pg8::DenseSched S; S.init(Xb, DM, WinT, DM, T, 3072, G, bx, REPF(1));
            pg8::EpiInProj E{U, Vg, C3, KR, GA, GB, RS, COS, SIN, 1, 1.0f};
            pg8::gemm_phase<pg8::EpiInProj, pg8::DenseSched, true>(ldsa, DM, DM, DM, S, E); }
          { pg8::DenseSched S; S.init(LOG, DM / 2, (const unsigned char*)WinT + (size_t)3072 * 2048, DM / 2, T, 1792, G, bx, REPF(1));
            pg8::EpiInProj E{U, Vg, C3, KR, GA, GB, RS, COS, SIN, 2, 1.0f / W8MUL};
            pg8::gemm_phase<pg8::EpiInProj, pg8::DenseSched, true, true>(ldsa, DM / 2, DM / 2, DM / 2, S, E); } }
        if (BOTH(1)) GRID_BAR();
    }

    if (IN(2)) {
        KARG(const float*, gmlp_ln_g, 3); KARG(const float*, gmlp_ln_b, 4); KARG(const float*, b_spatial, 6);
#ifndef NO_P2A
        { pg8::DenseSched S; S.init(C3, 768, WuqT, QLORA, T, 1536, G, bx, REPF(2)); pg8::EpiQ E{Qn, Qr, RS, COS, SIN};
          pg8::gemm_phase<pg8::EpiQ, pg8::DenseSched, true>(ldsa, QLORA, 768, QLORA, S, E); }
#endif
#ifndef NO_P2B
        { pg8::DenseSched S; S.init(C3 + QLORA, 768, WukvT, KVLORA, T, ATT_FP8 ? 1024 : 2048, G, bx, REPF(2)); pg8::EpiKV E{Kn, Vv, RS};
          pg8::gemm_phase<pg8::EpiKV, pg8::DenseSched, true>(ldsa, KVLORA, 768, KVLORA, S, E); }
        if (ATT_FP8) { pg8::DenseSched S; S.init(WukvT + (size_t)1024 * KVLORA, KVLORA, C3 + QLORA, 768, 1024, T, G, bx, REPF(2)); pg8::EpiVT E{(unsigned char*)Vv, RS};
          pg8::gemm_phase<pg8::EpiVT, pg8::DenseSched, true>(ldsa, KVLORA, KVLORA, 768, S, E); }
#endif
#ifndef NO_P2C
        {
            constexpr int LDT = 136;
            LAS bf16_t* Wl = (LAS bf16_t*)ldsa;
            LAS bf16_t* Vl = (LAS bf16_t*)(ldsa + 128 * LDT * 2);
            const int fr = lane & 15, fq = lane >> 4;
            for (int un0 = vcu; un0 < 1024 * REPF(13); un0 += G) { const int un = un0 & 1023;
                const int ch = un >> 3, hg = un & 7;
                for (int i = tid; i < 128 * 16; i += 512) { const int p = i >> 4, c8 = (i & 15) * 8; *(LAS u32x4*)(Wl + p * LDT + c8) = *(const u32x4*)(WsB + (size_t)hg * 16384 + p * 128 + c8); }
                { const int q = tid >> 2, d0 = (tid & 3) * 32; const bf16_t* vp = Vg + (size_t)(ch * 128 + q) * DM + hg * 128 + d0;
                  float v[32];
#pragma unroll
                  for (int j = 0; j < 4; ++j) { const u32x4 w = *(const u32x4*)(vp + j * 8); v[j * 8 + 0] = bf_lo(w.x); v[j * 8 + 1] = bf_hi(w.x); v[j * 8 + 2] = bf_lo(w.y); v[j * 8 + 3] = bf_hi(w.y); v[j * 8 + 4] = bf_lo(w.z); v[j * 8 + 5] = bf_hi(w.z); v[j * 8 + 6] = bf_lo(w.w); v[j * 8 + 7] = bf_hi(w.w); }
                  float s = 0.f;
#pragma unroll
                  for (int j = 0; j < 32; ++j) s += v[j];
                  s += __shfl_xor(s, 1); s += __shfl_xor(s, 2);
                  const float mu = s * (1.0f / 128.0f); float q2 = 0.f;
#pragma unroll
                  for (int j = 0; j < 32; ++j) { v[j] -= mu; q2 += v[j] * v[j]; }
                  q2 += __shfl_xor(q2, 1); q2 += __shfl_xor(q2, 2);
                  const float rstd = 1.0f / sqrtf(q2 * (1.0f / 128.0f) + LN_EPS);
#pragma unroll
                  for (int j = 0; j < 32; ++j) { const float o = v[j] * rstd * gmlp_ln_g[hg * 128 + d0 + j] + gmlp_ln_b[hg * 128 + d0 + j]; Vl[(d0 + j) * LDT + q] = (bf16_t)(cvt_pk_bf16(o, 0.f) & 0xffffu); }
                }
                __syncthreads();
                f32x4 acc[8];
#pragma unroll
                for (int n = 0; n < 8; ++n) acc[n] = (f32x4){0.f, 0.f, 0.f, 0.f};
#pragma unroll
                for (int ks = 0; ks < 4; ++ks) { const bf16x8 b = *(const LAS bf16x8*)(Wl + (16 * wave + fr) * LDT + 32 * ks + 8 * fq);
#pragma unroll
                    for (int n = 0; n < 8; ++n) { const bf16x8 a = *(const LAS bf16x8*)(Vl + (16 * n + fr) * LDT + 32 * ks + 8 * fq); acc[n] = __builtin_amdgcn_mfma_f32_16x16x32_bf16(a, b, acc[n], 0, 0, 0); } }
                { const int p = 16 * wave + fr; const float bsp = b_spatial[hg * 128 + p]; const unsigned ro = (unsigned)(ch * 128 + p) * DM + hg * 128 + 4 * fq;
                  u32x2 uv[8];
#pragma unroll
                  for (int n = 0; n < 8; ++n) uv[n] = *(const u32x2*)(U + ro + 16 * n);
#pragma unroll
                  for (int n = 0; n < 8; ++n) { u32x2 w; w.x = cvt_pk_bf16(bf_lo(uv[n].x) * (acc[n][0] + bsp), bf_hi(uv[n].x) * (acc[n][1] + bsp)); w.y = cvt_pk_bf16(bf_lo(uv[n].y) * (acc[n][2] + bsp), bf_hi(uv[n].y) * (acc[n][3] + bsp));
                      *(u32x2*)(Sg + ro + 16 * n) = w; } }
                __syncthreads();
            }
        }
#endif
        if (BOTH(2)) GRID_BAR();
    }

    if (IN(3)) {
#ifndef NO_P3A
        { pg8::DenseSched S; S.init(Sg, DM, WaT, DM, T, DM, G, bx, REPF(12)); pg8::EpiGate<false> E{YA, GA, nullptr, 1.0f};
          pg8::gemm_phase<pg8::EpiGate<false>, pg8::DenseSched, true>(ldsa, DM, DM, DM, S, E); }
#endif
#ifndef NO_P3B
        for (int i0 = 0; i0 * G + vcu < 512 * REPF(3); ++i0) { const int i = (G == 256) ? (i0 & 1) : i0; const int un = (i0 * G + vcu) & 511; int bh, qb;
            if (G == 256) { bh = i * 8 + (vcu >> 5); qb = vcu & 31; } else { bh = un >> 5; qb = un & 31; }
            const int b = bh >> 3, h = bh & 7;
            if (ATT_FP8 == 3) att::attn_unit_f8w((const unsigned char*)Qn, (const unsigned char*)Qr, (const unsigned char*)Kn, (const unsigned char*)KR, (const unsigned char*)Vv, Ob, (long)b * SEQ + qb * 256, (long)b * SEQ, h, SEQ, ldsa);
            else if (ATT_FP8) att::attn_unit_f8<1>((const unsigned char*)Qn, (const unsigned char*)Qr, (const unsigned char*)Kn, (const unsigned char*)KR, (const unsigned char*)Vv, Ob, (long)b * SEQ + qb * 256, (long)b * SEQ, h, SEQ, ldsa);
            else att::attn_unit<0>(Qn, Qr, Kn, KR, Vv, Ob, (long)b * SEQ + qb * 256, (long)b * SEQ, h, SEQ, ldsa); }
#ifdef ATTF_PROBE
        for (int i = 0; i * G + vcu < 512; ++i) { int bh, qb; const int un = i * G + vcu;
            if (G == 256) { bh = i * 8 + (vcu >> 5); qb = vcu & 31; } else { bh = un >> 5; qb = un & 31; }
            const int b = bh >> 3, h = bh & 7;
            att::attn_unit_f8<ATTF_PROBE>((const unsigned char*)Qn, (const unsigned char*)Qr, (const unsigned char*)Kn, (const unsigned char*)KR, (const unsigned char*)Vv, H1b, (long)b * SEQ + qb * 256, (long)b * SEQ, h, SEQ, ldsa); }
#endif
#ifdef ATT_PROBE
        for (int i = 0; i * G + vcu < 512; ++i) { int bh, qb; const int un = i * G + vcu;
            if (G == 256) { bh = i * 8 + (vcu >> 5); qb = vcu & 31; } else { bh = un >> 5; qb = un & 31; }
            const int b = bh >> 3, h = bh & 7;
            att::attn_unit<ATT_PROBE>(Qn, Qr, Kn, KR, Vv, H1b, (long)b * SEQ + qb * 256, (long)b * SEQ, h, SEQ, ldsa); }
#endif
#endif
        if (BOTH(3)) GRID_BAR();
    }

    if (IN(4)) {
        constexpr int KB = OB_FP8 ? DM / 2 : DM;
        pg8::DenseSched S; S.init(Ob, KB, WbT, KB, T, DM, G, bx, REPF(4)); pg8::EpiGate<true> E{Mb, GB, YA, OB_FP8 ? 1.0f / (W8MUL * O8MUL) : 1.0f};
        pg8::gemm_phase<pg8::EpiGate<true>, pg8::DenseSched, true, OB_FP8 != 0>(ldsa, KB, KB, KB, S, E);
        if (BOTH(4)) GRID_BAR();
    }

    if (IN(5)) {
        KARG(const float*, x, 0);
        pg8::DenseSched S; S.init(Mb, DM, WoT, DM, T, DM, G, bx, REPF(5)); pg8::EpiPre E{PRE, x};
        pg8::gemm_phase<pg8::EpiPre, pg8::DenseSched, true>(ldsa, DM, DM, DM, S, E);
        if (BOTH(5)) GRID_BAR();
    }

    if (IN(6)) {
        KARG(const float*, ln1_g, 15); KARG(const float*, ln1_b, 16); KARG(const float*, router_bias, 18);
        const int half = lane >> 5, l31 = lane & 31, fr = lane & 15, fq = lane >> 4;
        constexpr int LST = 260;
        float rb[4];
#pragma unroll
        for (int j = 0; j < 4; ++j) rb[j] = router_bias[lane + 64 * j];
        for (int grp = vcu; grp < T / 64; grp += G) {
            const int t0 = grp * 64;
#pragma unroll 2
            for (int i = 0; i < 8; ++i) { const int r = 8 * wave + i, m = t0 + r;
                f32x4* xr = (f32x4*)(PRE + (size_t)m * DM) + lane; f32x4 v[4]; float s = 0.f;
#pragma unroll
                for (int j = 0; j < 4; ++j) { v[j] = xr[64 * j]; s += (v[j].x + v[j].y) + (v[j].z + v[j].w); }
                const float mean = wave_sum(s) * (1.f / DM); float s2 = 0.f;
#pragma unroll
                for (int j = 0; j < 4; ++j) { v[j] = v[j] - mean; s2 += (v[j].x * v[j].x + v[j].y * v[j].y) + (v[j].z * v[j].z + v[j].w * v[j].w); }
                const float rstd = 1.f / sqrtf(wave_sum(s2) * (1.f / DM) + LN_EPS);
                u32x2* o8 = (u32x2*)(H1b + (size_t)m * DM) + lane;
#pragma unroll
                for (int j = 0; j < 4; ++j) { const f32x4 g = *((const f32x4*)ln1_g + lane + 64 * j), bb = *((const f32x4*)ln1_b + lane + 64 * j); const f32x4 o = v[j] * rstd * g + bb; xr[64 * j] = o;
                    u32x2 w; w.x = cvt_pk_bf16(o.x, o.y); w.y = cvt_pk_bf16(o.z, o.w);
                    if (MOE_FP8) { int a = __builtin_amdgcn_cvt_pk_fp8_f32(o.x, o.y, 0, false); a = __builtin_amdgcn_cvt_pk_fp8_f32(o.z, o.w, a, true); ((unsigned*)((unsigned char*)H1b + (size_t)m * DM))[lane + 64 * j] = (unsigned)a; } else o8[64 * j] = w;
                    const int chunk = (lane + 64 * j) >> 1; *(LAS u32x2*)(ldsa + r * 2048 + ((chunk ^ (r & 7)) << 4) + (lane & 1) * 8) = w; }
            }
            __syncthreads();
            f32x4 acc[2][4];
#pragma unroll
            for (int eb = 0; eb < 2; ++eb)
#pragma unroll
                for (int tb = 0; tb < 4; ++tb) acc[eb][tb] = (f32x4){0.f, 0.f, 0.f, 0.f};
            const bf16_t* wr0 = WrT + (size_t)(32 * wave + fr) * DM + 8 * fq;
#pragma unroll 4
            for (int ks = 0; ks < 32; ++ks) {
                bf16x8 a[2], b[4];
#pragma unroll
                for (int eb = 0; eb < 2; ++eb) a[eb] = *(const bf16x8*)(wr0 + (size_t)eb * 16 * DM + 32 * ks);
#pragma unroll
                for (int tb = 0; tb < 4; ++tb) { const int r = 16 * tb + fr; b[tb] = *(const LAS bf16x8*)(ldsa + r * 2048 + (((4 * ks + fq) ^ (r & 7)) << 4)); }
#pragma unroll
                for (int eb = 0; eb < 2; ++eb)
#pragma unroll
                    for (int tb = 0; tb < 4; ++tb) acc[eb][tb] = __builtin_amdgcn_mfma_f32_16x16x32_bf16(a[eb], b[tb], acc[eb][tb], 0, 0, 0);
            }
            __syncthreads();
            LAS float* L = (LAS float*)ldsa;
#pragma unroll
            for (int eb = 0; eb < 2; ++eb)
#pragma unroll
                for (int tb = 0; tb < 4; ++tb) *(LAS f32x4*)(L + (16 * tb + fr) * LST + 32 * wave + 16 * eb + 4 * fq) = acc[eb][tb];
            __syncthreads();
            { const int ts = lane >> 3, g = lane & 7, tl = 8 * wave + ts, t = t0 + tl;
              LAS float* Lrow = L + tl * LST + 32 * g; float b[32];
#pragma unroll
              for (int q = 0; q < 8; ++q) { const f32x4 lg = *(LAS f32x4*)(Lrow + 4 * q); const f32x4 bi = *(const f32x4*)(router_bias + 32 * g + 4 * q); f32x4 s;
#pragma unroll
                  for (int c = 0; c < 4; ++c) { s[c] = 1.0f / (1.0f + expf(-lg[c])); b[4 * q + c] = s[c] + bi[c]; }
                  *(LAS f32x4*)(Lrow + 4 * q) = s; }
              float m1 = -INFINITY, m2 = -INFINITY;
#pragma unroll
              for (int i = 0; i < 32; ++i) { const float x = b[i]; const bool gt = x > m1; m2 = gt ? m1 : fmaxf(m2, x); m1 = gt ? x : m1; }
              const float gsum = m1 + m2; int rank = 0;
#pragma unroll
              for (int k = 0; k < 8; ++k) { const float o = __shfl(gsum, (lane & ~7) + k); rank += (o > gsum || (o == gsum && k < g)) ? 1 : 0; }
              const bool sel = rank < 4;
              float lv[8]; int li[8];
#pragma unroll
              for (int p = 0; p < 8; ++p) { float bv = -INFINITY; int bi = 0;
#pragma unroll
                  for (int i = 0; i < 32; ++i) if (b[i] > bv) { bv = b[i]; bi = i; }
                  lv[p] = sel ? bv : -INFINITY; li[p] = 32 * g + bi;
#pragma unroll
                  for (int i = 0; i < 32; ++i) b[i] = (i == bi) ? -INFINITY : b[i]; }
              int mye = 0;
#pragma unroll
              for (int k = 0; k < TOPK; ++k) { float v = lv[0]; int e = li[0];
#pragma unroll
                  for (int off = 1; off < 8; off <<= 1) { const float ov = __shfl_xor(v, off); const int oe = __shfl_xor(e, off); if (ov > v || (ov == v && oe < e)) { v = ov; e = oe; } }
                  if (g == k) mye = e;
                  if (li[0] == e) {
#pragma unroll
                      for (int p = 0; p < 7; ++p) { lv[p] = lv[p + 1]; li[p] = li[p + 1]; }
                      lv[7] = -INFINITY; } }
              const float s = L[tl * LST + mye]; float ssum = s;
#pragma unroll
              for (int off = 1; off < 8; off <<= 1) ssum += __shfl_xor(ssum, off);
              const int pair = t * TOPK + g; const float gwv = s / ssum * 2.5f; TOPW[pair] = gwv; const int slot = atomicAdd(&CNT[mye * CNT_STRIDE], 1); LIST[(size_t)mye * T + slot] = pair; LOG[(size_t)mye * T + slot] = gwv;
            }
            __syncthreads();
        }
        if (BOTH(6)) GRID_BAR();
    }

    if (IN(9) || IN(10)) {
        LAS int* cntL = (LAS int*)(ldsa + TAB_OFF); LAS int* tbase = cntL + 256; LAS int* tile2e = tbase + 260;
        if (tid < 256) cntL[tid] = __hip_atomic_load(&CNT[tid * CNT_STRIDE], RLX_AGENT);
        __syncthreads();
        if (tid == 0) { int s = 0; for (int e = 0; e < NE; ++e) { tbase[e] = s; s += (cntL[e] + 255) >> 8; } tbase[NE] = s; }
        __syncthreads();
        if (tid < 256) { const int t0 = tbase[tid], t1 = tbase[tid + 1]; for (int q = t0; q < t1; ++q) tile2e[q] = tid; }
        __syncthreads();
        const int ntm = tbase[NE];
        if (IN(9)) {
            constexpr int KE = MOE_FP8 ? DM / 2 : DM;
            pg8::MoeSched<true> S; S.A = (const char*)H1b; S.Bt = (const char*)WguT; S.atile = (size_t)256 * KE * 2; S.bexp = (size_t)512 * KE * 2; S.btile = (size_t)256 * KE * 2; S.npn = 2; S.ntm = ntm; S.nwg = (ntm + 64) * 2; S.G = G; S.c = bx; S.rep = REPF(9);
            S.tile2e = tile2e; S.tbase = tbase; S.cntL = cntL; S.list = LIST;
            pg8::EpiGU E{ACT};
            pg8::gemm_phase<pg8::EpiGU, pg8::MoeSched<true>, true, MOE_FP8 != 0>(ldsa, KE, KE, KE, S, E);
            if (BOTH(9)) GRID_BAR();
        }
        if (IN(10)) {
            constexpr int KD = MOE_FP8 ? DE / 2 : DE;
            pg8::MoeSched<false> S; S.A = (const char*)ACT; S.Bt = (const char*)WdT; S.atile = (size_t)256 * KD * 2; S.bexp = (size_t)DM * KD * 2; S.btile = (size_t)256 * KD * 2; S.npn = 4; S.ntm = ntm; S.nwg = (ntm + 64) * 4; S.G = G; S.c = bx; S.rep = REPF(10);
            S.tile2e = tile2e; S.tbase = tbase; S.cntL = cntL; S.list = LIST;
            pg8::EpiDown E{(unsigned char*)YP, (unsigned char*)YS, LIST, LOG, ntm};
            pg8::gemm_phase<pg8::EpiDown, pg8::MoeSched<false>, true, MOE_FP8 != 0>(ldsa, KD, KD, KD, S, E);
            if (BOTH(10)) GRID_BAR();
        }
    }

    if (IN(11)) REPS(11) {
        KARG(const float*, ln2_g, 25); KARG(const float*, ln2_b, 26); KARG(float*, out, 27);
        const unsigned char* YP8 = (const unsigned char*)YP; const unsigned char* YS8 = (const unsigned char*)YS;
        for (int m = gw; m < T; m += NGW) {
            const f32x4* xr = (const f32x4*)(PRE + (size_t)m * DM) + 4 * lane; f32x4 v[4];
            u32x4 yw[TOPK + 1];
#pragma unroll
            for (int k = 0; k < TOPK + 1; ++k) yw[k] = *(const u32x4*)((k < TOPK ? YP8 + (size_t)(m * TOPK + k) * DM : YS8 + (size_t)m * DM) + 16 * lane);
#pragma unroll
            for (int j = 0; j < 4; ++j) v[j] = xr[j] * DN_ALPHA;
#pragma unroll
            for (int k = 0; k < TOPK + 1; ++k) {
#pragma unroll
                for (int j = 0; j < 4; ++j) { const int w = (int)yw[k][j]; const auto lo = __builtin_amdgcn_cvt_pk_f32_fp8(w, false), hh = __builtin_amdgcn_cvt_pk_f32_fp8(w, true);
                    v[j].x += lo[0] * (1.0f / Y8MUL); v[j].y += lo[1] * (1.0f / Y8MUL); v[j].z += hh[0] * (1.0f / Y8MUL); v[j].w += hh[1] * (1.0f / Y8MUL); } }
            float s = 0.f;
#pragma unroll
            for (int j = 0; j < 4; ++j) s += (v[j].x + v[j].y) + (v[j].z + v[j].w);
            const float mean = wave_sum(s) * (1.f / DM); float s2 = 0.f;
#pragma unroll
            for (int j = 0; j < 4; ++j) { v[j] = v[j] - mean; s2 += (v[j].x * v[j].x + v[j].y * v[j].y) + (v[j].z * v[j].z + v[j].w * v[j].w); }
            const float rstd = 1.f / sqrtf(wave_sum(s2) * (1.f / DM) + LN_EPS);
            f32x4* orow = (f32x4*)(out + (size_t)m * DM) + 4 * lane;
#pragma unroll
            for (int j = 0; j < 4; ++j) { const f32x4 g = *((const f32x4*)ln2_g + 4 * lane + j), bb = *((const f32x4*)ln2_b + 4 * lane + j); orow[j] = v[j] * rstd * g + bb; }
        }
    }
#undef IN
#undef BOTH
#undef GRID_BAR
}

#undef WinT
#undef WaT
#undef WbT
#undef WoT
#undef WuqT
#undef WukvT
#undef WrT
#undef WsB
#undef COS
#undef SIN
#undef RS
#undef TOPW
#undef LIST
#undef WguT
#undef WdT
#undef PRE
#undef H1b
#undef LOG
#undef YA
#undef Ob
#undef Mb
#undef ACT
#undef Xb
#undef U
#undef Vg
#undef GA
#undef GB
#undef C3
#undef KR
#undef Qn
#undef Qr
#undef Kn
#undef Vv
#undef Sg
#undef YP
#undef YS
#undef CNT
#undef CNT
extern "C" void kernel_launch(void* const* d_in, const int* in_sizes, int n_in, void* d_out, int out_size, void* d_ws, size_t ws_size, hipStream_t stream) {
    static int grid = 0;
    if (grid == 0) {
        if (n_in != 27 || in_sizes[0] != T * DM || out_size != T * DM || ws_size < WS_END) { fprintf(stderr, "kernel_launch: unexpected shapes: n_in %d in0 %d out %d ws %zu (need %zu)\n", n_in, n_in > 0 ? in_sizes[0] : -1, out_size, ws_size, (size_t)WS_END); grid = -1; return; }
        int dev = 0, cus = 0, per_cu = 0;
        if (hipGetDevice(&dev) != hipSuccess || hipDeviceGetAttribute(&cus, hipDeviceAttributeMultiprocessorCount, dev) != hipSuccess) { grid = -1; return; }
        if (hipFuncSetAttribute((const void*)mega_fwd, hipFuncAttributeMaxDynamicSharedMemorySize, LDS_BYTES) != hipSuccess) { fprintf(stderr, "kernel_launch: hipFuncSetAttribute failed\n"); grid = -1; return; }
        if (hipOccupancyMaxActiveBlocksPerMultiprocessor(&per_cu, (const void*)mega_fwd, NWAVES * 64, LDS_BYTES) != hipSuccess || per_cu < 1) { fprintf(stderr, "kernel_launch: occupancy query says %d blocks per CU\n", per_cu); grid = -1; return; }
        (void)hipGetLastError();
        grid = cus;
    }
    if (grid < 0) return;
    if (hipMemsetAsync((char*)d_ws + WS_CTL, 0, CTL_ZERO_BYTES, stream) != hipSuccess) return;
    Args a{};
    for (int i = 0; i < 27; ++i) a.in[i] = d_in[i];
    a.out = (float*)d_out; a.ws = (unsigned char*)d_ws;
    for (int li = 0; li < N_LAUNCHES; ++li) {
        if (N_LAUNCHES == PER_PHASE) { a.ph_lo = li; a.ph_hi = li + 1; } else { a.ph_lo = 0; a.ph_hi = PER_PHASE; }
        a.li = li;
        hipLaunchKernelGGL(mega_fwd, dim3(grid), dim3(NWAVES * 64), LDS_BYTES, stream, a);
        const hipError_t le = hipPeekAtLastError();
        if (le != hipSuccess) { fprintf(stderr, "kernel_launch: launch %d failed: %s\n", li, hipGetErrorName(le)); break; }
    }
}
```

```cpp
#include <hip/hip_runtime.h>
#include <hip/hip_bf16.h>
#include <cstdio>
#include <cstdint>

#ifndef MK_N_LAUNCHES
#define MK_N_LAUNCHES 1
#endif

#define LAS __attribute__((address_space(3)))
#define GAS __attribute__((address_space(1)))
typedef unsigned short bf16_t;
typedef short bf16x8 __attribute__((ext_vector_type(8)));
typedef short s16x4 __attribute__((ext_vector_type(4)));
typedef float f32x4 __attribute__((ext_vector_type(4)));
typedef float f32x2 __attribute__((ext_vector_type(2)));
typedef float f32x16 __attribute__((ext_vector_type(16)));
typedef unsigned u32x4 __attribute__((ext_vector_type(4)));
typedef unsigned u32x2 __attribute__((ext_vector_type(2)));

constexpr int T = 16384, DM = 1024, SEQ = 8192, NBATCH = 2;
constexpr int NH = 8, QK_NOPE = 128, QK_ROPE = 64, VH = 128, QLORA = 384, KVLORA = 256;
constexpr int NE = 256, TOPK = 8, DE = 256;
constexpr int IN_TOTAL = 4800, IN_PAD = 4864;
constexpr float DN_ALPHA = 1.189207115002721f;
constexpr float LN_EPS = 1e-5f, RMS_EPS = 1e-6f;
constexpr float LOG2E = 1.4426950408889634f;
constexpr float QSCALE = 0.07216878364870322f * LOG2E;
constexpr int NWAVES = 8;

__device__ __forceinline__ unsigned cvt_pk_bf16(float lo, float hi) { unsigned r; asm volatile("v_cvt_pk_bf16_f32 %0, %1, %2" : "=v"(r) : "v"(lo), "v"(hi)); return r; }
__device__ __forceinline__ float bf_lo(unsigned w) { return __uint_as_float(w << 16); }
__device__ __forceinline__ float bf_hi(unsigned w) { return __uint_as_float(w & 0xffff0000u); }
__device__ __forceinline__ float sigmoid_f(float x) { return __builtin_amdgcn_rcpf(1.0f + __builtin_amdgcn_exp2f(-x * LOG2E)); }
__device__ __forceinline__ float gelu_tanh(float x) { const float u = 1.5957691216057308f * (x + 0.044715f * x * x * x); return x * __builtin_amdgcn_rcpf(1.0f + __builtin_amdgcn_exp2f(-u * LOG2E)); }
#ifndef MOE_FP8
#define MOE_FP8 1
#endif
constexpr float W8MUL = 64.0f;
#ifndef INP_FP8
#define INP_FP8 1
#endif
#ifndef OB_FP8
#define OB_FP8 1
#endif
constexpr float O8MUL = 64.0f;
#ifndef ATT_FP8
#define ATT_FP8 3
#endif
constexpr float Y8MUL = 16.0f;
constexpr float K8MUL = (ATT_FP8 == 3) ? 0.125f : 1.0f;
constexpr float Q8MUL = 8.0f;
__device__ __forceinline__ u32x2 pack8_fp8(const f32x4 v0, const f32x4 v1) { int a = __builtin_amdgcn_cvt_pk_fp8_f32(v0[0], v0[1], 0, false); a = __builtin_amdgcn_cvt_pk_fp8_f32(v0[2], v0[3], a, true);
    int b = __builtin_amdgcn_cvt_pk_fp8_f32(v1[0], v1[1], 0, false); b = __builtin_amdgcn_cvt_pk_fp8_f32(v1[2], v1[3], b, true); u32x2 w; w.x = (unsigned)a; w.y = (unsigned)b; return w; }
__host__ __device__ __forceinline__ int rope_orig(int p) { return 16 * (p >> 5) + 4 * ((p >> 3) & 3) + (p & 3) + 32 * ((p >> 2) & 1); }

namespace pg8 {
typedef int v8i_t __attribute__((ext_vector_type(8)));
typedef int i4_t __attribute__((ext_vector_type(4)));
constexpr int BM = 256, BK = 64, HALF = 128, HTB = HALF * BK * 2, STAGE_BYTES = 8 * HTB, NXCD = 8, WGM = 2;
__host__ __device__ __forceinline__ int lds_byte(int r, int c) { const int st = (r >> 4) * 2 + (c >> 5), rr = r & 15, cc = c & 31, ob = rr * 64 + cc * 2; return st * 1024 + (ob ^ (((ob >> 9) & 1) << 5)); }
__host__ __device__ __forceinline__ void stage_rc(int b, int& R, int& C) { const int st = b / 1024, sb = b % 1024, swz = sb ^ (((sb >> 9) & 1) << 5); R = (st >> 1) * 16 + swz / 64; C = (st & 1) * 32 + (swz % 64) / 2; }
__host__ __device__ __forceinline__ int perm32(int rho) { const int n = rho >> 4, i = rho & 15; return 8 * (i >> 2) + 4 * n + (i & 3); }

struct Unit { const char* a; const char* b; int pm, pn, e, cnt, r0; };

__device__ __forceinline__ int xcd_remap(int wgid, int nwg) { const int q = nwg / NXCD, r = nwg % NXCD, xcd = wgid % NXCD, off = wgid / NXCD; return (xcd < r ? xcd * (q + 1) : r * (q + 1) + (xcd - r) * q) + off; }

struct DenseSched {
    static constexpr bool GATHER = false;
    const char* A; const char* Bt; size_t atile, btile; int nM, nN, nwg, G, c, rep;
    __device__ __forceinline__ void init(const void* A_, int lda, const void* B_, int ldb, int M, int N, int G_, int c_, int rep_ = 1) {
        A = (const char*)A_; Bt = (const char*)B_; atile = (size_t)BM * lda * 2; btile = (size_t)BM * ldb * 2; nM = M / BM; nN = N / BM; nwg = nM * nN; G = G_; c = c_; rep = rep_; }
    __device__ __forceinline__ bool next(int i, Unit& u) const {
        long L = (long)i * G + c; if (L >= (long)nwg * rep) return false; if (L >= nwg) L -= nwg;
        const int wgid = xcd_remap((int)L, nwg);
        const int nig = WGM * nN, gid = wgid / nig, fm = gid * WGM, gsz = (nM - fm) < WGM ? (nM - fm) : WGM;
        u.pm = fm + ((wgid % nig) % gsz); u.pn = (wgid % nig) / gsz; u.e = 0; u.cnt = BM; u.r0 = 0;
        u.a = A + (size_t)u.pm * atile; u.b = Bt + (size_t)u.pn * btile; return true; }
    __device__ __forceinline__ void aoffs(const Unit&, const int (&)[2], const int (&)[2], int, unsigned (&)[2][2]) const {}
};

template <class Epi, class Sched, bool ALIGN_EPI, bool F8 = false>
__device__ __forceinline__ void gemm_phase(LAS unsigned char* lds, const int K, const int lda, const int ldb, const Sched& S, const Epi& E) {
    const int tid = threadIdx.x, wid = __builtin_amdgcn_readfirstlane(tid >> 6), lane = tid & 63, wr = wid >> 2, wc = wid & 3, fr = lane & 15, fq = lane >> 4;
    const int nt = K / BK;
    constexpr bool GA_ = Sched::GATHER;
    int Rr[2], Cc[2]; unsigned voffA[2][2], nvoffA[2][2], voffB[2];
#pragma unroll
    for (int i = 0; i < 2; ++i) { int R, C; stage_rc(tid * 16 + i * 8192, R, C); Rr[i] = R; Cc[i] = C; const int Rb = Epi::PERM ? ((R & ~31) + perm32(R & 31)) : R;
        voffB[i] = (unsigned)(Rb * ldb + C) * 2u;
#pragma unroll
        for (int h = 0; h < 2; ++h) { voffA[h][i] = (unsigned)(((GA_ ? h * HALF : 0) + R) * lda + C) * 2u; nvoffA[h][i] = voffA[h][i]; } }
    const size_t kstep = (size_t)(BK * 2);
    const size_t hsA = GA_ ? (size_t)0 : (size_t)HALF * lda * 2, hsB = (size_t)HALF * ldb * 2;
    const unsigned ldsw = (unsigned)wid * 1024u;
    const int aoff = lds_byte(wr * 64 + fr, fq * 8), boff = lds_byte(wc * 32 + fr, fq * 8);
#define PG8_SA(b, h) (((b) * 2 + (h)) * HTB)
#define PG8_SB(b, h) ((4 + (b) * 2 + (h)) * HTB)
    const unsigned ldsb_ = (unsigned)__builtin_amdgcn_readfirstlane((int)((unsigned)(uintptr_t)lds + ldsw));
#define PG8_STAGE(bufoff, gbase, voff) do { _Pragma("unroll") for (int _i = 0; _i < 2; ++_i) { unsigned keep_; \
        asm volatile("s_mov_b32 %0, m0\n\ts_mov_b32 m0, %3\n\ts_nop 4\n\tglobal_load_lds_dwordx4 %1, %2\n\ts_mov_b32 m0, %0" : "=&s"(keep_) : "v"((voff)[_i]), "s"((const char*)(gbase)), "s"(ldsb_ + (unsigned)((bufoff) + _i * 8192)) : "memory"); } } while (0)
#define PG8_LDA(dst, b, h) do { if constexpr (F8) { _Pragma("unroll") for (int m = 0; m < 4; ++m) dst##8[m] = __builtin_shufflevector(*(const LAS i4_t*)(lds + PG8_SA(b, h) + aoff + m * 2048), *(const LAS i4_t*)(lds + PG8_SA(b, h) + aoff + m * 2048 + 1024), 0, 1, 2, 3, 4, 5, 6, 7); } \
        else { _Pragma("unroll") for (int m = 0; m < 4; ++m) _Pragma("unroll") for (int k = 0; k < 2; ++k) dst[m][k] = *(const LAS bf16x8*)(lds + PG8_SA(b, h) + aoff + m * 2048 + k * 1024); } } while (0)
#define PG8_LDB(dst, b, h) do { if constexpr (F8) { _Pragma("unroll") for (int n = 0; n < 2; ++n) dst##8[n] = __builtin_shufflevector(*(const LAS i4_t*)(lds + PG8_SB(b, h) + boff + n * 2048), *(const LAS i4_t*)(lds + PG8_SB(b, h) + boff + n * 2048 + 1024), 0, 1, 2, 3, 4, 5, 6, 7); } \
        else { _Pragma("unroll") for (int n = 0; n < 2; ++n) _Pragma("unroll") for (int k = 0; k < 2; ++k) dst[n][k] = *(const LAS bf16x8*)(lds + PG8_SB(b, h) + boff + n * 2048 + k * 1024); } } while (0)
#define PG8_MMA(ai, bj, At, Bt) do { __builtin_amdgcn_s_setprio(1); if constexpr (F8) { _Pragma("unroll") for (int m = 0; m < 4; ++m) _Pragma("unroll") for (int n = 0; n < 2; ++n) \
            asm volatile("v_mfma_f32_16x16x128_f8f6f4 %0, %1, %2, %0" : "+v"(acc[ai][bj][m][n]) : "v"(Bt##8[n]), "v"(At##8[m])); } \
        else { _Pragma("unroll") for (int m = 0; m < 4; ++m) _Pragma("unroll") for (int n = 0; n < 2; ++n) _Pragma("unroll") for (int k = 0; k < 2; ++k) \
        acc[ai][bj][m][n] = __builtin_amdgcn_mfma_f32_16x16x32_bf16(Bt[n][k], At[m][k], acc[ai][bj][m][n], 0, 0, 0); } __builtin_amdgcn_s_setprio(0); } while (0)
#define PG8_WAIT_V(n) asm volatile("s_waitcnt vmcnt(" #n ")" ::: "memory")
#define PG8_WAIT_L(n) asm volatile("s_waitcnt lgkmcnt(" #n ")" ::: "memory")
#define PG8_BAR __builtin_amdgcn_s_barrier()
#define PG8_SCHED __builtin_amdgcn_sched_barrier(0)
    Unit cur, nxt; int ui = 0;
    if (!S.next(0, cur)) return;
    if constexpr (Sched::GATHER) S.aoffs(cur, Rr, Cc, lda, voffA);
    f32x4 acc[2][2][4][2];
    bf16x8 At[4][2], B0[2][2], B1[2][2]; v8i_t At8[4], B08[2], B18[2];
    const char* cA = cur.a; const char* cB = cur.b;
    PG8_STAGE(PG8_SB(0, 0), cB, voffB); PG8_STAGE(PG8_SB(0, 1), cB + hsB, voffB); PG8_STAGE(PG8_SA(0, 0), cA, voffA[0]); PG8_STAGE(PG8_SA(0, 1), cA + hsA, voffA[1]);
    if (wr == 1) PG8_BAR;
    PG8_WAIT_V(2); PG8_BAR;
    PG8_STAGE(PG8_SB(1, 0), cB + kstep, voffB); PG8_STAGE(PG8_SA(1, 0), cA + kstep, voffA[0]); PG8_STAGE(PG8_SB(1, 1), cB + hsB + kstep, voffB);
    PG8_WAIT_V(6); PG8_BAR;
    for (;;) {
        const bool has_next = S.next(ui + 1, nxt);
        if constexpr (Sched::GATHER) { if (has_next) S.aoffs(nxt, Rr, Cc, lda, nvoffA); else {
#pragma unroll
            for (int h = 0; h < 2; ++h)
#pragma unroll
                for (int i = 0; i < 2; ++i) nvoffA[h][i] = voffA[h][i]; } }
        const char* nA = has_next ? nxt.a : cA; const char* nB = has_next ? nxt.b : cB;
#pragma unroll
        for (int a = 0; a < 2; ++a)
#pragma unroll
            for (int b = 0; b < 2; ++b)
#pragma unroll
                for (int m = 0; m < 4; ++m)
#pragma unroll
                    for (int n = 0; n < 2; ++n) acc[a][b][m][n] = (f32x4){0.f, 0.f, 0.f, 0.f};
#pragma unroll 1
        for (int t = 0; t < nt; t += 2) {
            const bool last = (t == nt - 2);
            const char* a1 = cA + (size_t)(t + 1) * kstep;
            const char* a2 = last ? nA : cA + (size_t)(t + 2) * kstep; const char* b2 = last ? nB : cB + (size_t)(t + 2) * kstep;
            const char* a3 = a2 + kstep; const char* b3 = b2 + kstep;
            unsigned vA2[2][2];
#pragma unroll
            for (int h = 0; h < 2; ++h)
#pragma unroll
                for (int i = 0; i < 2; ++i) vA2[h][i] = (Sched::GATHER && last) ? nvoffA[h][i] : voffA[h][i];
            PG8_LDB(B0, 0, 0); PG8_LDB(B1, 0, 1); PG8_SCHED; PG8_LDA(At, 0, 0); PG8_STAGE(PG8_SA(1, 1), a1 + hsA, voffA[1]);
            PG8_WAIT_V(8); PG8_WAIT_L(0); PG8_BAR; PG8_MMA(0, 0, At, B0); PG8_MMA(0, 1, At, B1); PG8_BAR; PG8_SCHED;
            PG8_LDA(At, 0, 1); PG8_STAGE(PG8_SB(0, 0), b2, voffB); PG8_STAGE(PG8_SB(0, 1), b2 + hsB, voffB); PG8_STAGE(PG8_SA(0, 0), a2, vA2[0]);
            PG8_WAIT_V(8); PG8_WAIT_L(0); PG8_BAR; PG8_MMA(1, 0, At, B0); PG8_MMA(1, 1, At, B1); PG8_BAR; PG8_SCHED;
            PG8_LDB(B0, 1, 0); PG8_LDB(B1, 1, 1); PG8_SCHED; PG8_LDA(At, 1, 0); PG8_STAGE(PG8_SA(0, 1), a2 + hsA, vA2[1]);
            PG8_WAIT_V(8); PG8_WAIT_L(0); PG8_BAR; PG8_MMA(0, 0, At, B0); PG8_MMA(0, 1, At, B1); PG8_BAR; PG8_SCHED;
            PG8_LDA(At, 1, 1); PG8_STAGE(PG8_SB(1, 0), b3, voffB); PG8_STAGE(PG8_SB(1, 1), b3 + hsB, voffB); PG8_STAGE(PG8_SA(1, 0), a3, vA2[0]);
            PG8_WAIT_V(8); PG8_WAIT_L(0); PG8_BAR; PG8_MMA(1, 0, At, B0); PG8_MMA(1, 1, At, B1); PG8_BAR; PG8_SCHED;
        }
        if constexpr (ALIGN_EPI) { if (wr == 0) PG8_BAR; }
        if constexpr (F8) asm volatile("s_nop 15\n\ts_nop 15" ::: "memory");
        E(acc, cur, wr, wc, fr, fq);
        if (!has_next) break;
        cur = nxt; cA = nA; cB = nB; ++ui;
        if constexpr (Sched::GATHER) {
#pragma unroll
            for (int h = 0; h < 2; ++h)
#pragma unroll
                for (int i = 0; i < 2; ++i) voffA[h][i] = nvoffA[h][i]; }
        if constexpr (ALIGN_EPI) { if (wr == 1) PG8_BAR; }
    }
    PG8_WAIT_V(0);
    if constexpr (!ALIGN_EPI) { if (wr == 0) PG8_BAR; }
    PG8_BAR;
#undef PG8_SA
#undef PG8_SB
#undef PG8_STAGE
#undef PG8_LDA
#undef PG8_LDB
#undef PG8_MMA
#undef PG8_WAIT_V
#undef PG8_WAIT_L
#undef PG8_BAR
#undef PG8_SCHED
}

typedef f32x4 AccT[2][2][4][2];
__device__ __forceinline__ u32x4 pack8(const f32x4 v0, const f32x4 v1) { u32x4 w; w.x = cvt_pk_bf16(v0[0], v0[1]); w.y = cvt_pk_bf16(v0[2], v0[3]); w.z = cvt_pk_bf16(v1[0], v1[1]); w.w = cvt_pk_bf16(v1[2], v1[3]); return w; }

struct EpiInProj {
    static constexpr bool PERM = true;
    bf16_t *U, *Vg, *C3, *KR, *GA, *GB; float* RS; const float* COS; const float* SIN; int pmode; float ascale;
    __device__ __forceinline__ void operator()(const AccT& acc, const Unit& u, int wr, int wc, int fr, int fq) const {
        const int row0 = u.pm * BM + wr * 64 + fr, pn = pmode == 0 ? u.pn : pmode == 1 ? (u.pn < 8 ? u.pn : u.pn + 3) : (u.pn < 3 ? u.pn + 8 : u.pn + 12), cw = wc * 32 + 8 * fq;
        if (pn < 8 || pn >= 11) {
            bf16_t* base; int ct; bool gel;
            if (pn < 4) { base = U; ct = pn; gel = true; } else if (pn < 8) { base = Vg; ct = pn - 4; gel = true; } else if (pn < 15) { base = GA; ct = pn - 11; gel = false; } else { base = GB; ct = pn - 15; gel = false; }
#pragma unroll
            for (int ai = 0; ai < 2; ++ai)
#pragma unroll
                for (int m = 0; m < 4; ++m) { bf16_t* rowp = base + (size_t)(row0 + ai * HALF + m * 16) * DM + ct * BM + cw;
#pragma unroll
                    for (int bj = 0; bj < 2; ++bj) { f32x4 v0 = acc[ai][bj][m][0] * ascale, v1 = acc[ai][bj][m][1] * ascale;
#pragma unroll
                        for (int i = 0; i < 4; ++i) { v0[i] = gel ? gelu_tanh(v0[i]) : sigmoid_f(v0[i]); v1[i] = gel ? gelu_tanh(v1[i]) : sigmoid_f(v1[i]); }
                        *(u32x4*)(rowp + bj * HALF) = pack8(v0, v1); } }
        } else {
            const int ct = pn - 8;
#pragma unroll
            for (int ai = 0; ai < 2; ++ai)
#pragma unroll
                for (int m = 0; m < 4; ++m) { const int row = row0 + ai * HALF + m * 16;
#pragma unroll
                    for (int bj = 0; bj < 2; ++bj) { const f32x4 v0 = acc[ai][bj][m][0] * ascale, v1 = acc[ai][bj][m][1] * ascale;
                        if (ct == 2 && bj == 1) {
                            if (wc < 2) { const int j0 = 16 * wc + 4 * fq; const f32x4 cs = *(const f32x4*)(COS + (size_t)row * 32 + j0), sn = *(const f32x4*)(SIN + (size_t)row * 32 + j0);
                                const f32x4 o0 = v0 * cs - v1 * sn, o1 = v0 * sn + v1 * cs;
                                if (ATT_FP8) *(u32x2*)((unsigned char*)KR + (size_t)row * 64 + cw) = pack8_fp8(o0 * K8MUL, o1 * K8MUL); else *(u32x4*)(KR + (size_t)row * 64 + cw) = pack8(o0, o1); }
                        } else {
                            *(u32x4*)(C3 + (size_t)row * 768 + ct * BM + bj * HALF + cw) = pack8(v0, v1);
                            float s = (v0[0] * v0[0] + v0[1] * v0[1]) + (v0[2] * v0[2] + v0[3] * v0[3]) + (v1[0] * v1[0] + v1[1] * v1[1]) + (v1[2] * v1[2] + v1[3] * v1[3]);
                            s += __shfl_xor(s, 16); s += __shfl_xor(s, 32);
                            if (fq == 0) RS[(size_t)row * 24 + ct * 8 + bj * 4 + wc] = s; } }
                    asm volatile("" ::: "memory"); }
        }
    }
};
struct EpiQ {
    static constexpr bool PERM = true;
    bf16_t *Qn, *Qr; const float* RS; const float* COS; const float* SIN;
    __device__ __forceinline__ void operator()(const AccT& acc, const Unit& u, int wr, int wc, int fr, int fq) const {
        const unsigned row0 = u.pm * BM + wr * 64 + fr, pn = u.pn, cw = wc * 32 + 8 * fq;
#pragma unroll
        for (int ai = 0; ai < 2; ++ai) {
            float scv[4];
#pragma unroll
            for (int m = 0; m < 4; ++m) { const float* rs = RS + (row0 + ai * HALF + m * 16) * 24u;
                const f32x4 r0 = *(const f32x4*)(rs), r1 = *(const f32x4*)(rs + 4), r2 = *(const f32x4*)(rs + 8);
                const float ss = ((r0[0] + r0[1]) + (r0[2] + r0[3])) + ((r1[0] + r1[1]) + (r1[2] + r1[3])) + ((r2[0] + r2[1]) + (r2[2] + r2[3]));
                scv[m] = (ATT_FP8 ? QSCALE * Q8MUL : QSCALE) * __builtin_amdgcn_rsqf(ss * (1.0f / QLORA) + RMS_EPS); }
            f32x4 csv[4], snv[4];
            if (pn >= 4) {
#pragma unroll
                for (int m = 0; m < 4; ++m) { const unsigned j0 = (row0 + ai * HALF + m * 16) * 32u + 16 * (wc & 1) + 4 * fq; csv[m] = *(const f32x4*)(COS + j0); snv[m] = *(const f32x4*)(SIN + j0); } }
#pragma unroll
            for (int m = 0; m < 4; ++m) { const unsigned row = row0 + ai * HALF + m * 16; const float sc = scv[m];
                if (pn < 4) { const unsigned eo = row * 1024u + pn * BM + cw;
#pragma unroll
                    for (int bj = 0; bj < 2; ++bj) { if (ATT_FP8) *(u32x2*)((unsigned char*)Qn + eo + bj * HALF) = pack8_fp8(acc[ai][bj][m][0] * sc, acc[ai][bj][m][1] * sc); else *(u32x4*)(Qn + eo + bj * HALF) = pack8(acc[ai][bj][m][0] * sc, acc[ai][bj][m][1] * sc); }
                } else { const f32x4 cs = csv[m] * sc, sn = snv[m] * sc;
                    const unsigned eo = row * 512u + (pn - 4) * BM + cw;
#pragma unroll
                    for (int bj = 0; bj < 2; ++bj) { const f32x4 v0 = acc[ai][bj][m][0], v1 = acc[ai][bj][m][1];
                        if (ATT_FP8) *(u32x2*)((unsigned char*)Qr + eo + bj * HALF) = pack8_fp8(v0 * cs - v1 * sn, v0 * sn + v1 * cs); else *(u32x4*)(Qr + eo + bj * HALF) = pack8(v0 * cs - v1 * sn, v0 * sn + v1 * cs); } }
            }
            asm volatile("" ::: "memory");
        }
    }
};
struct EpiKV {
    static constexpr bool PERM = true;
    bf16_t *Kn, *Vv; const float* RS;
    __device__ __forceinline__ void operator()(const AccT& acc, const Unit& u, int wr, int wc, int fr, int fq) const {
        const unsigned row0 = u.pm * BM + wr * 64 + fr, pn = u.pn, cw = wc * 32 + 8 * fq;
        bf16_t* base = pn < 4 ? Kn : Vv; const unsigned ct = pn & 3;
        float scv[8];
#pragma unroll
        for (int q = 0; q < 8; ++q) { const float* rs = RS + (row0 + (q >> 2) * HALF + (q & 3) * 16) * 24u;
            const f32x4 r0 = *(const f32x4*)(rs + 12), r1 = *(const f32x4*)(rs + 16);
            scv[q] = __builtin_amdgcn_rsqf((((r0[0] + r0[1]) + (r0[2] + r0[3])) + ((r1[0] + r1[1]) + (r1[2] + r1[3]))) * (1.0f / KVLORA) + RMS_EPS); }
        asm volatile("" ::: "memory");
#pragma unroll
        for (int ai = 0; ai < 2; ++ai)
#pragma unroll
            for (int m = 0; m < 4; ++m) { const unsigned row = row0 + ai * HALF + m * 16; const float sc = scv[ai * 4 + m] * ((ATT_FP8 && pn < 4) ? K8MUL : 1.0f);
                const unsigned eo = row * 1024u + ct * BM + cw;
#pragma unroll
                for (int bj = 0; bj < 2; ++bj) { if (ATT_FP8 && pn < 4) *(u32x2*)((unsigned char*)Kn + eo + bj * HALF) = pack8_fp8(acc[ai][bj][m][0] * sc, acc[ai][bj][m][1] * sc); else *(u32x4*)(base + eo + bj * HALF) = pack8(acc[ai][bj][m][0] * sc, acc[ai][bj][m][1] * sc); }
                if (m & 1) asm volatile("" ::: "memory");
            }
    }
};
struct EpiVT {
    static constexpr bool PERM = true;
    unsigned char* VT; const float* RS;
    __device__ __forceinline__ void operator()(const AccT& acc, const Unit& u, int wr, int wc, int fr, int fq) const {
        const unsigned hd0 = u.pm * BM + wr * 64 + fr;
#pragma unroll
        for (int bj = 0; bj < 2; ++bj) { const unsigned tb = u.pn * BM + bj * HALF + wc * 32 + 8 * fq;
            float rs[8];
#pragma unroll
            for (int i = 0; i < 8; ++i) { const float* p = RS + (tb + i) * 24u + 12; const f32x4 r0 = *(const f32x4*)p, r1 = *(const f32x4*)(p + 4);
                rs[i] = __builtin_amdgcn_rsqf((((r0[0] + r0[1]) + (r0[2] + r0[3])) + ((r1[0] + r1[1]) + (r1[2] + r1[3]))) * (1.0f / KVLORA) + RMS_EPS); }
            const unsigned b = tb >> 13, s0 = tb & 8191u, k0 = s0 & 63u;
            const unsigned cbase = (s0 & ~63u) + 16u * (k0 >> 5) + 4u * ((k0 >> 3) & 3u);
#pragma unroll
            for (int ai = 0; ai < 2; ++ai)
#pragma unroll
                for (int m = 0; m < 4; ++m) { const unsigned hd = hd0 + ai * HALF + m * 16; unsigned char* dst = VT + ((size_t)(b * 1024u + hd) * 8192u + cbase);
                    const f32x4 v0 = acc[ai][bj][m][0], v1 = acc[ai][bj][m][1];
                    int a = __builtin_amdgcn_cvt_pk_fp8_f32(v0[0] * rs[0], v0[1] * rs[1], 0, false); a = __builtin_amdgcn_cvt_pk_fp8_f32(v0[2] * rs[2], v0[3] * rs[3], a, true);
                    int c = __builtin_amdgcn_cvt_pk_fp8_f32(v1[0] * rs[4], v1[1] * rs[5], 0, false); c = __builtin_amdgcn_cvt_pk_fp8_f32(v1[2] * rs[6], v1[3] * rs[7], c, true);
                    *(unsigned*)dst = (unsigned)a; *(unsigned*)(dst + 32) = (unsigned)c; }
            asm volatile("" ::: "memory"); }
    }
};
template <bool ADD> struct EpiGate {
    static constexpr bool PERM = true;
    bf16_t* O; const bf16_t* G; const bf16_t* Y; float ascale;
    __device__ __forceinline__ void operator()(const AccT& acc, const Unit& u, int wr, int wc, int fr, int fq) const {
        const unsigned row0 = u.pm * BM + wr * 64 + fr, cw = u.pn * BM + wc * 32 + 8 * fq;
#pragma unroll
        for (int ai = 0; ai < 2; ++ai) {
            u32x4 gv[4][2], yv[4][2];
#pragma unroll
            for (int m = 0; m < 4; ++m)
#pragma unroll
                for (int bj = 0; bj < 2; ++bj) { const unsigned ro = (row0 + ai * HALF + m * 16) * DM + cw + bj * HALF; gv[m][bj] = *(const u32x4*)(G + ro); if (ADD) yv[m][bj] = *(const u32x4*)(Y + ro); }
#pragma unroll
            for (int m = 0; m < 4; ++m)
#pragma unroll
                for (int bj = 0; bj < 2; ++bj) { const unsigned ro = (row0 + ai * HALF + m * 16) * DM + cw + bj * HALF; const u32x4 g = gv[m][bj]; f32x4 v0 = acc[ai][bj][m][0] * ascale, v1 = acc[ai][bj][m][1] * ascale;
                    v0[0] *= bf_lo(g.x); v0[1] *= bf_hi(g.x); v0[2] *= bf_lo(g.y); v0[3] *= bf_hi(g.y); v1[0] *= bf_lo(g.z); v1[1] *= bf_hi(g.z); v1[2] *= bf_lo(g.w); v1[3] *= bf_hi(g.w);
                    if (ADD) { const u32x4 y = yv[m][bj];
                        v0[0] += bf_lo(y.x); v0[1] += bf_hi(y.x); v0[2] += bf_lo(y.y); v0[3] += bf_hi(y.y); v1[0] += bf_lo(y.z); v1[1] += bf_hi(y.z); v1[2] += bf_lo(y.w); v1[3] += bf_hi(y.w); }
                    *(u32x4*)(O + ro) = pack8(v0, v1); }
            asm volatile("" ::: "memory");
        }
    }
};
struct EpiPre {
    static constexpr bool PERM = false;
    float* P; const float* X;
    __device__ __forceinline__ void operator()(const AccT& acc, const Unit& u, int wr, int wc, int fr, int fq) const {
        const int row0 = u.pm * BM + wr * 64 + fr, col0 = u.pn * BM + wc * 32 + 4 * fq;
#pragma unroll
        for (int ai = 0; ai < 2; ++ai)
#pragma unroll
            for (int m = 0; m < 4; ++m) { const size_t ro = (size_t)(row0 + ai * HALF + m * 16) * DM + col0;
#pragma unroll
                for (int bj = 0; bj < 2; ++bj)
#pragma unroll
                    for (int n = 0; n < 2; ++n) { const f32x4 xv = *(const f32x4*)(X + ro + bj * HALF + n * 16); *(f32x4*)(P + ro + bj * HALF + n * 16) = xv * DN_ALPHA + acc[ai][bj][m][n]; }
                if (m & 1) asm volatile("" ::: "memory"); }
    }
};
struct EpiF32 {
    static constexpr bool PERM = false;
    float* C; int ldc;
    __device__ __forceinline__ void operator()(const AccT& acc, const Unit& u, int wr, int wc, int fr, int fq) const {
        const int row0 = u.pm * BM + wr * 64 + fr, col0 = u.pn * BM + wc * 32 + 4 * fq;
#pragma unroll
        for (int ai = 0; ai < 2; ++ai)
#pragma unroll
            for (int m = 0; m < 4; ++m) { float* rowp = C + (size_t)(row0 + ai * HALF + m * 16) * ldc + col0;
#pragma unroll
                for (int bj = 0; bj < 2; ++bj)
#pragma unroll
                    for (int n = 0; n < 2; ++n) *(f32x4*)(rowp + bj * HALF + n * 16) = acc[ai][bj][m][n]; }
    }
};
template <bool GATH> struct MoeSched {
    static constexpr bool GATHER = GATH;
    const char* A; const char* Bt; size_t atile, bexp, btile; int npn, ntm, nwg, G, c, rep;
    const LAS int* tile2e; const LAS int* tbase; const LAS int* cntL; const int* list;
    __device__ __forceinline__ bool next(int i, Unit& u) const {
        long L = (long)i * G + c; if (L >= (long)nwg * rep) return false; if (L >= nwg) L -= nwg;
        const int wgid = xcd_remap((int)L, nwg);
        const int tile = wgid / npn, pn = wgid - tile * npn;
        int e, r0, cnt;
        if (tile < ntm) { e = __builtin_amdgcn_readfirstlane(tile2e[tile]); r0 = (tile - __builtin_amdgcn_readfirstlane(tbase[e])) * BM; cnt = __builtin_amdgcn_readfirstlane(cntL[e]) - r0; cnt = cnt > BM ? BM : cnt; u.a = GATH ? A : A + (size_t)tile * atile; }
        else { e = NE; r0 = 0; cnt = BM; u.a = A + (size_t)(GATH ? (tile - ntm) : tile) * atile; }
        u.b = Bt + (size_t)e * bexp + (size_t)pn * btile; u.pm = tile; u.pn = pn; u.e = e; u.cnt = cnt; u.r0 = r0; return true; }
    __device__ __forceinline__ void aoffs(const Unit& u, const int (&R)[2], const int (&C)[2], int lda, unsigned (&off)[2][2]) const {
#pragma unroll
        for (int h = 0; h < 2; ++h)
#pragma unroll
            for (int i = 0; i < 2; ++i) { const int row = h * HALF + R[i];
                if (u.e == NE) off[h][i] = (unsigned)(row * lda + C[i]) * 2u;
                else { const int rr = row < u.cnt ? row : 0; const int pair = list[(size_t)u.e * T + u.r0 + rr]; off[h][i] = (unsigned)((pair >> 3) * lda + C[i]) * 2u; } }
    }
};
struct EpiGU {
    static constexpr bool PERM = true;
    bf16_t* ACT;
    __device__ __forceinline__ void operator()(const AccT& acc, const Unit& u, int wr, int wc, int fr, int fq) const {
        const int row0 = u.pm * BM + wr * 64 + fr, cw = u.pn * HALF + wc * 32 + 8 * fq;
#pragma unroll
        for (int ai = 0; ai < 2; ++ai)
#pragma unroll
            for (int m = 0; m < 4; ++m) { f32x4 g0 = acc[ai][0][m][0], g1 = acc[ai][0][m][1]; const f32x4 u0 = acc[ai][1][m][0], u1 = acc[ai][1][m][1];
#pragma unroll
                for (int i = 0; i < 4; ++i) { const float ws_ = MOE_FP8 ? 1.0f / W8MUL : 1.0f; const float ga = g0[i] * ws_, gb = g1[i] * ws_; g0[i] = ga * sigmoid_f(ga) * (u0[i] * ws_); g1[i] = gb * sigmoid_f(gb) * (u1[i] * ws_); }
                if (MOE_FP8) *(u32x2*)((unsigned char*)ACT + (size_t)(row0 + ai * HALF + m * 16) * DE + cw) = pack8_fp8(g0, g1); else *(u32x4*)(ACT + (size_t)(row0 + ai * HALF + m * 16) * DE + cw) = pack8(g0, g1); }
    }
};
struct EpiDown {
    static constexpr bool PERM = true;
    unsigned char *YP, *YS; const int* list; const float* TOPW; int ntm;
    __device__ __forceinline__ void operator()(const AccT& acc, const Unit& u, int wr, int wc, int fr, int fq) const {
        const unsigned cw = u.pn * BM + wc * 32 + 8 * fq;
        const bool shared = (u.e == NE);
        unsigned char* base = shared ? YS + (size_t)(u.pm - ntm) * BM * DM : YP;
        const int* lst = list + (shared ? 0u : (unsigned)u.e * (unsigned)T + (unsigned)u.r0);
        unsigned drow[8]; float wv[8];
#pragma unroll
        for (int q = 0; q < 8; ++q) { const unsigned r = (q >> 2) * HALF + wr * 64 + (q & 3) * 16 + fr; drow[q] = r; if (!shared) drow[q] = (unsigned)lst[(int)r < u.cnt ? r : 0u]; }
        const float* lw = TOPW + (shared ? 0u : (unsigned)u.e * (unsigned)T + (unsigned)u.r0);
#pragma unroll
        for (int q = 0; q < 8; ++q) { const unsigned r = (q >> 2) * HALF + wr * 64 + (q & 3) * 16 + fr; wv[q] = (shared ? 1.0f : lw[(int)r < u.cnt ? r : 0u]) * (MOE_FP8 ? Y8MUL / W8MUL : Y8MUL); }
#pragma unroll
        for (int ai = 0; ai < 2; ++ai)
#pragma unroll
            for (int m = 0; m < 4; ++m) { const unsigned r = ai * HALF + wr * 64 + m * 16 + fr; const float w = wv[ai * 4 + m];
                if (shared || (int)r < u.cnt) { unsigned char* dst = base + (drow[ai * 4 + m] * 1024u + cw);
#pragma unroll
                    for (int bj = 0; bj < 2; ++bj) *(u32x2*)(dst + bj * HALF) = pack8_fp8(acc[ai][bj][m][0] * w, acc[ai][bj][m][1] * w); }
                if (m & 1) asm volatile("" ::: "memory"); }
    }
};
}

namespace att {
constexpr int NW = 8, QBLK = 32, KVBLK = 64;
constexpr int SHM_V = 16384, SHM_KN = 16384, SHM_KR = 8192;
constexpr int OFF_V = 0, OFF_KN = 2 * SHM_V, OFF_KR = OFF_KN + 2 * SHM_KN, OFF_WS = OFF_KR + 2 * SHM_KR, OFF_QR = OFF_WS + NW * 64 * 4, LDS_BYTES = OFF_QR + NW * 4096;
constexpr float THRL = 8.0f * LOG2E;
constexpr float THRL8 = 6.0f;
#define KSW(row, colB) ((row) * 256 + ((colB) ^ (((row) & 15) << 4)))
#define KRSW(row, ch) ((row) * 128 + ((((ch) ^ (((row) >> 1) & 7))) << 4))
#define SBAR() __builtin_amdgcn_sched_barrier(0)
__device__ __forceinline__ int crow(int r, int hi) { return (r & 3) + 8 * (r >> 2) + 4 * hi; }
__device__ __forceinline__ unsigned cvtpk(float lo, float hi) { unsigned r; asm volatile("v_cvt_pk_bf16_f32 %0, %1, %2" : "=v"(r) : "v"(lo), "v"(hi)); return r; }
__device__ __forceinline__ void partialSM(f32x16& p0, f32x16& p1, float& m_reg, float& mn, float& alpha) {
    float pmax = p0[0];
#pragma unroll
    for (int r = 1; r < 16; ++r) pmax = fmaxf(pmax, p0[r]);
#pragma unroll
    for (int r = 0; r < 16; ++r) pmax = fmaxf(pmax, p1[r]);
    { auto rr = __builtin_amdgcn_permlane32_swap(__float_as_uint(pmax), __float_as_uint(pmax), false, false); pmax = fmaxf(__uint_as_float(rr[0]), __uint_as_float(rr[1])); }
    if (__builtin_expect(__all(pmax - m_reg <= THRL), 1)) { mn = m_reg; alpha = 1.f; }
    else { mn = fmaxf(m_reg, pmax); alpha = __builtin_amdgcn_exp2f(m_reg - mn); m_reg = mn; }
#pragma unroll
    for (int r = 0; r < 16; ++r) p0[r] = p0[r] - mn;
#pragma unroll
    for (int r = 0; r < 16; ++r) p1[r] = p1[r] - mn;
#pragma unroll
    for (int r = 0; r < 16; ++r) p0[r] = __builtin_amdgcn_exp2f(p0[r]);
}
__device__ __forceinline__ void finishSM(f32x16& p0, f32x16& p1, float alpha, float& l_reg, bf16x8& pa0, bf16x8& pa1, bf16x8& pa2, bf16x8& pa3) {
#pragma unroll
    for (int r = 0; r < 16; ++r) p1[r] = __builtin_amdgcn_exp2f(p1[r]);
    float ps = 0;
#pragma unroll
    for (int r = 0; r < 16; ++r) ps += p0[r];
#pragma unroll
    for (int r = 0; r < 16; ++r) ps += p1[r];
    { auto rr = __builtin_amdgcn_permlane32_swap(__float_as_uint(ps), __float_as_uint(ps), false, false); ps = __uint_as_float(rr[0]) + __uint_as_float(rr[1]); }
    l_reg = l_reg * alpha + ps;
#define PK4(P, BASE, OUT) do { unsigned a0 = cvtpk(P[BASE + 0], P[BASE + 1]), a1 = cvtpk(P[BASE + 2], P[BASE + 3]);   \
    unsigned b0 = cvtpk(P[BASE + 4], P[BASE + 5]), b1 = cvtpk(P[BASE + 6], P[BASE + 7]);                              \
    auto r0 = __builtin_amdgcn_permlane32_swap(a0, b0, false, false); auto r1 = __builtin_amdgcn_permlane32_swap(a1, b1, false, false); \
    u32x4 w = {r0[0], r1[0], r0[1], r1[1]}; OUT = *reinterpret_cast<bf16x8*>(&w); } while (0)
    PK4(p0, 0, pa0); PK4(p0, 8, pa1); PK4(p1, 0, pa2); PK4(p1, 8, pa3);
#undef PK4
}
__device__ __forceinline__ void qkt(f32x16& p0, f32x16& p1, const char* Kn, const char* Kr, const bf16x8* qr, const char* qrl, int r32, int hi) {
    p0 = f32x16{}; p1 = f32x16{};
#pragma unroll
    for (int d0 = 0; d0 < 8; ++d0) { const int cb = (d0 * 16 + hi * 8) * 2;
        const bf16x8 b0 = *reinterpret_cast<const bf16x8*>(Kn + KSW(r32, cb));
        const bf16x8 b1 = *reinterpret_cast<const bf16x8*>(Kn + KSW(32 + r32, cb));
        p0 = __builtin_amdgcn_mfma_f32_32x32x16_bf16(b0, qr[d0], p0, 0, 0, 0);
        p1 = __builtin_amdgcn_mfma_f32_32x32x16_bf16(b1, qr[d0], p1, 0, 0, 0); }
#pragma unroll
    for (int d0 = 0; d0 < 4; ++d0) { const int ch = d0 * 2 + hi;
        const bf16x8 b0 = *reinterpret_cast<const bf16x8*>(Kr + KRSW(r32, ch));
        const bf16x8 b1 = *reinterpret_cast<const bf16x8*>(Kr + KRSW(32 + r32, ch));
        const bf16x8 qv = *reinterpret_cast<const bf16x8*>(qrl + d0 * 1024);
        p0 = __builtin_amdgcn_mfma_f32_32x32x16_bf16(b0, qv, p0, 0, 0, 0);
        p1 = __builtin_amdgcn_mfma_f32_32x32x16_bf16(b1, qv, p1, 0, 0, 0); }
}
__device__ __forceinline__ int v_st(int k, int c) { const int kk = (k & ~0xC) | ((k & 4) << 1) | ((k & 8) >> 1); return ((kk >> 3) * 4 + (c >> 5)) * 512 + ((kk & 7) * 32 + (c & 31)) * 2; }
__device__ __forceinline__ int v_rd_base(int lane) { return ((lane & 3) << 3) | (((lane >> 2) & 3) << 6) | (((lane >> 4) & 1) << 5) | (((lane >> 5) & 1) << 8); }
constexpr int v_rd_off(int d0, int ks, int half) { return d0 * 512 + ks * 4096 + half * 2048; }
template <int OFF> __device__ __forceinline__ s16x4 tr_read(int vb) { s16x4 r; asm volatile("ds_read_b64_tr_b16 %0, %1 offset:%2" : "=&v"(r) : "v"(vb), "i"(OFF) : "memory"); return r; }
template <int D0> __device__ __forceinline__ void pv_one(f32x16& od, int vb, bf16x8 pa0, bf16x8 pa1, bf16x8 pa2, bf16x8 pa3) {
    const s16x4 l0 = tr_read<v_rd_off(D0, 0, 0)>(vb), h0 = tr_read<v_rd_off(D0, 0, 1)>(vb), l1 = tr_read<v_rd_off(D0, 1, 0)>(vb), h1 = tr_read<v_rd_off(D0, 1, 1)>(vb);
    const s16x4 l2 = tr_read<v_rd_off(D0, 2, 0)>(vb), h2 = tr_read<v_rd_off(D0, 2, 1)>(vb), l3 = tr_read<v_rd_off(D0, 3, 0)>(vb), h3 = tr_read<v_rd_off(D0, 3, 1)>(vb);
    asm volatile("s_waitcnt lgkmcnt(0)" ::: "memory"); SBAR();
#define PK(L, H) (bf16x8){L[0], L[1], L[2], L[3], H[0], H[1], H[2], H[3]}
    od = __builtin_amdgcn_mfma_f32_32x32x16_bf16(pa0, PK(l0, h0), od, 0, 0, 0);
    od = __builtin_amdgcn_mfma_f32_32x32x16_bf16(pa1, PK(l1, h1), od, 0, 0, 0);
    od = __builtin_amdgcn_mfma_f32_32x32x16_bf16(pa2, PK(l2, h2), od, 0, 0, 0);
    od = __builtin_amdgcn_mfma_f32_32x32x16_bf16(pa3, PK(l3, h3), od, 0, 0, 0);
#undef PK
}
__device__ __forceinline__ void pv_d0(f32x16* o, int vb, bf16x8 pa0, bf16x8 pa1, bf16x8 pa2, bf16x8 pa3) {
    pv_one<0>(o[0], vb, pa0, pa1, pa2, pa3); pv_one<1>(o[1], vb, pa0, pa1, pa2, pa3); pv_one<2>(o[2], vb, pa0, pa1, pa2, pa3); pv_one<3>(o[3], vb, pa0, pa1, pa2, pa3);
}
typedef short v4i16_t __attribute__((ext_vector_type(4)));
typedef __attribute__((address_space(3))) const char* lcp;
#ifndef ATT_SD
#define ATT_SD 5
#endif
#ifndef ATT_PRIO_MFMA
#define ATT_PRIO_MFMA 1
#endif
#ifndef ATT_PRIO_VALU
#define ATT_PRIO_VALU 0
#endif
constexpr int SD = ATT_SD, NSL = ATT_SD + 1;
struct Seg1Regs { bf16x8 fa[NSL]; bf16x8 fq[2]; };
template <int I, bool PV, int VAR> __device__ __forceinline__ void seg1_read(Seg1Regs& R, lcp kn, lcp kr, lcp ql, lcp vp, unsigned kx, unsigned krx, int hi) {
    if constexpr (VAR == 3) { asm volatile("" : "=v"(R.fa[I % NSL])); if constexpr (I >= 16 && I < 24 && ((I & 1) == 0)) asm volatile("" : "=v"(R.fq[((I - 16) >> 1) & 1])); }
    else if constexpr (I < 16) { constexpr int d0 = I >> 1, wh = I & 1; R.fa[I % NSL] = *(const __attribute__((address_space(3))) bf16x8*)(kn + wh * 8192 + (((unsigned)(d0 * 32 + hi * 16)) ^ kx)); }
    else if constexpr (I < 24) { constexpr int d0 = (I - 16) >> 1, wh = (I - 16) & 1; R.fa[I % NSL] = *(const __attribute__((address_space(3))) bf16x8*)(kr + wh * 4096 + ((((unsigned)(d0 * 2 + hi)) ^ krx) << 4));
        if constexpr (wh == 0) R.fq[d0 & 1] = *(const __attribute__((address_space(3))) bf16x8*)(ql + d0 * 1024); }
    else if constexpr (I < 40) { if constexpr (PV) { constexpr int d0 = (I - 24) >> 2, ks = (I - 24) & 3;
        const s16x4 lo = __builtin_bit_cast(s16x4, __builtin_amdgcn_ds_read_tr16_b64_v4i16((__attribute__((address_space(3))) v4i16_t*)(vp + v_rd_off(d0, ks, 0))));
        const s16x4 hh = __builtin_bit_cast(s16x4, __builtin_amdgcn_ds_read_tr16_b64_v4i16((__attribute__((address_space(3))) v4i16_t*)(vp + v_rd_off(d0, ks, 1))));
        R.fa[I % NSL] = (bf16x8){lo[0], lo[1], lo[2], lo[3], hh[0], hh[1], hh[2], hh[3]}; } }
}
template <int I, bool PV, int VAR> __device__ __forceinline__ void seg1_mfma(Seg1Regs& R, f32x16& p0, f32x16& p1, f32x16* o, const bf16x8* qr, const bf16x8 (&pa)[4]) {
    if constexpr (VAR == 2) { asm volatile("" :: "v"(R.fa[I % NSL])); if constexpr (I >= 16 && I < 24) asm volatile("" :: "v"(R.fq[((I - 16) >> 1) & 1])); }
    else if constexpr (I < 16) { constexpr int d0 = I >> 1; if constexpr (I & 1) p1 = __builtin_amdgcn_mfma_f32_32x32x16_bf16(R.fa[I % NSL], qr[d0], p1, 0, 0, 0); else p0 = __builtin_amdgcn_mfma_f32_32x32x16_bf16(R.fa[I % NSL], qr[d0], p0, 0, 0, 0); }
    else if constexpr (I < 24) { constexpr int d0 = (I - 16) >> 1; if constexpr (I & 1) p1 = __builtin_amdgcn_mfma_f32_32x32x16_bf16(R.fa[I % NSL], R.fq[d0 & 1], p1, 0, 0, 0); else p0 = __builtin_amdgcn_mfma_f32_32x32x16_bf16(R.fa[I % NSL], R.fq[d0 & 1], p0, 0, 0, 0); }
    else if constexpr (PV) { constexpr int d0 = (I - 24) >> 2, ks = (I - 24) & 3; o[d0] = __builtin_amdgcn_mfma_f32_32x32x16_bf16(pa[ks], R.fa[I % NSL], o[d0], 0, 0, 0); }
}
template <int I, bool PV, int VAR> __device__ __forceinline__ void seg1_steps(Seg1Regs& R, f32x16& p0, f32x16& p1, f32x16* o, const bf16x8* qr, const bf16x8 (&pa)[4], lcp kn, lcp kr, lcp ql, lcp vp, unsigned kx, unsigned krx, int hi) {
    constexpr int NOPS = PV ? 40 : 24;
    if constexpr (I < NOPS) {
        if constexpr (I + SD < NOPS) seg1_read<I + SD, PV, VAR>(R, kn, kr, ql, vp, kx, krx, hi);
        seg1_mfma<I, PV, VAR>(R, p0, p1, o, qr, pa);
        SBAR();
        seg1_steps<I + 1, PV, VAR>(R, p0, p1, o, qr, pa, kn, kr, ql, vp, kx, krx, hi);
    }
}
template <bool PV, int VAR> __device__ __forceinline__ void seg1(f32x16& p0, f32x16& p1, f32x16* o, const bf16x8* qr, const bf16x8 (&pa)[4], lcp kn, lcp kr, lcp ql, lcp vp, unsigned kx, unsigned krx, int hi) {
    Seg1Regs R; p0 = f32x16{}; p1 = f32x16{};
    seg1_read<0, PV, VAR>(R, kn, kr, ql, vp, kx, krx, hi); seg1_read<1, PV, VAR>(R, kn, kr, ql, vp, kx, krx, hi); seg1_read<2, PV, VAR>(R, kn, kr, ql, vp, kx, krx, hi);
    if constexpr (SD > 3) seg1_read<3, PV, VAR>(R, kn, kr, ql, vp, kx, krx, hi); if constexpr (SD > 4) seg1_read<4, PV, VAR>(R, kn, kr, ql, vp, kx, krx, hi); if constexpr (SD > 5) seg1_read<5, PV, VAR>(R, kn, kr, ql, vp, kx, krx, hi);
    SBAR();
    seg1_steps<0, PV, VAR>(R, p0, p1, o, qr, pa, kn, kr, ql, vp, kx, krx, hi);
}
__device__ __forceinline__ void seg1_pv_only(f32x16* o, const bf16x8 (&pa)[4], lcp vp) {
#pragma unroll
    for (int d0 = 0; d0 < 4; ++d0) { bf16x8 vf[4];
#pragma unroll
        for (int ks = 0; ks < 4; ++ks) { const s16x4 lo = __builtin_bit_cast(s16x4, __builtin_amdgcn_ds_read_tr16_b64_v4i16((__attribute__((address_space(3))) v4i16_t*)(vp + v_rd_off(d0, ks, 0))));
            const s16x4 hh = __builtin_bit_cast(s16x4, __builtin_amdgcn_ds_read_tr16_b64_v4i16((__attribute__((address_space(3))) v4i16_t*)(vp + v_rd_off(d0, ks, 1))));
            vf[ks] = (bf16x8){lo[0], lo[1], lo[2], lo[3], hh[0], hh[1], hh[2], hh[3]}; }
#pragma unroll
        for (int ks = 0; ks < 4; ++ks) o[d0] = __builtin_amdgcn_mfma_f32_32x32x16_bf16(pa[ks], vf[ks], o[d0], 0, 0, 0); }
}
__device__ __forceinline__ void glds16(const void* gsrc, unsigned lds_dst) { unsigned keep;
    asm volatile("s_mov_b32 %0, m0\n\ts_mov_b32 m0, %2\n\ts_nop 0\n\tglobal_load_lds_dwordx4 %1, off\n\ts_mov_b32 m0, %0" : "=&s"(keep) : "v"(gsrc), "s"(lds_dst) : "memory"); }
__device__ __forceinline__ void glds16s(const char* sbase, unsigned voff, unsigned lds_dst) { unsigned keep;
    asm volatile("s_mov_b32 %0, m0\n\ts_mov_b32 m0, %3\n\ts_nop 0\n\tglobal_load_lds_dwordx4 %1, %2\n\ts_mov_b32 m0, %0" : "=&s"(keep) : "v"(voff), "s"(sbase), "s"(lds_dst) : "memory"); }
#define ABAR() asm volatile("s_waitcnt lgkmcnt(0)\n\ts_barrier" ::: "memory")
template <int VAR> __device__ __forceinline__ void softmax_tile(f32x16& p0, f32x16& p1, float& m_reg, float& l_reg, f32x16* o, float* al_l, int r32, int hi, bf16x8 (&pa)[4]) {
    float pm0 = fmaxf(p0[0], p0[1]), pm1 = fmaxf(p0[2], p0[3]);
#pragma unroll
    for (int r = 4; r < 16; r += 2) { pm0 = fmaxf(pm0, p0[r]); pm1 = fmaxf(pm1, p0[r + 1]); }
#pragma unroll
    for (int r = 0; r < 16; r += 2) { pm0 = fmaxf(pm0, p1[r]); pm1 = fmaxf(pm1, p1[r + 1]); }
    float pmax = fmaxf(pm0, pm1);
    { auto rr = __builtin_amdgcn_permlane32_swap(__float_as_uint(pmax), __float_as_uint(pmax), false, false); pmax = fmaxf(__uint_as_float(rr[0]), __uint_as_float(rr[1])); }
    float mn = m_reg, alpha = 1.f;
    if (!__builtin_expect(__all(pmax - m_reg <= THRL), 1)) { mn = fmaxf(m_reg, pmax); alpha = __builtin_amdgcn_exp2f(m_reg - mn); m_reg = mn; }
#pragma unroll
    for (int r = 0; r < 16; ++r) { if constexpr (VAR == 1) { p0[r] = p0[r] - mn; p1[r] = p1[r] - mn; } else { p0[r] = __builtin_amdgcn_exp2f(p0[r] - mn); p1[r] = __builtin_amdgcn_exp2f(p1[r] - mn); } }
    float s0 = p0[0] + p1[0], s1 = p0[1] + p1[1], s2 = p0[2] + p1[2], s3 = p0[3] + p1[3];
#pragma unroll
    for (int r = 4; r < 16; r += 4) { s0 += p0[r] + p1[r]; s1 += p0[r + 1] + p1[r + 1]; s2 += p0[r + 2] + p1[r + 2]; s3 += p0[r + 3] + p1[r + 3]; }
    float ps = (s0 + s1) + (s2 + s3);
    { auto rr = __builtin_amdgcn_permlane32_swap(__float_as_uint(ps), __float_as_uint(ps), false, false); ps = __uint_as_float(rr[0]) + __uint_as_float(rr[1]); }
    l_reg = l_reg * alpha + ps;
#define PK4(P, BASE, OUT) do { unsigned a0 = cvtpk(P[BASE + 0], P[BASE + 1]), a1 = cvtpk(P[BASE + 2], P[BASE + 3]);   \
    unsigned b0 = cvtpk(P[BASE + 4], P[BASE + 5]), b1 = cvtpk(P[BASE + 6], P[BASE + 7]);                              \
    auto r0 = __builtin_amdgcn_permlane32_swap(a0, b0, false, false); auto r1 = __builtin_amdgcn_permlane32_swap(a1, b1, false, false); \
    u32x4 w = {r0[0], r1[0], r0[1], r1[1]}; OUT = *reinterpret_cast<bf16x8*>(&w); } while (0)
    PK4(p0, 0, pa[0]); PK4(p0, 8, pa[1]); PK4(p1, 0, pa[2]); PK4(p1, 8, pa[3]);
#undef PK4
    if (__any(alpha < 1.f)) { if (hi == 0) al_l[r32] = alpha; asm volatile("s_waitcnt lgkmcnt(0)" ::: "memory");
#pragma unroll
        for (int d = 0; d < 4; ++d)
#pragma unroll
            for (int r = 0; r < 16; ++r) o[d][r] *= al_l[crow(r, hi)]; }
}
template <int VAR> __device__ __forceinline__ void attn_unit(const bf16_t* __restrict__ Qn, const bf16_t* __restrict__ Qr, const bf16_t* __restrict__ Kn, const bf16_t* __restrict__ KR, const bf16_t* __restrict__ Vv,
                                          bf16_t* __restrict__ O, long qrow0, long krow0, int h, int seq, LAS unsigned char* ldsl) {
    char* lds = (char*)ldsl;
    const int tid = threadIdx.x, wid = __builtin_amdgcn_readfirstlane(tid >> 6), lane = tid & 63, r32 = lane & 31, hi = lane >> 5;
    const int half = wid >> 2;
    char* V_lds = lds + OFF_V; char* Kn_lds = lds + OFF_KN; char* Kr_lds = lds + OFF_KR;
    float* ws = (float*)(lds + OFF_WS) + wid * 64; float* li_l = ws; float* al_l = ws + 32;
    float m_reg = -1e30f, l_reg = 0; f32x16 o[4] = {}; bf16x8 qr[8]; char* qrl = lds + OFF_QR + wid * 4096 + lane * 16;
    { const bf16_t* qn = Qn + (qrow0 + wid * QBLK + r32) * 1024 + h * 128 + hi * 8; const bf16_t* qp = Qr + (qrow0 + wid * QBLK + r32) * 512 + h * 64 + hi * 8;
#pragma unroll
      for (int d0 = 0; d0 < 8; ++d0) qr[d0] = *reinterpret_cast<const bf16x8*>(qn + d0 * 16);
#pragma unroll
      for (int d0 = 0; d0 < 4; ++d0) *reinterpret_cast<bf16x8*>(qrl + d0 * 1024) = *reinterpret_cast<const bf16x8*>(qp + d0 * 16);
#pragma unroll
      for (int d0 = 0; d0 < 8; ++d0) asm volatile("" :: "v"(qr[d0]));
    }
    const bf16_t* Kh = Kn + krow0 * 1024 + h * 128; const bf16_t* Vh = Vv + krow0 * 1024 + h * 128; const bf16_t* Rh = KR + krow0 * 64;
    unsigned kn_so[2], v_so[2], kr_so;
#pragma unroll
    for (int i = 0; i < 2; ++i) { const int p = 2 * wid + i;
        { const int row = 4 * p + (lane >> 4), pc = lane & 15, lc = pc ^ (row & 15); kn_so[i] = (unsigned)(row * 1024 + lc * 8); }
        { const int st = 2 * p + (lane >> 5), kk = (st >> 2) * 8 + ((lane & 31) >> 2), c = (st & 3) * 32 + (lane & 3) * 8; const int k = (kk & ~0xC) | ((kk & 4) << 1) | ((kk & 8) >> 1); v_so[i] = (unsigned)(k * 1024 + c); } }
    { const int row = 8 * wid + (lane >> 3), pc = lane & 7, lc = pc ^ ((row >> 1) & 7); kr_so = (unsigned)(row * 64 + lc * 8); }
    const int NT = seq / KVBLK;
    const unsigned lds0 = (unsigned)(uintptr_t)ldsl;
    const unsigned dk_ = (unsigned)__builtin_amdgcn_readfirstlane((int)(lds0 + OFF_KN + (2 * wid) * 1024)), dr_ = (unsigned)__builtin_amdgcn_readfirstlane((int)(lds0 + OFF_KR + wid * 1024)), dv_ = (unsigned)__builtin_amdgcn_readfirstlane((int)(lds0 + OFF_V + (2 * wid) * 1024));
#define DMA_K(t, b) do { const bf16_t* Kt_ = Kh + (size_t)(t) * (KVBLK * 1024); const bf16_t* Rt_ = Rh + (size_t)(t) * (KVBLK * 64); \
    glds16(Kt_ + kn_so[0], dk_ + (b) * SHM_KN); glds16(Kt_ + kn_so[1], dk_ + (b) * SHM_KN + 1024); glds16(Rt_ + kr_so, dr_ + (b) * SHM_KR); } while (0)
#define DMA_V(t, b) do { const bf16_t* Vt_ = Vh + (size_t)(t) * (KVBLK * 1024); \
    glds16(Vt_ + v_so[0], dv_ + (b) * SHM_V); glds16(Vt_ + v_so[1], dv_ + (b) * SHM_V + 1024); } while (0)
#define VMW() asm volatile("s_waitcnt vmcnt(0)" ::: "memory")
    f32x16 p0, p1; bf16x8 pa[4] = {};
    { const bf16x8 z = {}; *(bf16x8*)(V_lds + SHM_V + tid * 32) = z; *(bf16x8*)(V_lds + SHM_V + tid * 32 + 16) = z; }
    const lcp kn_l = (lcp)Kn_lds + r32 * 256, kr_l = (lcp)Kr_lds + r32 * 128, ql_l = (lcp)qrl, vp_l = (lcp)V_lds + v_rd_base(lane);
    const unsigned kx = (unsigned)(r32 & 15) << 4, krx = (unsigned)((r32 >> 1) & 7);
    DMA_K(0, 0); VMW();
    ABAR();
    if (half) { DMA_K(1, 1); DMA_V(0, 0); ABAR(); }
    for (int j = 0; j < NT; j += 2) {
        if constexpr (VAR != 4) { if (!half) { DMA_K(j + 1, 1); DMA_V(j, 0); } }
        SBAR(); __builtin_amdgcn_s_setprio(ATT_PRIO_MFMA);
        seg1<true, VAR>(p0, p1, o, qr, pa, kn_l, kr_l, ql_l, vp_l + SHM_V, kx, krx, hi);
        __builtin_amdgcn_s_setprio(ATT_PRIO_VALU); SBAR();
        if (half) VMW();
        ABAR();
        if constexpr (VAR != 4) { if (half) { if (j + 2 < NT) DMA_K(j + 2, 0); DMA_V(j + 1, 1); } }
        softmax_tile<VAR>(p0, p1, m_reg, l_reg, o, al_l, r32, hi, pa);
        if (!half) VMW();
        ABAR();
        if constexpr (VAR != 4) { if (!half) { if (j + 2 < NT) DMA_K(j + 2, 0); DMA_V(j + 1, 1); } }
        SBAR(); __builtin_amdgcn_s_setprio(ATT_PRIO_MFMA);
        seg1<true, VAR>(p0, p1, o, qr, pa, kn_l + SHM_KN, kr_l + SHM_KR, ql_l, vp_l, kx, krx, hi);
        __builtin_amdgcn_s_setprio(ATT_PRIO_VALU); SBAR();
        if (half) VMW();
        ABAR();
        if constexpr (VAR != 4) { if (half) { if (j + 3 < NT) DMA_K(j + 3, 1); if (j + 2 < NT) DMA_V(j + 2, 0); } }
        softmax_tile<VAR>(p0, p1, m_reg, l_reg, o, al_l, r32, hi, pa);
        if (!half) VMW();
        ABAR();
    }
    SBAR(); seg1_pv_only(o, pa, vp_l + SHM_V); SBAR();
    if (!half) ABAR();
    if (hi == 0) li_l[r32] = l_reg; asm volatile("s_waitcnt lgkmcnt(0)" ::: "memory");
    float rli[16];
#pragma unroll
    for (int r = 0; r < 16; ++r) rli[r] = __builtin_amdgcn_rcpf(li_l[crow(r, hi)]);
    bf16_t* Ow = O + (qrow0 + wid * QBLK) * 1024 + h * 128;
#pragma unroll
    for (int r = 0; r < 16; ++r) { const int orow = crow(r, hi);
#pragma unroll
        for (int d0 = 0; d0 < 4; ++d0) Ow[(long)orow * 1024 + d0 * 32 + r32] = (bf16_t)(cvtpk(o[d0][r] * rli[r], 0.f) & 0xffffu); }
    asm volatile("s_waitcnt vmcnt(0)" ::: "memory");
    __syncthreads();
#undef DMA_K
#undef DMA_V
#undef VMW
}
typedef int v8i __attribute__((ext_vector_type(8)));
constexpr int F_SHM_K = 12288, F_SHM_V = 8192, F_OFF_V = 0, F_OFF_K = 2 * F_SHM_V, F_OFF_WS = F_OFF_K + 2 * F_SHM_K, F_LDS_BYTES = F_OFF_WS + NW * 64 * 4;
constexpr int FOPS = 10;
#ifndef ATT_FD
#define ATT_FD 3
#endif
constexpr int FD = ATT_FD, FSL = ATT_FD + 1;
struct Seg1F { v8i fk[FSL]; };
template <int I> __device__ __forceinline__ void seg1f_read(Seg1F& R, lcp k8, lcp vp, unsigned x0, unsigned x1) {
    if constexpr (I < 6) { constexpr int c = I >> 1, wh = I & 1; const lcp b = k8 + c * 4096 + wh * 2048;
        const u32x4 lo = *(const __attribute__((address_space(3))) u32x4*)(b + x0), hh = *(const __attribute__((address_space(3))) u32x4*)(b + x1);
        R.fk[I % FSL] = (v8i){(int)lo.x, (int)lo.y, (int)lo.z, (int)lo.w, (int)hh.x, (int)hh.y, (int)hh.z, (int)hh.w}; }
    else if constexpr (I < FOPS) { constexpr int d0 = I - 6; const lcp b = vp + d0 * 2048;
        const u32x4 lo = *(const __attribute__((address_space(3))) u32x4*)(b + x0), hh = *(const __attribute__((address_space(3))) u32x4*)(b + x1);
        R.fk[I % FSL] = (v8i){(int)lo.x, (int)lo.y, (int)lo.z, (int)lo.w, (int)hh.x, (int)hh.y, (int)hh.z, (int)hh.w}; }
}
template <int I> __device__ __forceinline__ void seg1f_mfma(Seg1F& R, f32x16& p0, f32x16& p1, f32x16* o, const v8i (&q8)[3], const v8i& pa) {
    if constexpr (I == 0) asm volatile("v_mfma_f32_32x32x64_f8f6f4 %0, %1, %2, 0" : "=v"(p0) : "v"(R.fk[I % FSL]), "v"(q8[0]));
    else if constexpr (I == 1) asm volatile("v_mfma_f32_32x32x64_f8f6f4 %0, %1, %2, 0" : "=v"(p1) : "v"(R.fk[I % FSL]), "v"(q8[0]));
    else if constexpr (I < 6) { constexpr int c = I >> 1;
        if constexpr (I & 1) asm volatile("v_mfma_f32_32x32x64_f8f6f4 %0, %1, %2, %0" : "+v"(p1) : "v"(R.fk[I % FSL]), "v"(q8[c]));
        else asm volatile("v_mfma_f32_32x32x64_f8f6f4 %0, %1, %2, %0" : "+v"(p0) : "v"(R.fk[I % FSL]), "v"(q8[c])); }
    else { constexpr int d0 = I - 6; asm volatile("v_mfma_f32_32x32x64_f8f6f4 %0, %1, %2, %0" : "+v"(o[d0]) : "v"(pa), "v"(R.fk[I % FSL])); }
}
template <int I> __device__ __forceinline__ void seg1f_steps(Seg1F& R, f32x16& p0, f32x16& p1, f32x16* o, const v8i (&q8)[3], const v8i& pa, lcp k8, lcp vp, unsigned x0, unsigned x1) {
    if constexpr (I < FOPS) {
        if constexpr (I + FD < FOPS) seg1f_read<I + FD>(R, k8, vp, x0, x1);
        seg1f_mfma<I>(R, p0, p1, o, q8, pa);
        SBAR();
        seg1f_steps<I + 1>(R, p0, p1, o, q8, pa, k8, vp, x0, x1);
    }
}
__device__ __forceinline__ void seg1f(f32x16& p0, f32x16& p1, f32x16* o, const v8i (&q8)[3], const v8i& pa, lcp k8, lcp vp, unsigned x0, unsigned x1) {
    Seg1F R; p0 = f32x16{}; p1 = f32x16{};
    seg1f_read<0>(R, k8, vp, x0, x1); if constexpr (FD > 1) seg1f_read<1>(R, k8, vp, x0, x1); if constexpr (FD > 2) seg1f_read<2>(R, k8, vp, x0, x1); if constexpr (FD > 3) seg1f_read<3>(R, k8, vp, x0, x1); if constexpr (FD > 4) seg1f_read<4>(R, k8, vp, x0, x1); if constexpr (FD > 5) seg1f_read<5>(R, k8, vp, x0, x1);
    SBAR();
    seg1f_steps<0>(R, p0, p1, o, q8, pa, k8, vp, x0, x1);
}
template <int SINV8> __device__ __forceinline__ void softmax_tile_s(f32x16& p0, f32x16& p1, float& m_reg, float& l_reg, f32x16* o, float* al_l, int r32, int hi, v8i& pa) {
    constexpr float C = 1.0f / Q8MUL;
    float pm0 = fmaxf(p0[0], p0[1]), pm1 = fmaxf(p0[2], p0[3]);
#pragma unroll
    for (int r = 4; r < 16; r += 2) { pm0 = fmaxf(pm0, p0[r]); pm1 = fmaxf(pm1, p0[r + 1]); }
#pragma unroll
    for (int r = 0; r < 16; r += 2) { pm0 = fmaxf(pm0, p1[r]); pm1 = fmaxf(pm1, p1[r + 1]); }
    float pmax = fmaxf(pm0, pm1);
    { auto rr = __builtin_amdgcn_permlane32_swap(__float_as_uint(pmax), __float_as_uint(pmax), false, false); pmax = fmaxf(__uint_as_float(rr[0]), __uint_as_float(rr[1])); }
    float mn = m_reg, alpha = 1.f;
    if (!__builtin_expect(__all(pmax - m_reg <= THRL8 * Q8MUL), 1)) { mn = fmaxf(m_reg, pmax); alpha = __builtin_amdgcn_exp2f((m_reg - mn) * C); m_reg = mn; }
    const float mc = -mn * C;
#pragma unroll
    for (int r = 0; r < 16; ++r) { if constexpr (SINV8 == 2) { p0[r] = fmaf(p0[r], C, mc); p1[r] = fmaf(p1[r], C, mc); } else if constexpr (SINV8 == 3) { p0[r] = __builtin_amdgcn_exp2f(p0[r]); p1[r] = __builtin_amdgcn_exp2f(p1[r]); } else { p0[r] = __builtin_amdgcn_exp2f(fmaf(p0[r], C, mc)); p1[r] = __builtin_amdgcn_exp2f(fmaf(p1[r], C, mc)); } }
    float s0 = p0[0] + p1[0], s1 = p0[1] + p1[1], s2 = p0[2] + p1[2], s3 = p0[3] + p1[3];
#pragma unroll
    for (int r = 4; r < 16; r += 4) { s0 += p0[r] + p1[r]; s1 += p0[r + 1] + p1[r + 1]; s2 += p0[r + 2] + p1[r + 2]; s3 += p0[r + 3] + p1[r + 3]; }
    float ps = (s0 + s1) + (s2 + s3);
    { auto rr = __builtin_amdgcn_permlane32_swap(__float_as_uint(ps), __float_as_uint(ps), false, false); ps = __uint_as_float(rr[0]) + __uint_as_float(rr[1]); }
    l_reg = l_reg * alpha + ps;
#pragma unroll
    for (int j = 0; j < 4; ++j) { int a = __builtin_amdgcn_cvt_pk_fp8_f32(p0[4 * j], p0[4 * j + 1], 0, false); a = __builtin_amdgcn_cvt_pk_fp8_f32(p0[4 * j + 2], p0[4 * j + 3], a, true); pa[j] = a;
        int c = __builtin_amdgcn_cvt_pk_fp8_f32(p1[4 * j], p1[4 * j + 1], 0, false); c = __builtin_amdgcn_cvt_pk_fp8_f32(p1[4 * j + 2], p1[4 * j + 3], c, true); pa[4 + j] = c; }
    if (__any(alpha < 1.f)) { if (hi == 0) al_l[r32] = alpha; asm volatile("s_waitcnt lgkmcnt(0)" ::: "memory");
#pragma unroll
        for (int d = 0; d < 4; ++d)
#pragma unroll
            for (int r = 0; r < 16; ++r) o[d][r] *= al_l[crow(r, hi)]; }
}
template <int VARF> __device__ __forceinline__ void attn_unit_f8(const unsigned char* __restrict__ Qn8, const unsigned char* __restrict__ Qr8, const unsigned char* __restrict__ Kn8, const unsigned char* __restrict__ KR8, const unsigned char* __restrict__ VT8,
                                             bf16_t* __restrict__ O, long qrow0, long krow0, int h, int seq, LAS unsigned char* ldsl) {
    char* lds = (char*)ldsl;
    const int tid = threadIdx.x, wid = __builtin_amdgcn_readfirstlane(tid >> 6), lane = tid & 63, r32 = lane & 31, hi = lane >> 5;
    const int half = wid >> 2;
    char* V_lds = lds + F_OFF_V; char* K_lds = lds + F_OFF_K;
    float* ws = (float*)(lds + F_OFF_WS) + wid * 64; float* li_l = ws; float* al_l = ws + 32;
    float m_reg = -1e30f, l_reg = 0; f32x16 o[4] = {}; v8i q8[3];
    { const unsigned char* qn = Qn8 + (qrow0 + wid * QBLK + r32) * 1024 + h * 128 + hi * 32; const unsigned char* qp = Qr8 + (qrow0 + wid * QBLK + r32) * 512 + h * 64 + hi * 32;
#pragma unroll
      for (int c = 0; c < 3; ++c) { const unsigned char* s = c < 2 ? qn + c * 64 : qp; const u32x4 lo = *(const u32x4*)s, hh = *(const u32x4*)(s + 16);
          q8[c] = (v8i){(int)lo.x, (int)lo.y, (int)lo.z, (int)lo.w, (int)hh.x, (int)hh.y, (int)hh.z, (int)hh.w}; }
#pragma unroll
      for (int c = 0; c < 3; ++c) asm volatile("" :: "v"(q8[c]));
    }
    const unsigned char* Kh = Kn8 + krow0 * 1024 + h * 128; const unsigned char* Vh = VT8 + ((size_t)(krow0 >> 13) * 1024 + h * 128) * 8192; const unsigned char* Rh = KR8 + krow0 * 64;
    unsigned kso0, kso1, vso;
    { const int key = 16 * (wid & 3) + (lane >> 2), pc = lane & 3, lc = pc ^ ((key >> 2) & 3); kso0 = (unsigned)(key * 1024 + (wid >> 2) * 64 + lc * 16); kso1 = (unsigned)(key * 64 + lc * 16); }
    { const int d = 16 * wid + (lane >> 2), pc = lane & 3, lc = pc ^ ((d >> 2) & 3); vso = (unsigned)(d * 8192 + lc * 16); }
    const int NT = seq / KVBLK;
    const unsigned lds0 = (unsigned)(uintptr_t)ldsl;
    const unsigned dk_ = (unsigned)__builtin_amdgcn_readfirstlane((int)(lds0 + F_OFF_K + wid * 1024)), dv_ = (unsigned)__builtin_amdgcn_readfirstlane((int)(lds0 + F_OFF_V + wid * 1024));
#define DMA_K(t, b) do { glds16(Kh + (size_t)(t) * (KVBLK * 1024) + kso0, dk_ + (b) * F_SHM_K); if (wid < 4) glds16(Rh + (size_t)(t) * (KVBLK * 64) + kso1, dk_ + (b) * F_SHM_K + 8192); } while (0)
#define DMA_V(t, b) do { glds16(Vh + (size_t)(t) * KVBLK + vso, dv_ + (b) * F_SHM_V); } while (0)
#define VMW() asm volatile("s_waitcnt vmcnt(0)" ::: "memory")
    f32x16 p0, p1; v8i pa = {};
    { const bf16x8 z = {}; *(bf16x8*)(V_lds + F_SHM_V + tid * 16) = z; }
    const lcp k8_l = (lcp)K_lds + r32 * 64, vp_l = (lcp)V_lds + r32 * 64;
    const unsigned sw = (unsigned)((r32 >> 2) & 3), x0 = ((2u * hi) ^ sw) << 4, x1 = ((2u * hi + 1u) ^ sw) << 4;
    DMA_K(0, 0); VMW();
    ABAR();
    if (half) { DMA_K(1, 1); DMA_V(0, 0); ABAR(); }
    for (int j = 0; j < NT; j += 2) {
        if (!half) { DMA_K(j + 1, 1); DMA_V(j, 0); }
        SBAR(); __builtin_amdgcn_s_setprio(ATT_PRIO_MFMA);
        seg1f(p0, p1, o, q8, pa, k8_l, vp_l + F_SHM_V, x0, x1);
        __builtin_amdgcn_s_setprio(ATT_PRIO_VALU); SBAR();
        if (half) VMW();
        ABAR();
        if (half) { if (j + 2 < NT) DMA_K(j + 2, 0); DMA_V(j + 1, 1); }
        softmax_tile_s<VARF>(p0, p1, m_reg, l_reg, o, al_l, r32, hi, pa);
        if (!half) VMW();
        ABAR();
        if (!half) { if (j + 2 < NT) DMA_K(j + 2, 0); DMA_V(j + 1, 1); }
        SBAR(); __builtin_amdgcn_s_setprio(ATT_PRIO_MFMA);
        seg1f(p0, p1, o, q8, pa, k8_l + F_SHM_K, vp_l, x0, x1);
        __builtin_amdgcn_s_setprio(ATT_PRIO_VALU); SBAR();
        if (half) VMW();
        ABAR();
        if (half) { if (j + 3 < NT) DMA_K(j + 3, 1); if (j + 2 < NT) DMA_V(j + 2, 0); }
        softmax_tile_s<VARF>(p0, p1, m_reg, l_reg, o, al_l, r32, hi, pa);
        if (!half) VMW();
        ABAR();
    }
    SBAR();
#pragma unroll
    for (int d0 = 0; d0 < 4; ++d0) { const lcp b = vp_l + F_SHM_V + d0 * 2048; const u32x4 lo = *(const __attribute__((address_space(3))) u32x4*)(b + x0), hh = *(const __attribute__((address_space(3))) u32x4*)(b + x1);
        const v8i vf = (v8i){(int)lo.x, (int)lo.y, (int)lo.z, (int)lo.w, (int)hh.x, (int)hh.y, (int)hh.z, (int)hh.w}; o[d0] = __builtin_amdgcn_mfma_scale_f32_32x32x64_f8f6f4(pa, vf, o[d0], 0, 0, 0, 0, 0, 0); }
    SBAR();
    if (!half) ABAR();
    if (hi == 0) li_l[r32] = l_reg; asm volatile("s_waitcnt lgkmcnt(0)" ::: "memory");
    float rli[16];
#pragma unroll
    for (int r = 0; r < 16; ++r) rli[r] = __builtin_amdgcn_rcpf(li_l[crow(r, hi)]);
    bf16_t* Ow = O + (qrow0 + wid * QBLK) * 1024 + h * 128;
#pragma unroll
    for (int r = 0; r < 16; ++r) { const int orow = crow(r, hi);
#pragma unroll
        for (int d0 = 0; d0 < 4; ++d0) { if (OB_FP8) ((unsigned char*)O)[((qrow0 + wid * QBLK + orow) * 1024 + h * 128) + d0 * 32 + r32] = (unsigned char)(__builtin_amdgcn_cvt_pk_fp8_f32(o[d0][r] * rli[r] * O8MUL, 0.f, 0, false) & 0xff); else Ow[(long)orow * 1024 + d0 * 32 + r32] = (bf16_t)(cvtpk(o[d0][r] * rli[r], 0.f) & 0xffffu); } }
    asm volatile("s_waitcnt vmcnt(0)" ::: "memory");
    __syncthreads();
#undef DMA_K
#undef DMA_V
#undef VMW
}
constexpr int W_SHM_K = 2 * F_SHM_K, W_SHM_V = 2 * F_SHM_V, W_OFF_V = 0, W_OFF_K = 2 * W_SHM_V, W_OFF_WS = W_OFF_K + 2 * W_SHM_K, W_LDS_BYTES = W_OFF_WS + NW * 64 * 4;
constexpr int X_OFF_V = 0, X_OFF_K = 3 * W_SHM_V, X_OFF_WS = X_OFF_K + 3 * W_SHM_K, X_LDS_BYTES = X_OFF_WS + NW * 64 * 4;
constexpr int WOPS = 20;
template <int I> __device__ __forceinline__ void seg1w_read(Seg1F& R, lcp k8, lcp vp, unsigned x0, unsigned x1) {
    if constexpr (I < 12) { constexpr int sub = I / 6, c = (I % 6) >> 1, wh = I & 1; const lcp b = k8 + sub * F_SHM_K + c * 4096 + wh * 2048;
        const u32x4 lo = *(const __attribute__((address_space(3))) u32x4*)(b + x0), hh = *(const __attribute__((address_space(3))) u32x4*)(b + x1);
        R.fk[I % FSL] = (v8i){(int)lo.x, (int)lo.y, (int)lo.z, (int)lo.w, (int)hh.x, (int)hh.y, (int)hh.z, (int)hh.w}; }
    else if constexpr (I < WOPS) { constexpr int sub = (I - 12) >> 2, d0 = (I - 12) & 3; const lcp b = vp + sub * F_SHM_V + d0 * 2048;
        const u32x4 lo = *(const __attribute__((address_space(3))) u32x4*)(b + x0), hh = *(const __attribute__((address_space(3))) u32x4*)(b + x1);
        R.fk[I % FSL] = (v8i){(int)lo.x, (int)lo.y, (int)lo.z, (int)lo.w, (int)hh.x, (int)hh.y, (int)hh.z, (int)hh.w}; }
}
template <int I> __device__ __forceinline__ void seg1w_mfma(Seg1F& R, f32x16 (&s)[4], f32x16* o, const v8i (&q8)[3], const v8i (&pa)[2]) {
    if constexpr (I < 12) { constexpr int sub = I / 6, c = (I % 6) >> 1, wh = I & 1;
        if constexpr (c == 0) asm volatile("v_mfma_f32_32x32x64_f8f6f4 %0, %1, %2, 0" : "=v"(s[2 * sub + wh]) : "v"(R.fk[I % FSL]), "v"(q8[0]));
        else asm volatile("v_mfma_f32_32x32x64_f8f6f4 %0, %1, %2, %0" : "+v"(s[2 * sub + wh]) : "v"(R.fk[I % FSL]), "v"(q8[c])); }
    else { constexpr int sub = (I - 12) >> 2, d0 = (I - 12) & 3; asm volatile("v_mfma_f32_32x32x64_f8f6f4 %0, %1, %2, %0" : "+v"(o[d0]) : "v"(pa[sub]), "v"(R.fk[I % FSL])); }
}
template <int I> __device__ __forceinline__ void seg1w_steps(Seg1F& R, f32x16 (&s)[4], f32x16* o, const v8i (&q8)[3], const v8i (&pa)[2], lcp k8, lcp vp, unsigned x0, unsigned x1) {
    if constexpr (I < WOPS) {
        if constexpr (I + FD < WOPS) seg1w_read<I + FD>(R, k8, vp, x0, x1);
        seg1w_mfma<I>(R, s, o, q8, pa);
        SBAR();
        seg1w_steps<I + 1>(R, s, o, q8, pa, k8, vp, x0, x1);
    }
}
__device__ __forceinline__ void seg1w(f32x16 (&s)[4], f32x16* o, const v8i (&q8)[3], const v8i (&pa)[2], lcp k8, lcp vp, unsigned x0, unsigned x1) {
    Seg1F R;
    seg1w_read<0>(R, k8, vp, x0, x1); if constexpr (FD > 1) seg1w_read<1>(R, k8, vp, x0, x1); if constexpr (FD > 2) seg1w_read<2>(R, k8, vp, x0, x1); if constexpr (FD > 3) seg1w_read<3>(R, k8, vp, x0, x1); if constexpr (FD > 4) seg1w_read<4>(R, k8, vp, x0, x1); if constexpr (FD > 5) seg1w_read<5>(R, k8, vp, x0, x1);
    SBAR();
    seg1w_steps<0>(R, s, o, q8, pa, k8, vp, x0, x1);
}
typedef short v2s_t __attribute__((ext_vector_type(2)));
__device__ __forceinline__ int cvt4_scale(float a, float b, float c, float d, float scale) {
    v2s_t x = {0, 0}; x = __builtin_amdgcn_cvt_scalef32_pk_fp8_f32(x, a, b, scale, false); x = __builtin_amdgcn_cvt_scalef32_pk_fp8_f32(x, c, d, scale, true);
    return __builtin_bit_cast(int, x); }
__device__ __forceinline__ void softmax_tile_w(f32x16 (&s)[4], float& m_reg, float& l_reg, f32x16* o, float* al_l, int r32, int hi, v8i (&pa)[2]) {
    float pm0 = fmaxf(s[0][0], s[0][1]), pm1 = fmaxf(s[0][2], s[0][3]);
#pragma unroll
    for (int r = 4; r < 16; r += 2) { pm0 = fmaxf(pm0, s[0][r]); pm1 = fmaxf(pm1, s[0][r + 1]); }
#pragma unroll
    for (int v = 1; v < 4; ++v)
#pragma unroll
        for (int r = 0; r < 16; r += 2) { pm0 = fmaxf(pm0, s[v][r]); pm1 = fmaxf(pm1, s[v][r + 1]); }
    float pmax = fmaxf(pm0, pm1);
    { auto rr = __builtin_amdgcn_permlane32_swap(__float_as_uint(pmax), __float_as_uint(pmax), false, false); pmax = fmaxf(__uint_as_float(rr[0]), __uint_as_float(rr[1])); }
    float alpha = 1.f;
    if (!__builtin_expect(__all(pmax - m_reg <= THRL8), 1)) { const float mn = fmaxf(m_reg, __builtin_ceilf(pmax)); alpha = __builtin_amdgcn_exp2f(m_reg - mn); m_reg = mn; }
    float M = m_reg;
    if (!__builtin_expect(__all(fabsf(M) <= 90.f), 1)) {
#pragma unroll
        for (int v = 0; v < 4; ++v)
#pragma unroll
            for (int r = 0; r < 16; ++r) s[v][r] -= M;
        M = 0.f; }
    const int Mi = (int)M; const float scale = __uint_as_float((unsigned)(Mi + 127) << 23), iscale = __uint_as_float((unsigned)(127 - Mi) << 23);
#pragma unroll
    for (int v = 0; v < 4; ++v)
#pragma unroll
        for (int r = 0; r < 16; ++r) s[v][r] = __builtin_amdgcn_exp2f(s[v][r]);
    float s0 = 0.f, s1 = 0.f, s2 = 0.f, s3 = 0.f;
#pragma unroll
    for (int v = 0; v < 4; ++v)
#pragma unroll
        for (int r = 0; r < 16; r += 4) { s0 += s[v][r]; s1 += s[v][r + 1]; s2 += s[v][r + 2]; s3 += s[v][r + 3]; }
    float ps = ((s0 + s1) + (s2 + s3)) * iscale;
#pragma unroll
    for (int sub = 0; sub < 2; ++sub)
#pragma unroll
        for (int j = 0; j < 4; ++j) { const f32x16& a = s[2 * sub]; const f32x16& b = s[2 * sub + 1];
            pa[sub][j] = cvt4_scale(a[4 * j], a[4 * j + 1], a[4 * j + 2], a[4 * j + 3], scale); pa[sub][4 + j] = cvt4_scale(b[4 * j], b[4 * j + 1], b[4 * j + 2], b[4 * j + 3], scale); }
    { auto rr = __builtin_amdgcn_permlane32_swap(__float_as_uint(ps), __float_as_uint(ps), false, false); ps = __uint_as_float(rr[0]) + __uint_as_float(rr[1]); }
    l_reg = l_reg * alpha + ps;
    if (__any(alpha < 1.f)) { if (hi == 0) al_l[r32] = alpha; asm volatile("s_nop 15\n\ts_nop 15\n\ts_waitcnt lgkmcnt(0)" ::: "memory");
#pragma unroll
        for (int d = 0; d < 4; ++d)
#pragma unroll
            for (int r = 0; r < 16; ++r) o[d][r] *= al_l[crow(r, hi)]; }
}
__device__ __forceinline__ void attn_unit_f8w(const unsigned char* __restrict__ Qn8, const unsigned char* __restrict__ Qr8, const unsigned char* __restrict__ Kn8, const unsigned char* __restrict__ KR8, const unsigned char* __restrict__ VT8,
                                              bf16_t* __restrict__ O, long qrow0, long krow0, int h, int seq, LAS unsigned char* ldsl) {
    char* lds = (char*)ldsl;
    const int tid = threadIdx.x, wid = __builtin_amdgcn_readfirstlane(tid >> 6), lane = tid & 63, r32 = lane & 31, hi = lane >> 5;
    const int half = wid >> 2;
    char* V_lds = lds + X_OFF_V; char* K_lds = lds + X_OFF_K;
    float* ws = (float*)(lds + X_OFF_WS) + wid * 64; float* li_l = ws; float* al_l = ws + 32;
    float m_reg = -1e30f, l_reg = 0; f32x16 o[4] = {}; v8i q8[3];
    { const unsigned char* qn = Qn8 + (qrow0 + wid * QBLK + r32) * 1024 + h * 128 + hi * 32; const unsigned char* qp = Qr8 + (qrow0 + wid * QBLK + r32) * 512 + h * 64 + hi * 32;
#pragma unroll
      for (int c = 0; c < 3; ++c) { const unsigned char* s = c < 2 ? qn + c * 64 : qp; const u32x4 lo = *(const u32x4*)s, hh = *(const u32x4*)(s + 16);
          q8[c] = (v8i){(int)lo.x, (int)lo.y, (int)lo.z, (int)lo.w, (int)hh.x, (int)hh.y, (int)hh.z, (int)hh.w}; }
#pragma unroll
      for (int c = 0; c < 3; ++c) asm volatile("" :: "v"(q8[c]));
    }
    const unsigned char* Kh = Kn8 + krow0 * 1024 + h * 128; const unsigned char* Vh = VT8 + ((size_t)(krow0 >> 13) * 1024 + h * 128) * 8192; const unsigned char* Rh = KR8 + krow0 * 64;
    unsigned kso0, kso1, vso;
    { const int key = 16 * (wid & 3) + (lane >> 2), pc = lane & 3, lc = pc ^ ((key >> 2) & 3); kso0 = (unsigned)(key * 1024 + (wid >> 2) * 64 + lc * 16); kso1 = (unsigned)(key * 64 + lc * 16); }
    { const int d = 16 * wid + (lane >> 2), pc = lane & 3, lc = pc ^ ((d >> 2) & 3); vso = (unsigned)(d * 8192 + lc * 16); }
    const int NT = seq / (2 * KVBLK);
    const unsigned lds0 = (unsigned)(uintptr_t)ldsl;
    const unsigned dr_ = (unsigned)__builtin_amdgcn_readfirstlane((int)(lds0 + X_OFF_K + 8192 + (wid & 3) * 1024));
    const unsigned dk_ = (unsigned)__builtin_amdgcn_readfirstlane((int)(lds0 + X_OFF_K + wid * 1024)), dv_ = (unsigned)__builtin_amdgcn_readfirstlane((int)(lds0 + X_OFF_V + wid * 1024));
#define DMA_K(t, sl) do { _Pragma("unroll") for (int sb_ = 0; sb_ < 2; ++sb_) { glds16s((const char*)Kh + (size_t)(2 * (t) + sb_) * (KVBLK * 1024), kso0, dk_ + (sl) * W_SHM_K + sb_ * F_SHM_K); if ((wid >> 2) == sb_) glds16s((const char*)Rh + (size_t)(2 * (t) + sb_) * (KVBLK * 64), kso1, dr_ + (sl) * W_SHM_K + sb_ * F_SHM_K); } } while (0)
#define DMA_V(t, sl) do { _Pragma("unroll") for (int sb_ = 0; sb_ < 2; ++sb_) glds16s((const char*)Vh + (size_t)(2 * (t) + sb_) * KVBLK, vso, dv_ + (sl) * W_SHM_V + sb_ * F_SHM_V); } while (0)
    f32x16 s[4]; v8i pa[2] = {};
    { const bf16x8 z = {}; *(bf16x8*)(V_lds + 2 * W_SHM_V + tid * 32) = z; *(bf16x8*)(V_lds + 2 * W_SHM_V + tid * 32 + 16) = z; }
    const lcp k8_l = (lcp)K_lds + r32 * 64, vp_l = (lcp)V_lds + r32 * 64;
    const unsigned sw = (unsigned)((r32 >> 2) & 3), x0 = ((2u * hi) ^ sw) << 4, x1 = ((2u * hi + 1u) ^ sw) << 4;
    DMA_K(0, 0); DMA_K(1, 1); DMA_V(0, 0);
    asm volatile("s_waitcnt vmcnt(0)" ::: "memory");
    ABAR();
    if (half) ABAR();
    const int nkp = 3;
    int ks = 0, vs = 2;
    if (!half) __builtin_amdgcn_s_setprio(1);
    for (int j = 0; j < NT; ++j) {
        SBAR();
        seg1w(s, o, q8, pa, k8_l + ks * W_SHM_K, vp_l + vs * W_SHM_V, x0, x1);
        SBAR();
        if (half) asm volatile("s_waitcnt vmcnt(0)" ::: "memory");
        ABAR();
        { int k2 = ks + 2; k2 = k2 >= 3 ? k2 - 3 : k2; int v2 = vs + 2; v2 = v2 >= 3 ? v2 - 3 : v2;
          const bool ik = j + 2 < NT, iv = j + 1 < NT;
          if (ik) DMA_K(j + 2, k2); if (iv) DMA_V(j + 1, v2);
          softmax_tile_w(s, m_reg, l_reg, o, al_l, r32, hi, pa);
          if (!half) { const int n = (ik ? nkp : 0) + (iv ? 2 : 0);
              if (n == 5) asm volatile("s_waitcnt vmcnt(5)" ::: "memory"); else if (n == 3) asm volatile("s_waitcnt vmcnt(3)" ::: "memory"); else if (n == 2) asm volatile("s_waitcnt vmcnt(2)" ::: "memory"); else asm volatile("s_waitcnt vmcnt(0)" ::: "memory"); } }
        ABAR();
        ks = ks + 1 >= 3 ? 0 : ks + 1; vs = vs + 1 >= 3 ? 0 : vs + 1;
    }
    __builtin_amdgcn_s_setprio(0);
    SBAR();
#pragma unroll
    for (int sub = 0; sub < 2; ++sub)
#pragma unroll
        for (int d0 = 0; d0 < 4; ++d0) { const lcp b = vp_l + vs * W_SHM_V + sub * F_SHM_V + d0 * 2048; const u32x4 lo = *(const __attribute__((address_space(3))) u32x4*)(b + x0), hh = *(const __attribute__((address_space(3))) u32x4*)(b + x1);
            const v8i vf = (v8i){(int)lo.x, (int)lo.y, (int)lo.z, (int)lo.w, (int)hh.x, (int)hh.y, (int)hh.z, (int)hh.w}; o[d0] = __builtin_amdgcn_mfma_scale_f32_32x32x64_f8f6f4(pa[sub], vf, o[d0], 0, 0, 0, 0, 0, 0); }
    SBAR();
    if (!half) ABAR();
    if (hi == 0) li_l[r32] = l_reg; asm volatile("s_waitcnt lgkmcnt(0)" ::: "memory");
    float rli[16];
#pragma unroll
    for (int r = 0; r < 16; ++r) rli[r] = __builtin_amdgcn_rcpf(li_l[crow(r, hi)]);
    bf16_t* Ow = O + (qrow0 + wid * QBLK) * 1024 + h * 128;
#pragma unroll
    for (int r = 0; r < 16; ++r) { const int orow = crow(r, hi);
#pragma unroll
        for (int d0 = 0; d0 < 4; ++d0) { if (OB_FP8) ((unsigned char*)O)[((qrow0 + wid * QBLK + orow) * 1024 + h * 128) + d0 * 32 + r32] = (unsigned char)(__builtin_amdgcn_cvt_pk_fp8_f32(o[d0][r] * rli[r] * O8MUL, 0.f, 0, false) & 0xff); else Ow[(long)orow * 1024 + d0 * 32 + r32] = (bf16_t)(cvtpk(o[d0][r] * rli[r], 0.f) & 0xffffu); } }
    asm volatile("s_waitcnt vmcnt(0)" ::: "memory");
    __syncthreads();
#undef DMA_K
#undef DMA_V
}
#undef ABAR
#undef SBAR
}

constexpr size_t MiB = 1u << 20;
constexpr size_t WS_CTL = 0, CTL_ZERO_BYTES = 1 * MiB;
constexpr size_t WS_WIN = 1 * MiB;
constexpr size_t WS_WA = 11 * MiB, WS_WB = 13 * MiB, WS_WO = 15 * MiB;
constexpr size_t WS_WUQ = 17 * MiB;
constexpr size_t WS_WUKV = 19 * MiB;
constexpr size_t WS_WR = 20 * MiB;
constexpr size_t WS_WS = 21 * MiB;
constexpr size_t WS_COS = 22 * MiB, WS_SIN = 24 * MiB;
constexpr size_t WS_RS = 26 * MiB;
constexpr size_t WS_TOPW = 28 * MiB;
constexpr size_t WS_LIST = 29 * MiB;
constexpr size_t WS_WGU = 45 * MiB;
constexpr size_t WS_WD = 302 * MiB;
constexpr size_t WS_PRE = 431 * MiB;
constexpr size_t WS_H1B = 495 * MiB;
constexpr size_t WS_LOG = 527 * MiB;
constexpr size_t WS_RB = 543 * MiB;
constexpr size_t WS_YA = WS_RB, WS_O = WS_RB + 32 * MiB, WS_M = WS_RB + 64 * MiB, WS_ACT = WS_RB;
constexpr size_t WS_RA = 647 * MiB;
constexpr size_t WS_XB = WS_RA, WS_U = WS_RA + 32 * MiB, WS_VG = WS_RA + 64 * MiB, WS_GA = WS_RA + 96 * MiB, WS_GB = WS_RA + 128 * MiB;
constexpr size_t WS_C3 = WS_RA + 160 * MiB, WS_KR = WS_RA + 184 * MiB, WS_QN = WS_RA + 186 * MiB, WS_QR = WS_RA + 218 * MiB;
constexpr size_t WS_KN = WS_RA + 234 * MiB, WS_VV = WS_RA + 266 * MiB, WS_SG = WS_RA + 298 * MiB;
constexpr size_t WS_YP = WS_RA, WS_YS = WS_RA + 256 * MiB;
constexpr size_t WS_END = WS_RA + 330 * MiB;
static_assert(WS_END <= 1024 * MiB, "d_ws map");
constexpr int CW_CNT = 65536, CNT_STRIDE = 64;
constexpr int CW_BAR = 4096;

constexpr int RING_BYTES = 131072;
constexpr int LDSCTL_OFF = RING_BYTES, MISC_OFF = LDSCTL_OFF + 320;
constexpr int TAB_OFF = RING_BYTES + 512;
constexpr int LDS_BYTES = 147456;

typedef GAS unsigned gu32;
#define RLX_AGENT __ATOMIC_RELAXED, __HIP_MEMORY_SCOPE_AGENT

#define XB_TMO      128
#define XB_XCNT(j)  (256  + 64 * (j))
#define XB_XSUB(j)  (1280 + 64 * (j))
#define XB_XGEN(j)  (2304 + 64 * (j))
#define XB_TOP      3328
#define XB_TOPGEN   3392
#define XCD_BAR_WORDS 3456
#define XB_SPIN_CAP (1u << 22)
__device__ __forceinline__ unsigned xb_ld(unsigned* p)              { return __hip_atomic_load(p, __ATOMIC_RELAXED, __HIP_MEMORY_SCOPE_AGENT); }
__device__ __forceinline__ unsigned xb_add(unsigned* p, unsigned v) { return __hip_atomic_fetch_add(p, v, __ATOMIC_RELAXED, __HIP_MEMORY_SCOPE_AGENT); }
__device__ __forceinline__ unsigned xb_xcc_id() { return (unsigned)__builtin_amdgcn_s_getreg((3 << 11) | 20) & 0xFu; }
#define XB_SPIN(cond, bar) do { unsigned _sp = 0; while (cond) { __builtin_amdgcn_s_sleep(1); \
    if ((++_sp & 255u) == 0u) { if (xb_ld(&(bar)[XB_TMO])) break; if (_sp > XB_SPIN_CAP) { atomicAdd(&(bar)[XB_TMO], 1u); break; } } } } while (0)
struct XcdBarrier { unsigned* bar; unsigned x; volatile LAS unsigned* st; };
__device__ __forceinline__ XcdBarrier xcd_barrier_post(unsigned* bar, volatile LAS unsigned* st) {
    XcdBarrier b; b.bar = bar; b.x = xb_xcc_id(); b.st = st;
    if (threadIdx.x == 0) (void)xb_add(&bar[XB_XCNT(b.x)], 1u);
    return b;
}
__device__ __forceinline__ void xcd_barrier_complete(unsigned* bar, unsigned x, unsigned& nloc, unsigned& nx) {
    const unsigned G = gridDim.x * gridDim.y * gridDim.z;
    unsigned sum, cnt, mine, sp = 0u;
    for (;;) {
        sum = 0u; cnt = 0u; mine = 0u;
#pragma unroll
        for (unsigned j = 0; j < 16; ++j) { const unsigned c = xb_ld(&bar[XB_XCNT(j)]); sum += c; cnt += (c > 0u) ? 1u : 0u; mine = (j == x) ? c : mine; }
        if (sum == G) break;
        __builtin_amdgcn_s_sleep(1);
        if ((++sp & 255u) == 0u) { if (xb_ld(&bar[XB_TMO])) break; if (sp > XB_SPIN_CAP) { atomicAdd(&bar[XB_TMO], 1u); break; } }
    }
    nloc = mine > 0u ? mine : 1u; nx = cnt > 0u ? cnt : 1u;
}
__device__ __forceinline__ void xcd_barrier(const XcdBarrier& b) {
    asm volatile("s_waitcnt vmcnt(0)" ::: "memory");
    __syncthreads();
    if (threadIdx.x == 0) {
        unsigned* bar = b.bar;
        __builtin_amdgcn_s_waitcnt(0);
        unsigned nloc = b.st[0], nx = b.st[1];
        if (nloc == 0u) { xcd_barrier_complete(bar, b.x, nloc, nx); b.st[0] = nloc; b.st[1] = nx; }
        const unsigned old = xb_add(&bar[XB_XSUB(b.x)], 1u);
        const unsigned gen = old / nloc;
        if (old + 1u == (gen + 1u) * nloc) {
            __builtin_amdgcn_fence(__ATOMIC_RELEASE, "agent");
            asm volatile("s_waitcnt vmcnt(0)" ::: "memory");
            const unsigned og = xb_add(&bar[XB_TOP], 1u);
            const unsigned tg = og / nx;
            if (og + 1u == (tg + 1u) * nx) xb_add(&bar[XB_TOPGEN], 1u);
            else XB_SPIN(xb_ld(&bar[XB_TOPGEN]) == tg, bar);
            __builtin_amdgcn_fence(__ATOMIC_ACQUIRE, "agent");
            xb_add(&bar[XB_XGEN(b.x)], 1u);
            asm volatile("s_waitcnt vmcnt(0)" ::: "memory");
        } else {
            XB_SPIN(xb_ld(&bar[XB_XGEN(b.x)]) == gen, bar);
            __builtin_amdgcn_fence(__ATOMIC_ACQUIRE, "agent");
            asm volatile("s_waitcnt vmcnt(0)" ::: "memory");
        }
    }
    __syncthreads();
}

__device__ __forceinline__ float wave_sum(float v) {
#pragma unroll
    for (int o = 1; o < 64; o <<= 1) v += __shfl_xor(v, o);
    return v;
}
__device__ __forceinline__ float half_max(float v) {
#pragma unroll
    for (int o = 1; o < 32; o <<= 1) v = fmaxf(v, __shfl_xor(v, o));
    return v;
}
__device__ __forceinline__ int half_min_i(int v) {
#pragma unroll
    for (int o = 1; o < 32; o <<= 1) { const int w = __shfl_xor(v, o); v = w < v ? w : v; }
    return v;
}
__device__ __forceinline__ void tr_item(const float* W, size_t ldw, int k0, int sc, bf16_t* D, size_t ldd, int n0, const float* kscale, LAS float* scr, int lane) {
    { const float* wp = W + (size_t)(k0 + (lane >> 5)) * ldw + (sc >= 0 ? sc : 0); float v[32];
#pragma unroll
      for (int i = 0; i < 32; ++i) v[i] = wp[(size_t)(2 * i) * ldw];
#pragma unroll
      for (int i = 0; i < 32; ++i) { const int kk = 2 * i + (lane >> 5); float t = sc >= 0 ? v[i] : 0.f; if (kscale) t *= kscale[k0 + kk]; scr[kk * 33 + (lane & 31)] = t; } }
    asm volatile("s_waitcnt lgkmcnt(0)" ::: "memory");
    const int c = lane & 7;
#pragma unroll
    for (int j = 0; j < 4; ++j) { const int n = (lane >> 3) + 8 * j; const LAS float* s = scr + (8 * c) * 33 + n;
        u32x4 o; o.x = cvt_pk_bf16(s[0 * 33], s[1 * 33]); o.y = cvt_pk_bf16(s[2 * 33], s[3 * 33]); o.z = cvt_pk_bf16(s[4 * 33], s[5 * 33]); o.w = cvt_pk_bf16(s[6 * 33], s[7 * 33]);
        *(u32x4*)(D + (size_t)(n0 + n) * ldd + k0 + 8 * c) = o; }
    asm volatile("s_waitcnt lgkmcnt(0)" ::: "memory");
}
__device__ __forceinline__ void tr_item8(const float* W, size_t ldw, int k0, int sc, unsigned char* D, size_t ldd, int n0, float mul, LAS float* scr, int lane) {
    { const float* wp = W + (size_t)(k0 + (lane >> 5)) * ldw + sc; float v[32];
#pragma unroll
      for (int i = 0; i < 32; ++i) v[i] = wp[(size_t)(2 * i) * ldw];
#pragma unroll
      for (int i = 0; i < 32; ++i) { const int kk = 2 * i + (lane >> 5); scr[kk * 33 + (lane & 31)] = v[i] * mul; } }
    asm volatile("s_waitcnt lgkmcnt(0)" ::: "memory");
    const int c = lane & 7;
#pragma unroll
    for (int j = 0; j < 4; ++j) { const int n = (lane >> 3) + 8 * j; const LAS float* s = scr + (8 * c) * 33 + n;
        int a = __builtin_amdgcn_cvt_pk_fp8_f32(s[0 * 33], s[1 * 33], 0, false); a = __builtin_amdgcn_cvt_pk_fp8_f32(s[2 * 33], s[3 * 33], a, true);
        int b = __builtin_amdgcn_cvt_pk_fp8_f32(s[4 * 33], s[5 * 33], 0, false); b = __builtin_amdgcn_cvt_pk_fp8_f32(s[6 * 33], s[7 * 33], b, true);
        u32x2 o; o.x = (unsigned)a; o.y = (unsigned)b; *(u32x2*)(D + (size_t)(n0 + n) * ldd + k0 + 8 * c) = o; }
    asm volatile("s_waitcnt lgkmcnt(0)" ::: "memory");
}
__device__ __forceinline__ void tr_item8w(const float* W, size_t ldw, int k0, int sc4, unsigned char* D, size_t ldd, int n0, float mul, LAS float* scr, int lane) {
    { const float* wp = W + (size_t)(k0 + (lane >> 3)) * ldw + sc4; f32x4 v[16];
#pragma unroll
      for (int i = 0; i < 16; ++i) v[i] = __builtin_nontemporal_load((const f32x4*)(wp + (size_t)(8 * i) * ldw));
#pragma unroll
      for (int i = 0; i < 16; ++i) { const int kk = 8 * i + (lane >> 3); *(LAS f32x4*)(scr + kk * 32 + ((4 * (lane & 7)) ^ ((kk >> 4) << 2))) = v[i] * mul; } }
    asm volatile("s_waitcnt lgkmcnt(0)" ::: "memory");
    const int c = lane & 7;
#pragma unroll
    for (int j = 0; j < 4; ++j) { const int n = (lane >> 3) + 8 * j; const LAS float* s = scr + (16 * c) * 32 + (n ^ (c << 2));
        u32x4 o;
#pragma unroll
        for (int q = 0; q < 4; ++q) { int a = __builtin_amdgcn_cvt_pk_fp8_f32(s[(4 * q) * 32], s[(4 * q + 1) * 32], 0, false); a = __builtin_amdgcn_cvt_pk_fp8_f32(s[(4 * q + 2) * 32], s[(4 * q + 3) * 32], a, true); o[q] = (unsigned)a; }
        __builtin_nontemporal_store(o, (u32x4*)(D + (size_t)(n0 + n) * ldd + k0 + 16 * c)); }
    asm volatile("s_waitcnt lgkmcnt(0)" ::: "memory");
}
__device__ __forceinline__ int map_in(int n) { if (n < 2688) return n; if (n < 2752) return 2688 + rope_orig(n - 2688); if (n < 2816) return -1; return n - 64; }
__device__ __forceinline__ int map_in2(int n) { if (n < 2048) return n; if (n < 3072) return 2752 + (n - 2048); const int m = n - 3072; if (m < 768) return map_in(2048 + m); return 3776 + (m - 768); }
__device__ __forceinline__ int map_q(int n) { if (n < 1024) return (n >> 7) * 192 + (n & 127); const int q = n - 1024; return (q >> 6) * 192 + 128 + rope_orig(q & 63); }

struct Args { const void* in[27]; float* out; unsigned char* ws; int ph_lo, ph_hi, li, pad; };
constexpr int PER_PHASE = 12;
constexpr int N_LAUNCHES = MK_N_LAUNCHES;

#define WinT ((bf16_t*)(ws + WS_WIN))
#define WaT ((bf16_t*)(ws + WS_WA))
#define WbT ((bf16_t*)(ws + WS_WB))
#define WoT ((bf16_t*)(ws + WS_WO))
#define WuqT ((bf16_t*)(ws + WS_WUQ))
#define WukvT ((bf16_t*)(ws + WS_WUKV))
#define WrT ((bf16_t*)(ws + WS_WR))
#define WsB ((bf16_t*)(ws + WS_WS))
#define COS ((float*)(ws + WS_COS))
#define SIN ((float*)(ws + WS_SIN))
#define RS ((float*)(ws + WS_RS))
#define TOPW ((float*)(ws + WS_TOPW))
#define LIST ((int*)(ws + WS_LIST))
#define WguT ((bf16_t*)(ws + WS_WGU))
#define WdT ((bf16_t*)(ws + WS_WD))
#define PRE ((float*)(ws + WS_PRE))
#define H1b ((bf16_t*)(ws + WS_H1B))
#define LOG ((float*)(ws + WS_LOG))
#define YA ((bf16_t*)(ws + WS_YA))
#define Ob ((bf16_t*)(ws + WS_O))
#define Mb ((bf16_t*)(ws + WS_M))
#define ACT ((bf16_t*)(ws + WS_ACT))
#define Xb ((bf16_t*)(ws + WS_XB))
#define U ((bf16_t*)(ws + WS_U))
#define Vg ((bf16_t*)(ws + WS_VG))
#define GA ((bf16_t*)(ws + WS_GA))
#define GB ((bf16_t*)(ws + WS_GB))
#define C3 ((bf16_t*)(ws + WS_C3))
#define KR ((bf16_t*)(ws + WS_KR))
#define Qn ((bf16_t*)(ws + WS_QN))
#define Qr ((bf16_t*)(ws + WS_QR))
#define Kn ((bf16_t*)(ws + WS_KN))
#define Vv ((bf16_t*)(ws + WS_VV))
#define Sg ((bf16_t*)(ws + WS_SG))
#define YP ((bf16_t*)(ws + WS_YP))
#define YS ((bf16_t*)(ws + WS_YS))
#define CNT ((int*)(ws + WS_CTL))
#define CNT ((int*)(ws + WS_CTL) + CW_CNT)
__global__ void __launch_bounds__(NWAVES * 64, 2) mega_fwd(Args args) {
    extern __shared__ __attribute__((aligned(16))) unsigned char lds[];
    LAS unsigned char* ldsa = (LAS unsigned char*)lds;
    volatile LAS unsigned* MISC = (volatile LAS unsigned*)(ldsa + MISC_OFF);
    const int tid = threadIdx.x, lane = tid & 63, wave = __builtin_amdgcn_readfirstlane(tid >> 6);
    const int G = gridDim.x; const int bx = blockIdx.x; const int vcu = (G % 8 == 0) ? (bx % 8) * (G / 8) + bx / 8 : bx;
    const int gw = vcu * NWAVES + wave, NGW = G * NWAVES;
    unsigned char* ws = args.ws;
    gu32* ctl = (gu32*)(ws + WS_CTL);
    const __attribute__((address_space(4))) char* const kp0 = (const __attribute__((address_space(4))) char*)__builtin_amdgcn_kernarg_segment_ptr();
#define KARG(TYPE, NAME, i) const __attribute__((address_space(4))) char* kp_##NAME = kp0; asm volatile("" : "+s"(kp_##NAME)); TYPE NAME = (TYPE)(*(void* const __attribute__((address_space(4)))*)(kp_##NAME + 8 * (i)))
    for (int u = tid; u < (LDS_BYTES - LDSCTL_OFF) / 4; u += NWAVES * 64) ((LAS unsigned*)(ldsa + LDSCTL_OFF))[u] = 0u;
    __syncthreads();
    XcdBarrier bar; bar.bar = (unsigned*)(ctl + CW_BAR); bar.x = 0; bar.st = nullptr;
    if (N_LAUNCHES != PER_PHASE) bar = xcd_barrier_post((unsigned*)(ctl + CW_BAR), MISC + 8);
#define GRID_BAR() do { if (N_LAUNCHES != PER_PHASE) xcd_barrier(bar); } while (0)
    const int lo = args.ph_lo, hi = args.ph_hi;
#ifndef PH_MASK
#define PH_MASK 0xFFF
#endif
#ifndef REP_MASK
#define REP_MASK 0
#endif
#define IN(k) (((PH_MASK >> (k)) & 1) && lo <= (k) && (k) < hi)
#define REPF(k) ((((REP_MASK) >> (k)) & 1) ? 2 : 1)
#define REPS(k) for (int rep_ = 0; rep_ < (((REP_MASK >> (k)) & 1) ? 2 : 1); ++rep_)
#define BOTH(k) (IN(k) && IN((k) + 1))

    if (IN(0)) REPS(0) {
        KARG(const float*, x, 0); KARG(const int*, positions, 1); KARG(const float*, w_in, 2); KARG(const float*, w_spatial, 5); KARG(const float*, w_a_proj, 7); KARG(const float*, q_norm_g, 8); KARG(const float*, w_uq, 9); KARG(const float*, kv_norm_g, 10);
        KARG(const float*, w_uk, 11); KARG(const float*, w_uv, 12); KARG(const float*, w_b_proj, 13); KARG(const float*, w_out, 14); KARG(const float*, w_router, 17); KARG(const float*, w_gate, 19); KARG(const float*, w_up, 20); KARG(const float*, w_down, 21);
        KARG(const float*, w_sh_gate, 22); KARG(const float*, w_sh_up, 23); KARG(const float*, w_sh_down, 24);
        LAS float* scr = (LAS float*)(ldsa + wave * 16384);
        constexpr int I_IN = 16 * (IN_PAD / 32), I_SQ = 16 * 32, I_UQ = 6 * 48, I_UKV = 4 * 32, I_R = 16 * 8, I_GU1 = MOE_FP8 ? 16 * 8 : 16 * 16, I_D1 = MOE_FP8 ? 2 * 32 : 4 * 32;
        constexpr int I_GU = NE * I_GU1, I_D = NE * I_D1;
        constexpr int NITEMS = I_IN + 3 * I_SQ + I_UQ + 2 * I_UKV + I_R + I_GU + I_D + I_GU1 + I_D1;
        for (int it = gw; it < NITEMS; it += NGW) {
            int r = it; const int l31 = lane & 31;
            if (r < I_IN) { const int nb = r % (IN_PAD / 32), kb = r / (IN_PAD / 32);
                if (!INP_FP8) tr_item(w_in, IN_TOTAL, 64 * kb, map_in(32 * nb + l31), WinT, 1024, 32 * nb, nullptr, scr, lane);
                else if (32 * nb < 3072) tr_item(w_in, IN_TOTAL, 64 * kb, map_in2(32 * nb + l31), WinT, 1024, 32 * nb, nullptr, scr, lane);
                else { const int sc_ = map_in2(32 * nb + l31); const bool zr_ = sc_ < 0; tr_item8(w_in, IN_TOTAL, 64 * kb, zr_ ? 0 : sc_, (unsigned char*)WinT + (size_t)3072 * 2048, 1024, 32 * nb - 3072, zr_ ? 0.f : W8MUL, scr, lane); }
                continue; } r -= I_IN;
            if (r < 3 * I_SQ) { const int which = r / I_SQ; r -= which * I_SQ; const int nb = r % 32, kb = r / 32; const float* W = which == 0 ? w_a_proj : which == 1 ? w_b_proj : w_out; bf16_t* Dd = which == 0 ? WaT : which == 1 ? WbT : WoT;
                if (OB_FP8 && which == 1) tr_item8(W, 1024, 64 * kb, 32 * nb + l31, (unsigned char*)Dd, 1024, 32 * nb, W8MUL, scr, lane); else tr_item(W, 1024, 64 * kb, 32 * nb + l31, Dd, 1024, 32 * nb, nullptr, scr, lane); continue; } r -= 3 * I_SQ;
            if (r < I_UQ) { const int nb = r % 48, kb = r / 48; tr_item(w_uq, 1536, 64 * kb, map_q(32 * nb + l31), WuqT, QLORA, 32 * nb, q_norm_g, scr, lane); continue; } r -= I_UQ;
            if (r < 2 * I_UKV) { const int which = r / I_UKV; r -= which * I_UKV; const int nb = r % 32, kb = r / 32; tr_item(which ? w_uv : w_uk, 1024, 64 * kb, 32 * nb + l31, WukvT + (size_t)which * 1024 * KVLORA, KVLORA, 32 * nb, kv_norm_g, scr, lane); continue; } r -= 2 * I_UKV;
            if (r < I_R) { const int nb = r % 8, kb = r / 8; tr_item(w_router, 256, 64 * kb, 32 * nb + l31, WrT, 1024, 32 * nb, nullptr, scr, lane); continue; } r -= I_R;
            if (r < I_GU + I_GU1) { const int e = r / I_GU1; r -= e * I_GU1; const int nb = r % 16, kb = r / 16; const int n = 32 * nb + l31; const int bj = (n >> 7) & 1, pn = n >> 8, j = n & 127;
                const float* W = e < NE ? ((bj ? w_up : w_gate) + (size_t)e * DM * DE) : (bj ? w_sh_up : w_sh_gate);
                if (MOE_FP8) tr_item8w(W, DE, 128 * kb, 128 * pn + ((32 * nb) & 127) + 4 * (lane & 7), (unsigned char*)WguT + (size_t)e * 512 * DM, DM, 32 * nb, W8MUL, scr, lane); else tr_item(W, DE, 64 * kb, 128 * pn + j, WguT + (size_t)e * 512 * DM, DM, 32 * nb, nullptr, scr, lane); continue; } r -= I_GU + I_GU1;
            { const int e = r / I_D1; r -= e * I_D1; const int nb = r % 32, kb = r / 32; const float* W = e < NE ? (w_down + (size_t)e * DE * DM) : w_sh_down;
                if (MOE_FP8) tr_item8w(W, DM, 128 * kb, 32 * nb + 4 * (lane & 7), (unsigned char*)WdT + (size_t)e * DM * DE, DE, 32 * nb, W8MUL, scr, lane); else tr_item(W, DM, 64 * kb, 32 * nb + l31, WdT + (size_t)e * DM * DE, DE, 32 * nb, nullptr, scr, lane); }
        }
        for (size_t i = (size_t)bx * 512 + tid; i < (size_t)T * DM / 8; i += (size_t)G * 512) { const f32x4 a = *(const f32x4*)(x + i * 8), b = *(const f32x4*)(x + i * 8 + 4); *(u32x4*)(Xb + i * 8) = pg8::pack8(a, b);
            if (INP_FP8) *(u32x2*)((unsigned char*)LOG + i * 8) = pack8_fp8(a, b); }
        for (int i = bx * 512 + tid; i < 8 * 128 * 128 / 8; i += G * 512) { const f32x4 a = *(const f32x4*)(w_spatial + (size_t)i * 8), b = *(const f32x4*)(w_spatial + (size_t)i * 8 + 4); *(u32x4*)(WsB + (size_t)i * 8) = pg8::pack8(a, b); }
        for (int i = bx * 512 + tid; i < T * 32; i += G * 512) { const int t = i >> 5, j = i & 31; const float freq = powf(10000.0f, -(float)j * (1.0f / 32.0f)); const float ang = (float)positions[t] * freq;
            float sv_, cv_; sincosf(ang, &sv_, &cv_); COS[i] = cv_; SIN[i] = sv_; }
        if (BOTH(0)) GRID_BAR();
    }

    if (IN(1)) {
        if (!INP_FP8) { pg8::DenseSched S; S.init(Xb, DM, WinT, DM, T, IN_PAD, G, bx, REPF(1));
          pg8::EpiInProj E{U, Vg, C3, KR, GA, GB, RS, COS, SIN, 0, 1.0f};
          pg8::gemm_phase<pg8::EpiInProj, pg8::DenseSched, true>(ldsa, DM, DM, DM, S, E); }
        else {
          { pg8::DenseSched S; S.init(Xb, DM, WinT, DM, T, 3072, G, bx, REPF(1));
            pg8::EpiInProj E{U, Vg, C3, KR, GA, GB, RS, COS, SIN, 1, 1.0f};
            pg8::gemm_phase<pg8::EpiInProj, pg8::DenseSched, true>(ldsa, DM, DM, DM, S, E); }
          { pg8::DenseSched S; S.init(LOG, DM / 2, (const unsigned char*)WinT + (size_t)3072 * 2048, DM / 2, T, 1792, G, bx, REPF(1));
            pg8::EpiInProj E{U, Vg, C3, KR, GA, GB, RS, COS, SIN, 2, 1.0f / W8MUL};
            pg8::gemm_phase<pg8::EpiInProj, pg8::DenseSched, true, true>(ldsa, DM / 2, DM / 2, DM / 2, S, E); } }
        if (BOTH(1)) GRID_BAR();
    }

    if (IN(2)) {
        KARG(const float*, gmlp_ln_g, 3); KARG(const float*, gmlp_ln_b, 4); KARG(const float*, b_spatial, 6);
#ifndef NO_P2A
        { pg8::DenseSched S; S.init(C3, 768, WuqT, QLORA, T, 1536, G, bx, REPF(2)); pg8::EpiQ E{Qn, Qr, RS, COS, SIN};
          pg8::gemm_phase<pg8::EpiQ, pg8::DenseSched, true>(ldsa, QLORA, 768, QLORA, S, E); }
#endif
#ifndef NO_P2B
        { pg8::DenseSched S; S.init(C3 + QLORA, 768, WukvT, KVLORA, T, ATT_FP8 ? 1024 : 2048, G, bx, REPF(2)); pg8::EpiKV E{Kn, Vv, RS};
          pg8::gemm_phase<pg8::EpiKV, pg8::DenseSched, true>(ldsa, KVLORA, 768, KVLORA, S, E); }
        if (ATT_FP8) { pg8::DenseSched S; S.init(WukvT + (size_t)1024 * KVLORA, KVLORA, C3 + QLORA, 768, 1024, T, G, bx, REPF(2)); pg8::EpiVT E{(unsigned char*)Vv, RS};
          pg8::gemm_phase<pg8::EpiVT, pg8::DenseSched, true>(ldsa, KVLORA, KVLORA, 768, S, E); }
#endif
#ifndef NO_P2C
        {
            constexpr int LDT = 136;
            LAS bf16_t* Wl = (LAS bf16_t*)ldsa;
            LAS bf16_t* Vl = (LAS bf16_t*)(ldsa + 128 * LDT * 2);
            const int fr = lane & 15, fq = lane >> 4;
            for (int un0 = vcu; un0 < 1024 * REPF(13); un0 += G) { const int un = un0 & 1023;
                const int ch = un >> 3, hg = un & 7;
                for (int i = tid; i < 128 * 16; i += 512) { const int p = i >> 4, c8 = (i & 15) * 8; *(LAS u32x4*)(Wl + p * LDT + c8) = *(const u32x4*)(WsB + (size_t)hg * 16384 + p * 128 + c8); }
                { const int q = tid >> 2, d0 = (tid & 3) * 32; const bf16_t* vp = Vg + (size_t)(ch * 128 + q) * DM + hg * 128 + d0;
                  float v[32];
#pragma unroll
                  for (int j = 0; j < 4; ++j) { const u32x4 w = *(const u32x4*)(vp + j * 8); v[j * 8 + 0] = bf_lo(w.x); v[j * 8 + 1] = bf_hi(w.x); v[j * 8 + 2] = bf_lo(w.y); v[j * 8 + 3] = bf_hi(w.y); v[j * 8 + 4] = bf_lo(w.z); v[j * 8 + 5] = bf_hi(w.z); v[j * 8 + 6] = bf_lo(w.w); v[j * 8 + 7] = bf_hi(w.w); }
                  float s = 0.f;
#pragma unroll
                  for (int j = 0; j < 32; ++j) s += v[j];
                  s += __shfl_xor(s, 1); s += __shfl_xor(s, 2);
                  const float mu = s * (1.0f / 128.0f); float q2 = 0.f;
#pragma unroll
                  for (int j = 0; j < 32; ++j) { v[j] -= mu; q2 += v[j] * v[j]; }
                  q2 += __shfl_xor(q2, 1); q2 += __shfl_xor(q2, 2);
                  const float rstd = 1.0f / sqrtf(q2 * (1.0f / 128.0f) + LN_EPS);
#pragma unroll
                  for (int j = 0; j < 32; ++j) { const float o = v[j] * rstd * gmlp_ln_g[hg * 128 + d0 + j] + gmlp_ln_b[hg * 128 + d0 + j]; Vl[(d0 + j) * LDT + q] = (bf16_t)(cvt_pk_bf16(o, 0.f) & 0xffffu); }
                }
                __syncthreads();
                f32x4 acc[8];
#pragma unroll
                for (int n = 0; n < 8; ++n) acc[n] = (f32x4){0.f, 0.f, 0.f, 0.f};
#pragma unroll
                for (int ks = 0; ks < 4; ++ks) { const bf16x8 b = *(const LAS bf16x8*)(Wl + (16 * wave + fr) * LDT + 32 * ks + 8 * fq);
#pragma unroll
                    for (int n = 0; n < 8; ++n) { const bf16x8 a = *(const LAS bf16x8*)(Vl + (16 * n + fr) * LDT + 32 * ks + 8 * fq); acc[n] = __builtin_amdgcn_mfma_f32_16x16x32_bf16(a, b, acc[n], 0, 0, 0); } }
                { const int p = 16 * wave + fr; const float bsp = b_spatial[hg * 128 + p]; const unsigned ro = (unsigned)(ch * 128 + p) * DM + hg * 128 + 4 * fq;
                  u32x2 uv[8];
#pragma unroll
                  for (int n = 0; n < 8; ++n) uv[n] = *(const u32x2*)(U + ro + 16 * n);
#pragma unroll
                  for (int n = 0; n < 8; ++n) { u32x2 w; w.x = cvt_pk_bf16(bf_lo(uv[n].x) * (acc[n][0] + bsp), bf_hi(uv[n].x) * (acc[n][1] + bsp)); w.y = cvt_pk_bf16(bf_lo(uv[n].y) * (acc[n][2] + bsp), bf_hi(uv[n].y) * (acc[n][3] + bsp));
                      *(u32x2*)(Sg + ro + 16 * n) = w; } }
                __syncthreads();
            }
        }
#endif
        if (BOTH(2)) GRID_BAR();
    }

    if (IN(3)) {
#ifndef NO_P3A
        { pg8::DenseSched S; S.init(Sg, DM, WaT, DM, T, DM, G, bx, REPF(12)); pg8::EpiGate<false> E{YA, GA, nullptr, 1.0f};
          pg8::gemm_phase<pg8::EpiGate<false>, pg8::DenseSched, true>(ldsa, DM, DM, DM, S, E); }
#endif
#ifndef NO_P3B
        for (int i0 = 0; i0 * G + vcu < 512 * REPF(3); ++i0) { const int i = (G == 256) ? (i0 & 1) : i0; const int un = (i0 * G + vcu) & 511; int bh, qb;
            if (G == 256) { bh = i * 8 + (vcu >> 5); qb = vcu & 31; } else { bh = un >> 5; qb = un & 31; }
            const int b = bh >> 3, h = bh & 7;
            if (ATT_FP8 == 3) att::attn_unit_f8w((const unsigned char*)Qn, (const unsigned char*)Qr, (const unsigned char*)Kn, (const unsigned char*)KR, (const unsigned char*)Vv, Ob, (long)b * SEQ + qb * 256, (long)b * SEQ, h, SEQ, ldsa);
            else if (ATT_FP8) att::attn_unit_f8<1>((const unsigned char*)Qn, (const unsigned char*)Qr, (const unsigned char*)Kn, (const unsigned char*)KR, (const unsigned char*)Vv, Ob, (long)b * SEQ + qb * 256, (long)b * SEQ, h, SEQ, ldsa);
            else att::attn_unit<0>(Qn, Qr, Kn, KR, Vv, Ob, (long)b * SEQ + qb * 256, (long)b * SEQ, h, SEQ, ldsa); }
#ifdef ATTF_PROBE
        for (int i = 0; i * G + vcu < 512; ++i) { int bh, qb; const int un = i * G + vcu;
            if (G == 256) { bh = i * 8 + (vcu >> 5); qb = vcu & 31; } else { bh = un >> 5; qb = un & 31; }
            const int b = bh >> 3, h = bh & 7;
            att::attn_unit_f8<ATTF_PROBE>((const unsigned char*)Qn, (const unsigned char*)Qr, (const unsigned char*)Kn, (const unsigned char*)KR, (const unsigned char*)Vv, H1b, (long)b * SEQ + qb * 256, (long)b * SEQ, h, SEQ, ldsa); }
#endif
#ifdef ATT_PROBE
        for (int i = 0; i * G + vcu < 512; ++i) { int bh, qb; const int un = i * G + vcu;
            if (G == 256) { bh = i * 8 + (vcu >> 5); qb = vcu & 31; } else { bh = un >> 5; qb = un & 31; }
            const int b = bh >> 3, h = bh & 7;
            att::attn_unit<ATT_PROBE>(Qn, Qr, Kn, KR, Vv, H1b, (long)b * SEQ + qb * 256, (long)b * SEQ, h, SEQ, ldsa); }
#endif
#endif
        if (BOTH(3)) GRID_BAR();
    }

    if (IN(4)) {
        constexpr int KB = OB_FP8 ? DM / 2 : DM;
        pg8::DenseSched S; S.init(Ob, KB, WbT, KB, T, DM, G, bx, REPF(4)); pg8::EpiGate<true> E{Mb, GB, YA, OB_FP8 ? 1.0f / (W8MUL * O8MUL) : 1.0f};
        pg8::gemm_phase<pg8::EpiGate<true>, pg8::DenseSched, true, OB_FP8 != 0>(ldsa, KB, KB, KB, S, E);
        if (BOTH(4)) GRID_BAR();
    }

    if (IN(5)) {
        KARG(const float*, x, 0);
        pg8::DenseSched S; S.init(Mb, DM, WoT, DM, T, DM, G, bx, REPF(5)); pg8::EpiPre E{PRE, x};
        pg8::gemm_phase<pg8::EpiPre, pg8::DenseSched, true>(ldsa, DM, DM, DM, S, E);
        if (BOTH(5)) GRID_BAR();
    }

    if (IN(6)) {
        KARG(const float*, ln1_g, 15); KARG(const float*, ln1_b, 16); KARG(const float*, router_bias, 18);
        const int half = lane >> 5, l31 = lane & 31, fr = lane & 15, fq = lane >> 4;
        constexpr int LST = 260;
        float rb[4];
#pragma unroll
        for (int j = 0; j < 4; ++j) rb[j] = router_bias[lane + 64 * j];
        for (int grp = vcu; grp < T / 64; grp += G) {
            const int t0 = grp * 64;
#pragma unroll 2
            for (int i = 0; i < 8; ++i) { const int r = 8 * wave + i, m = t0 + r;
                f32x4* xr = (f32x4*)(PRE + (size_t)m * DM) + lane; f32x4 v[4]; float s = 0.f;
#pragma unroll
                for (int j = 0; j < 4; ++j) { v[j] = xr[64 * j]; s += (v[j].x + v[j].y) + (v[j].z + v[j].w); }
                const float mean = wave_sum(s) * (1.f / DM); float s2 = 0.f;
#pragma unroll
                for (int j = 0; j < 4; ++j) { v[j] = v[j] - mean; s2 += (v[j].x * v[j].x + v[j].y * v[j].y) + (v[j].z * v[j].z + v[j].w * v[j].w); }
                const float rstd = 1.f / sqrtf(wave_sum(s2) * (1.f / DM) + LN_EPS);
                u32x2* o8 = (u32x2*)(H1b + (size_t)m * DM) + lane;
#pragma unroll
                for (int j = 0; j < 4; ++j) { const f32x4 g = *((const f32x4*)ln1_g + lane + 64 * j), bb = *((const f32x4*)ln1_b + lane + 64 * j); const f32x4 o = v[j] * rstd * g + bb; xr[64 * j] = o;
                    u32x2 w; w.x = cvt_pk_bf16(o.x, o.y); w.y = cvt_pk_bf16(o.z, o.w);
                    if (MOE_FP8) { int a = __builtin_amdgcn_cvt_pk_fp8_f32(o.x, o.y, 0, false); a = __builtin_amdgcn_cvt_pk_fp8_f32(o.z, o.w, a, true); ((unsigned*)((unsigned char*)H1b + (size_t)m * DM))[lane + 64 * j] = (unsigned)a; } else o8[64 * j] = w;
                    const int chunk = (lane + 64 * j) >> 1; *(LAS u32x2*)(ldsa + r * 2048 + ((chunk ^ (r & 7)) << 4) + (lane & 1) * 8) = w; }
            }
            __syncthreads();
            f32x4 acc[2][4];
#pragma unroll
            for (int eb = 0; eb < 2; ++eb)
#pragma unroll
                for (int tb = 0; tb < 4; ++tb) acc[eb][tb] = (f32x4){0.f, 0.f, 0.f, 0.f};
            const bf16_t* wr0 = WrT + (size_t)(32 * wave + fr) * DM + 8 * fq;
#pragma unroll 4
            for (int ks = 0; ks < 32; ++ks) {
                bf16x8 a[2], b[4];
#pragma unroll
                for (int eb = 0; eb < 2; ++eb) a[eb] = *(const bf16x8*)(wr0 + (size_t)eb * 16 * DM + 32 * ks);
#pragma unroll
                for (int tb = 0; tb < 4; ++tb) { const int r = 16 * tb + fr; b[tb] = *(const LAS bf16x8*)(ldsa + r * 2048 + (((4 * ks + fq) ^ (r & 7)) << 4)); }
#pragma unroll
                for (int eb = 0; eb < 2; ++eb)
#pragma unroll
                    for (int tb = 0; tb < 4; ++tb) acc[eb][tb] = __builtin_amdgcn_mfma_f32_16x16x32_bf16(a[eb], b[tb], acc[eb][tb], 0, 0, 0);
            }
            __syncthreads();
            LAS float* L = (LAS float*)ldsa;
#pragma unroll
            for (int eb = 0; eb < 2; ++eb)
#pragma unroll
                for (int tb = 0; tb < 4; ++tb) *(LAS f32x4*)(L + (16 * tb + fr) * LST + 32 * wave + 16 * eb + 4 * fq) = acc[eb][tb];
            __syncthreads();
            { const int ts = lane >> 3, g = lane & 7, tl = 8 * wave + ts, t = t0 + tl;
              LAS float* Lrow = L + tl * LST + 32 * g; float b[32];
#pragma unroll
              for (int q = 0; q < 8; ++q) { const f32x4 lg = *(LAS f32x4*)(Lrow + 4 * q); const f32x4 bi = *(const f32x4*)(router_bias + 32 * g + 4 * q); f32x4 s;
#pragma unroll
                  for (int c = 0; c < 4; ++c) { s[c] = 1.0f / (1.0f + expf(-lg[c])); b[4 * q + c] = s[c] + bi[c]; }
                  *(LAS f32x4*)(Lrow + 4 * q) = s; }
              float m1 = -INFINITY, m2 = -INFINITY;
#pragma unroll
              for (int i = 0; i < 32; ++i) { const float x = b[i]; const bool gt = x > m1; m2 = gt ? m1 : fmaxf(m2, x); m1 = gt ? x : m1; }
              const float gsum = m1 + m2; int rank = 0;
#pragma unroll
              for (int k = 0; k < 8; ++k) { const float o = __shfl(gsum, (lane & ~7) + k); rank += (o > gsum || (o == gsum && k < g)) ? 1 : 0; }
              const bool sel = rank < 4;
              float lv[8]; int li[8];
#pragma unroll
              for (int p = 0; p < 8; ++p) { float bv = -INFINITY; int bi = 0;
#pragma unroll
                  for (int i = 0; i < 32; ++i) if (b[i] > bv) { bv = b[i]; bi = i; }
                  lv[p] = sel ? bv : -INFINITY; li[p] = 32 * g + bi;
#pragma unroll
                  for (int i = 0; i < 32; ++i) b[i] = (i == bi) ? -INFINITY : b[i]; }
              int mye = 0;
#pragma unroll
              for (int k = 0; k < TOPK; ++k) { float v = lv[0]; int e = li[0];
#pragma unroll
                  for (int off = 1; off < 8; off <<= 1) { const float ov = __shfl_xor(v, off); const int oe = __shfl_xor(e, off); if (ov > v || (ov == v && oe < e)) { v = ov; e = oe; } }
                  if (g == k) mye = e;
                  if (li[0] == e) {
#pragma unroll
                      for (int p = 0; p < 7; ++p) { lv[p] = lv[p + 1]; li[p] = li[p + 1]; }
                      lv[7] = -INFINITY; } }
              const float s = L[tl * LST + mye]; float ssum = s;
#pragma unroll
              for (int off = 1; off < 8; off <<= 1) ssum += __shfl_xor(ssum, off);
              const int pair = t * TOPK + g; const float gwv = s / ssum * 2.5f; TOPW[pair] = gwv; const int slot = atomicAdd(&CNT[mye * CNT_STRIDE], 1); LIST[(size_t)mye * T + slot] = pair; LOG[(size_t)mye * T + slot] = gwv;
            }
            __syncthreads();
        }
        if (BOTH(6)) GRID_BAR();
    }

    if (IN(9) || IN(10)) {
        LAS int* cntL = (LAS int*)(ldsa + TAB_OFF); LAS int* tbase = cntL + 256; LAS int* tile2e = tbase + 260;
        if (tid < 256) cntL[tid] = __hip_atomic_load(&CNT[tid * CNT_STRIDE], RLX_AGENT);
        __syncthreads();
        if (tid == 0) { int s = 0; for (int e = 0; e < NE; ++e) { tbase[e] = s; s += (cntL[e] + 255) >> 8; } tbase[NE] = s; }
        __syncthreads();
        if (tid < 256) { const int t0 = tbase[tid], t1 = tbase[tid + 1]; for (int q = t0; q < t1; ++q) tile2e[q] = tid; }
        __syncthreads();
        const int ntm = tbase[NE];
        if (IN(9)) {
            constexpr int KE = MOE_FP8 ? DM / 2 : DM;
            pg8::MoeSched<true> S; S.A = (const char*)H1b; S.Bt = (const char*)WguT; S.atile = (size_t)256 * KE * 2; S.bexp = (size_t)512 * KE * 2; S.btile = (size_t)256 * KE * 2; S.npn = 2; S.ntm = ntm; S.nwg = (ntm + 64) * 2; S.G = G; S.c = bx; S.rep = REPF(9);
            S.tile2e = tile2e; S.tbase = tbase; S.cntL = cntL; S.list = LIST;
            pg8::EpiGU E{ACT};
            pg8::gemm_phase<pg8::EpiGU, pg8::MoeSched<true>, true, MOE_FP8 != 0>(ldsa, KE, KE, KE, S, E);
            if (BOTH(9)) GRID_BAR();
        }
        if (IN(10)) {
            constexpr int KD = MOE_FP8 ? DE / 2 : DE;
            pg8::MoeSched<false> S; S.A = (const char*)ACT; S.Bt = (const char*)WdT; S.atile = (size_t)256 * KD * 2; S.bexp = (size_t)DM * KD * 2; S.btile = (size_t)256 * KD * 2; S.npn = 4; S.ntm = ntm; S.nwg = (ntm + 64) * 4; S.G = G; S.c = bx; S.rep = REPF(10);
            S.tile2e = tile2e; S.tbase = tbase; S.cntL = cntL; S.list = LIST;
            pg8::EpiDown E{(unsigned char*)YP, (unsigned char*)YS, LIST, LOG, ntm};
            pg8::gemm_phase<pg8::EpiDown, pg8::MoeSched<false>, true, MOE_FP8 != 0>(ldsa, KD, KD, KD, S, E);
            if (BOTH(10)) GRID_BAR();
        }
    }

    if (IN(11)) REPS(11) {
        KARG(const float*, ln2_g, 25); KARG(const float*, ln2_b, 26); KARG(float*, out, 27);
        const unsigned char* YP8 = (const unsigned char*)YP; const unsigned char* YS8 = (const unsigned char*)YS;
        for (int m = gw; m < T; m += NGW) {
            const f32x4* xr = (const f32x4*)(PRE + (size_t)m * DM) + 4 * lane; f32x4 v[4];
            u32x4 yw[TOPK + 1];
#pragma unroll
            for (int k = 0; k < TOPK + 1; ++k) yw[k] = *(const u32x4*)((k < TOPK ? YP8 + (size_t)(m * TOPK + k) * DM : YS8 + (size_t)m * DM) + 16 * lane);
#pragma unroll
            for (int j = 0; j < 4; ++j) v[j] = xr[j] * DN_ALPHA;
#pragma unroll
            for (int k = 0; k < TOPK + 1; ++k) {
#pragma unroll
                for (int j = 0; j < 4; ++j) { const int w = (int)yw[k][j]; const auto lo = __builtin_amdgcn_cvt_pk_f32_fp8(w, false), hh = __builtin_amdgcn_cvt_pk_f32_fp8(w, true);
                    v[j].x += lo[0] * (1.0f / Y8MUL); v[j].y += lo[1] * (1.0f / Y8MUL); v[j].z += hh[0] * (1.0f / Y8MUL); v[j].w += hh[1] * (1.0f / Y8MUL); } }
            float s = 0.f;
#pragma unroll
            for (int j = 0; j < 4; ++j) s += (v[j].x + v[j].y) + (v[j].z + v[j].w);
            const float mean = wave_sum(s) * (1.f / DM); float s2 = 0.f;
#pragma unroll
            for (int j = 0; j < 4; ++j) { v[j] = v[j] - mean; s2 += (v[j].x * v[j].x + v[j].y * v[j].y) + (v[j].z * v[j].z + v[j].w * v[j].w); }
            const float rstd = 1.f / sqrtf(wave_sum(s2) * (1.f / DM) + LN_EPS);
            f32x4* orow = (f32x4*)(out + (size_t)m * DM) + 4 * lane;
#pragma unroll
            for (int j = 0; j < 4; ++j) { const f32x4 g = *((const f32x4*)ln2_g + 4 * lane + j), bb = *((const f32x4*)ln2_b + 4 * lane + j); orow[j] = v[j] * rstd * g + bb; }
        }
    }
#undef IN
#undef BOTH
#undef GRID_BAR
}

#undef WinT
#undef WaT
#undef WbT
#undef WoT
#undef WuqT
#undef WukvT
#undef WrT
#undef WsB
#undef COS
#undef SIN
#undef RS
#undef TOPW
#undef LIST
#undef WguT
#undef WdT
#undef PRE
#undef H1b
#undef LOG
#undef YA
#undef Ob
#undef Mb
#undef ACT
#undef Xb
#undef U
#undef Vg
#undef GA
#undef GB
#undef C3
#undef KR
#undef Qn
#undef Qr
#undef Kn
#undef Vv
#undef Sg
#undef YP
#undef YS
#undef CNT
#undef CNT
extern "C" void kernel_launch(void* const* d_in, const int* in_sizes, int n_in, void* d_out, int out_size, void* d_ws, size_t ws_size, hipStream_t stream) {
    static int grid = 0;
    if (grid == 0) {
        if (n_in != 27 || in_sizes[0] != T * DM || out_size != T * DM || ws_size < WS_END) { fprintf(stderr, "kernel_launch: unexpected shapes: n_in %d in0 %d out %d ws %zu (need %zu)\n", n_in, n_in > 0 ? in_sizes[0] : -1, out_size, ws_size, (size_t)WS_END); grid = -1; return; }
        int dev = 0, cus = 0, per_cu = 0;
        if (hipGetDevice(&dev) != hipSuccess || hipDeviceGetAttribute(&cus, hipDeviceAttributeMultiprocessorCount, dev) != hipSuccess) { grid = -1; return; }
        if (hipFuncSetAttribute((const void*)mega_fwd, hipFuncAttributeMaxDynamicSharedMemorySize, LDS_BYTES) != hipSuccess) { fprintf(stderr, "kernel_launch: hipFuncSetAttribute failed\n"); grid = -1; return; }
        if (hipOccupancyMaxActiveBlocksPerMultiprocessor(&per_cu, (const void*)mega_fwd, NWAVES * 64, LDS_BYTES) != hipSuccess || per_cu < 1) { fprintf(stderr, "kernel_launch: occupancy query says %d blocks per CU\n", per_cu); grid = -1; return; }
        (void)hipGetLastError();
        grid = cus;
    }
    if (grid < 0) return;
    if (hipMemsetAsync((char*)d_ws + WS_CTL, 0, CTL_ZERO_BYTES, stream) != hipSuccess) return;
    Args a{};
    for (int i = 0; i < 27; ++i) a.in[i] = d_in[i];
    a.out = (float*)d_out; a.ws = (unsigned char*)d_ws;
    for (int li = 0; li < N_LAUNCHES; ++li) {
        if (N_LAUNCHES == PER_PHASE) { a.ph_lo = li; a.ph_hi = li + 1; } else { a.ph_lo = 0; a.ph_hi = PER_PHASE; }
        a.li = li;
        hipLaunchKernelGGL(mega_fwd, dim3(grid), dim3(NWAVES * 64), LDS_BYTES, stream, a);
        const hipError_t le = hipPeekAtLastError();
        if (le != hipSuccess) { fprintf(stderr, "kernel_launch: launch %d failed: %s\n", li, hipGetErrorName(le)); break; }
    }
}
```

```cpp
#include <hip/hip_runtime.h>
#include <hip/hip_bf16.h>
#include <cstdio>
#include <cstdint>

#ifndef MK_N_LAUNCHES
#define MK_N_LAUNCHES 1
#endif

#define LAS __attribute__((address_space(3)))
#define GAS __attribute__((address_space(1)))
typedef unsigned short bf16_t;
typedef short bf16x8 __attribute__((ext_vector_type(8)));
typedef short s16x4 __attribute__((ext_vector_type(4)));
typedef float f32x4 __attribute__((ext_vector_type(4)));
typedef float f32x2 __attribute__((ext_vector_type(2)));
typedef float f32x16 __attribute__((ext_vector_type(16)));
typedef unsigned u32x4 __attribute__((ext_vector_type(4)));
typedef unsigned u32x2 __attribute__((ext_vector_type(2)));

constexpr int T = 16384, DM = 1024, SEQ = 8192, NBATCH = 2;
constexpr int NH = 8, QK_NOPE = 128, QK_ROPE = 64, VH = 128, QLORA = 384, KVLORA = 256;
constexpr int NE = 256, TOPK = 8, DE = 256;
constexpr int IN_TOTAL = 4800, IN_PAD = 4864;
constexpr float DN_ALPHA = 1.189207115002721f;
constexpr float LN_EPS = 1e-5f, RMS_EPS = 1e-6f;
constexpr float LOG2E = 1.4426950408889634f;
constexpr float QSCALE = 0.07216878364870322f * LOG2E;
constexpr int NWAVES = 8;

__device__ __forceinline__ unsigned cvt_pk_bf16(float lo, float hi) { unsigned r; asm volatile("v_cvt_pk_bf16_f32 %0, %1, %2" : "=v"(r) : "v"(lo), "v"(hi)); return r; }
__device__ __forceinline__ float bf_lo(unsigned w) { return __uint_as_float(w << 16); }
__device__ __forceinline__ float bf_hi(unsigned w) { return __uint_as_float(w & 0xffff0000u); }
__device__ __forceinline__ float sigmoid_f(float x) { return __builtin_amdgcn_rcpf(1.0f + __builtin_amdgcn_exp2f(-x * LOG2E)); }
__device__ __forceinline__ float gelu_tanh(float x) { const float u = 1.5957691216057308f * (x + 0.044715f * x * x * x); return x * __builtin_amdgcn_rcpf(1.0f + __builtin_amdgcn_exp2f(-u * LOG2E)); }
#ifndef MOE_FP8
#define MOE_FP8 1
#endif
constexpr float W8MUL = 64.0f;
#ifndef INP_FP8
#define INP_FP8 1
#endif
#ifndef OB_FP8
#define OB_FP8 1
#endif
constexpr float O8MUL = 64.0f;
#ifndef ATT_FP8
#define ATT_FP8 3
#endif
constexpr float Y8MUL = 16.0f;
constexpr float K8MUL = (ATT_FP8 == 3) ? 0.125f : 1.0f;
constexpr float Q8MUL = 8.0f;
__device__ __forceinline__ u32x2 pack8_fp8(const f32x4 v0, const f32x4 v1) { int a = __builtin_amdgcn_cvt_pk_fp8_f32(v0[0], v0[1], 0, false); a = __builtin_amdgcn_cvt_pk_fp8_f32(v0[2], v0[3], a, true);
    int b = __builtin_amdgcn_cvt_pk_fp8_f32(v1[0], v1[1], 0, false); b = __builtin_amdgcn_cvt_pk_fp8_f32(v1[2], v1[3], b, true); u32x2 w; w.x = (unsigned)a; w.y = (unsigned)b; return w; }
__host__ __device__ __forceinline__ int rope_orig(int p) { return 16 * (p >> 5) + 4 * ((p >> 3) & 3) + (p & 3) + 32 * ((p >> 2) & 1); }

namespace pg8 {
typedef int v8i_t __attribute__((ext_vector_type(8)));
typedef int i4_t __attribute__((ext_vector_type(4)));
constexpr int BM = 256, BK = 64, HALF = 128, HTB = HALF * BK * 2, STAGE_BYTES = 8 * HTB, NXCD = 8, WGM = 2;
__host__ __device__ __forceinline__ int lds_byte(int r, int c) { const int st = (r >> 4) * 2 + (c >> 5), rr = r & 15, cc = c & 31, ob = rr * 64 + cc * 2; return st * 1024 + (ob ^ (((ob >> 9) & 1) << 5)); }
__host__ __device__ __forceinline__ void stage_rc(int b, int& R, int& C) { const int st = b / 1024, sb = b % 1024, swz = sb ^ (((sb >> 9) & 1) << 5); R = (st >> 1) * 16 + swz / 64; C = (st & 1) * 32 + (swz % 64) / 2; }
__host__ __device__ __forceinline__ int perm32(int rho) { const int n = rho >> 4, i = rho & 15; return 8 * (i >> 2) + 4 * n + (i & 3); }

struct Unit { const char* a; const char* b; int pm, pn, e, cnt, r0; };

__device__ __forceinline__ int xcd_remap(int wgid, int nwg) { const int q = nwg / NXCD, r = nwg % NXCD, xcd = wgid % NXCD, off = wgid / NXCD; return (xcd < r ? xcd * (q + 1) : r * (q + 1) + (xcd - r) * q) + off; }

struct DenseSched {
    static constexpr bool GATHER = false;
    const char* A; const char* Bt; size_t atile, btile; int nM, nN, nwg, G, c, rep;
    __device__ __forceinline__ void init(const void* A_, int lda, const void* B_, int ldb, int M, int N, int G_, int c_, int rep_ = 1) {
        A = (const char*)A_; Bt = (const char*)B_; atile = (size_t)BM * lda * 2; btile = (size_t)BM * ldb * 2; nM = M / BM; nN = N / BM; nwg = nM * nN; G = G_; c = c_; rep = rep_; }
    __device__ __forceinline__ bool next(int i, Unit& u) const {
        long L = (long)i * G + c; if (L >= (long)nwg * rep) return false; if (L >= nwg) L -= nwg;
        const int wgid = xcd_remap((int)L, nwg);
        const int nig = WGM * nN, gid = wgid / nig, fm = gid * WGM, gsz = (nM - fm) < WGM ? (nM - fm) : WGM;
        u.pm = fm + ((wgid % nig) % gsz); u.pn = (wgid % nig) / gsz; u.e = 0; u.cnt = BM; u.r0 = 0;
        u.a = A + (size_t)u.pm * atile; u.b = Bt + (size_t)u.pn * btile; return true; }
    __device__ __forceinline__ void aoffs(const Unit&, const int (&)[2], const int (&)[2], int, unsigned (&)[2][2]) const {}
};

template <class Epi, class Sched, bool ALIGN_EPI, bool F8 = false>
__device__ __forceinline__ void gemm_phase(LAS unsigned char* lds, const int K, const int lda, const int ldb, const Sched& S, const Epi& E) {
    const int tid = threadIdx.x, wid = __builtin_amdgcn_readfirstlane(tid >> 6), lane = tid & 63, wr = wid >> 2, wc = wid & 3, fr = lane & 15, fq = lane >> 4;
    const int nt = K / BK;
    constexpr bool GA_ = Sched::GATHER;
    int Rr[2], Cc[2]; unsigned voffA[2][2], nvoffA[2][2], voffB[2];
#pragma unroll
    for (int i = 0; i < 2; ++i) { int R, C; stage_rc(tid * 16 + i * 8192, R, C); Rr[i] = R; Cc[i] = C; const int Rb = Epi::PERM ? ((R & ~31) + perm32(R & 31)) : R;
        voffB[i] = (unsigned)(Rb * ldb + C) * 2u;
#pragma unroll
        for (int h = 0; h < 2; ++h) { voffA[h][i] = (unsigned)(((GA_ ? h * HALF : 0) + R) * lda + C) * 2u; nvoffA[h][i] = voffA[h][i]; } }
    const size_t kstep = (size_t)(BK * 2);
    const size_t hsA = GA_ ? (size_t)0 : (size_t)HALF * lda * 2, hsB = (size_t)HALF * ldb * 2;
    const unsigned ldsw = (unsigned)wid * 1024u;
    const int aoff = lds_byte(wr * 64 + fr, fq * 8), boff = lds_byte(wc * 32 + fr, fq * 8);
#define PG8_SA(b, h) (((b) * 2 + (h)) * HTB)
#define PG8_SB(b, h) ((4 + (b) * 2 + (h)) * HTB)
    const unsigned ldsb_ = (unsigned)__builtin_amdgcn_readfirstlane((int)((unsigned)(uintptr_t)lds + ldsw));
#define PG8_STAGE(bufoff, gbase, voff) do { _Pragma("unroll") for (int _i = 0; _i < 2; ++_i) { unsigned keep_; \
        asm volatile("s_mov_b32 %0, m0\n\ts_mov_b32 m0, %3\n\ts_nop 4\n\tglobal_load_lds_dwordx4 %1, %2\n\ts_mov_b32 m0, %0" : "=&s"(keep_) : "v"((voff)[_i]), "s"((const char*)(gbase)), "s"(ldsb_ + (unsigned)((bufoff) + _i * 8192)) : "memory"); } } while (0)
#define PG8_LDA(dst, b, h) do { if constexpr (F8) { _Pragma("unroll") for (int m = 0; m < 4; ++m) dst##8[m] = __builtin_shufflevector(*(const LAS i4_t*)(lds + PG8_SA(b, h) + aoff + m * 2048), *(const LAS i4_t*)(lds + PG8_SA(b, h) + aoff + m * 2048 + 1024), 0, 1, 2, 3, 4, 5, 6, 7); } \
        else { _Pragma("unroll") for (int m = 0; m < 4; ++m) _Pragma("unroll") for (int k = 0; k < 2; ++k) dst[m][k] = *(const LAS bf16x8*)(lds + PG8_SA(b, h) + aoff + m * 2048 + k * 1024); } } while (0)
#define PG8_LDB(dst, b, h) do { if constexpr (F8) { _Pragma("unroll") for (int n = 0; n < 2; ++n) dst##8[n] = __builtin_shufflevector(*(const LAS i4_t*)(lds + PG8_SB(b, h) + boff + n * 2048), *(const LAS i4_t*)(lds + PG8_SB(b, h) + boff + n * 2048 + 1024), 0, 1, 2, 3, 4, 5, 6, 7); } \
        else { _Pragma("unroll") for (int n = 0; n < 2; ++n) _Pragma("unroll") for (int k = 0; k < 2; ++k) dst[n][k] = *(const LAS bf16x8*)(lds + PG8_SB(b, h) + boff + n * 2048 + k * 1024); } } while (0)
#define PG8_MMA(ai, bj, At, Bt) do { __builtin_amdgcn_s_setprio(1); if constexpr (F8) { _Pragma("unroll") for (int m = 0; m < 4; ++m) _Pragma("unroll") for (int n = 0; n < 2; ++n) \
            asm volatile("v_mfma_f32_16x16x128_f8f6f4 %0, %1, %2, %0" : "+v"(acc[ai][bj][m][n]) : "v"(Bt##8[n]), "v"(At##8[m])); } \
        else { _Pragma("unroll") for (int m = 0; m < 4; ++m) _Pragma("unroll") for (int n = 0; n < 2; ++n) _Pragma("unroll") for (int k = 0; k < 2; ++k) \
        acc[ai][bj][m][n] = __builtin_amdgcn_mfma_f32_16x16x32_bf16(Bt[n][k], At[m][k], acc[ai][bj][m][n], 0, 0, 0); } __builtin_amdgcn_s_setprio(0); } while (0)
#define PG8_WAIT_V(n) asm volatile("s_waitcnt vmcnt(" #n ")" ::: "memory")
#define PG8_WAIT_L(n) asm volatile("s_waitcnt lgkmcnt(" #n ")" ::: "memory")
#define PG8_BAR __builtin_amdgcn_s_barrier()
#define PG8_SCHED __builtin_amdgcn_sched_barrier(0)
    Unit cur, nxt; int ui = 0;
    if (!S.next(0, cur)) return;
    if constexpr (Sched::GATHER) S.aoffs(cur, Rr, Cc, lda, voffA);
    f32x4 acc[2][2][4][2];
    bf16x8 At[4][2], B0[2][2], B1[2][2]; v8i_t At8[4], B08[2], B18[2];
    const char* cA = cur.a; const char* cB = cur.b;
    PG8_STAGE(PG8_SB(0, 0), cB, voffB); PG8_STAGE(PG8_SB(0, 1), cB + hsB, voffB); PG8_STAGE(PG8_SA(0, 0), cA, voffA[0]); PG8_STAGE(PG8_SA(0, 1), cA + hsA, voffA[1]);
    if (wr == 1) PG8_BAR;
    PG8_WAIT_V(2); PG8_BAR;
    PG8_STAGE(PG8_SB(1, 0), cB + kstep, voffB); PG8_STAGE(PG8_SA(1, 0), cA + kstep, voffA[0]); PG8_STAGE(PG8_SB(1, 1), cB + hsB + kstep, voffB);
    PG8_WAIT_V(6); PG8_BAR;
    for (;;) {
        const bool has_next = S.next(ui + 1, nxt);
        if constexpr (Sched::GATHER) { if (has_next) S.aoffs(nxt, Rr, Cc, lda, nvoffA); else {
#pragma unroll
            for (int h = 0; h < 2; ++h)
#pragma unroll
                for (int i = 0; i < 2; ++i) nvoffA[h][i] = voffA[h][i]; } }
        const char* nA = has_next ? nxt.a : cA; const char* nB = has_next ? nxt.b : cB;
#pragma unroll
        for (int a = 0; a < 2; ++a)
#pragma unroll
            for (int b = 0; b < 2; ++b)
#pragma unroll
                for (int m = 0; m < 4; ++m)
#pragma unroll
                    for (int n = 0; n < 2; ++n) acc[a][b][m][n] = (f32x4){0.f, 0.f, 0.f, 0.f};
#pragma unroll 1
        for (int t = 0; t < nt; t += 2) {
            const bool last = (t == nt - 2);
            const char* a1 = cA + (size_t)(t + 1) * kstep;
            const char* a2 = last ? nA : cA + (size_t)(t + 2) * kstep; const char* b2 = last ? nB : cB + (size_t)(t + 2) * kstep;
            const char* a3 = a2 + kstep; const char* b3 = b2 + kstep;
            unsigned vA2[2][2];
#pragma unroll
            for (int h = 0; h < 2; ++h)
#pragma unroll
                for (int i = 0; i < 2; ++i) vA2[h][i] = (Sched::GATHER && last) ? nvoffA[h][i] : voffA[h][i];
            PG8_LDB(B0, 0, 0); PG8_LDB(B1, 0, 1); PG8_SCHED; PG8_LDA(At, 0, 0); PG8_STAGE(PG8_SA(1, 1), a1 + hsA, voffA[1]);
            PG8_WAIT_V(8); PG8_WAIT_L(0); PG8_BAR; PG8_MMA(0, 0, At, B0); PG8_MMA(0, 1, At, B1); PG8_BAR; PG8_SCHED;
            PG8_LDA(At, 0, 1); PG8_STAGE(PG8_SB(0, 0), b2, voffB); PG8_STAGE(PG8_SB(0, 1), b2 + hsB, voffB); PG8_STAGE(PG8_SA(0, 0), a2, vA2[0]);
            PG8_WAIT_V(8); PG8_WAIT_L(0); PG8_BAR; PG8_MMA(1, 0, At, B0); PG8_MMA(1, 1, At, B1); PG8_BAR; PG8_SCHED;
            PG8_LDB(B0, 1, 0); PG8_LDB(B1, 1, 1); PG8_SCHED; PG8_LDA(At, 1, 0); PG8_STAGE(PG8_SA(0, 1), a2 + hsA, vA2[1]);
            PG8_WAIT_V(8); PG8_WAIT_L(0); PG8_BAR; PG8_MMA(0, 0, At, B0); PG8_MMA(0, 1, At, B1); PG8_BAR; PG8_SCHED;
            PG8_LDA(At, 1, 1); PG8_STAGE(PG8_SB(1, 0), b3, voffB); PG8_STAGE(PG8_SB(1, 1), b3 + hsB, voffB); PG8_STAGE(PG8_SA(1, 0), a3, vA2[0]);
            PG8_WAIT_V(8); PG8_WAIT_L(0); PG8_BAR; PG8_MMA(1, 0, At, B0); PG8_MMA(1, 1, At, B1); PG8_BAR; PG8_SCHED;
        }
        if constexpr (ALIGN_EPI) { if (wr == 0) PG8_BAR; }
        if constexpr (F8) asm volatile("s_nop 15\n\ts_nop 15" ::: "memory");
        E(acc, cur, wr, wc, fr, fq);
        if (!has_next) break;
        cur = nxt; cA = nA; cB = nB; ++ui;
        if constexpr (Sched::GATHER) {
#pragma unroll
            for (int h = 0; h < 2; ++h)
#pragma unroll
                for (int i = 0; i < 2; ++i) voffA[h][i] = nvoffA[h][i]; }
        if constexpr (ALIGN_EPI) { if (wr == 1) PG8_BAR; }
    }
    PG8_WAIT_V(0);
    if constexpr (!ALIGN_EPI) { if (wr == 0) PG8_BAR; }
    PG8_BAR;
#undef PG8_SA
#undef PG8_SB
#undef PG8_STAGE
#undef PG8_LDA
#undef PG8_LDB
#undef PG8_MMA
#undef PG8_WAIT_V
#undef PG8_WAIT_L
#undef PG8_BAR
#undef PG8_SCHED
}

typedef f32x4 AccT[2][2][4][2];
__device__ __forceinline__ u32x4 pack8(const f32x4 v0, const f32x4 v1) { u32x4 w; w.x = cvt_pk_bf16(v0[0], v0[1]); w.y = cvt_pk_bf16(v0[2], v0[3]); w.z = cvt_pk_bf16(v1[0], v1[1]); w.w = cvt_pk_bf16(v1[2], v1[3]); return w; }

struct EpiInProj {
    static constexpr bool PERM = true;
    bf16_t *U, *Vg, *C3, *KR, *GA, *GB; float* RS; const float* COS; const float* SIN; int pmode; float ascale;
    __device__ __forceinline__ void operator()(const AccT& acc, const Unit& u, int wr, int wc, int fr, int fq) const {
        const int row0 = u.pm * BM + wr * 64 + fr, pn = pmode == 0 ? u.pn : pmode == 1 ? (u.pn < 8 ? u.pn : u.pn + 3) : (u.pn < 3 ? u.pn + 8 : u.pn + 12), cw = wc * 32 + 8 * fq;
        if (pn < 8 || pn >= 11) {
            bf16_t* base; int ct; bool gel;
            if (pn < 4) { base = U; ct = pn; gel = true; } else if (pn < 8) { base = Vg; ct = pn - 4; gel = true; } else if (pn < 15) { base = GA; ct = pn - 11; gel = false; } else { base = GB; ct = pn - 15; gel = false; }
#pragma unroll
            for (int ai = 0; ai < 2; ++ai)
#pragma unroll
                for (int m = 0; m < 4; ++m) { bf16_t* rowp = base + (size_t)(row0 + ai * HALF + m * 16) * DM + ct * BM + cw;
#pragma unroll
                    for (int bj = 0; bj < 2; ++bj) { f32x4 v0 = acc[ai][bj][m][0] * ascale, v1 = acc[ai][bj][m][1] * ascale;
#pragma unroll
                        for (int i = 0; i < 4; ++i) { v0[i] = gel ? gelu_tanh(v0[i]) : sigmoid_f(v0[i]); v1[i] = gel ? gelu_tanh(v1[i]) : sigmoid_f(v1[i]); }
                        *(u32x4*)(rowp + bj * HALF) = pack8(v0, v1); } }
        } else {
            const int ct = pn - 8;
#pragma unroll
            for (int ai = 0; ai < 2; ++ai)
#pragma unroll
                for (int m = 0; m < 4; ++m) { const int row = row0 + ai * HALF + m * 16;
#pragma unroll
                    for (int bj = 0; bj < 2; ++bj) { const f32x4 v0 = acc[ai][bj][m][0] * ascale, v1 = acc[ai][bj][m][1] * ascale;
                        if (ct == 2 && bj == 1) {
                            if (wc < 2) { const int j0 = 16 * wc + 4 * fq; const f32x4 cs = *(const f32x4*)(COS + (size_t)row * 32 + j0), sn = *(const f32x4*)(SIN + (size_t)row * 32 + j0);
                                const f32x4 o0 = v0 * cs - v1 * sn, o1 = v0 * sn + v1 * cs;
                                if (ATT_FP8) *(u32x2*)((unsigned char*)KR + (size_t)row * 64 + cw) = pack8_fp8(o0 * K8MUL, o1 * K8MUL); else *(u32x4*)(KR + (size_t)row * 64 + cw) = pack8(o0, o1); }
                        } else {
                            *(u32x4*)(C3 + (size_t)row * 768 + ct * BM + bj * HALF + cw) = pack8(v0, v1);
                            float s = (v0[0] * v0[0] + v0[1] * v0[1]) + (v0[2] * v0[2] + v0[3] * v0[3]) + (v1[0] * v1[0] + v1[1] * v1[1]) + (v1[2] * v1[2] + v1[3] * v1[3]);
                            s += __shfl_xor(s, 16); s += __shfl_xor(s, 32);
                            if (fq == 0) RS[(size_t)row * 24 + ct * 8 + bj * 4 + wc] = s; } }
                    asm volatile("" ::: "memory"); }
        }
    }
};
struct EpiQ {
    static constexpr bool PERM = true;
    bf16_t *Qn, *Qr; const float* RS; const float* COS; const float* SIN;
    __device__ __forceinline__ void operator()(const AccT& acc, const Unit& u, int wr, int wc, int fr, int fq) const {
        const unsigned row0 = u.pm * BM + wr * 64 + fr, pn = u.pn, cw = wc * 32 + 8 * fq;
#pragma unroll
        for (int ai = 0; ai < 2; ++ai) {
            float scv[4];
#pragma unroll
            for (int m = 0; m < 4; ++m) { const float* rs = RS + (row0 + ai * HALF + m * 16) * 24u;
                const f32x4 r0 = *(const f32x4*)(rs), r1 = *(const f32x4*)(rs + 4), r2 = *(const f32x4*)(rs + 8);
                const float ss = ((r0[0] + r0[1]) + (r0[2] + r0[3])) + ((r1[0] + r1[1]) + (r1[2] + r1[3])) + ((r2[0] + r2[1]) + (r2[2] + r2[3]));
                scv[m] = (ATT_FP8 ? QSCALE * Q8MUL : QSCALE) * __builtin_amdgcn_rsqf(ss * (1.0f / QLORA) + RMS_EPS); }
            f32x4 csv[4], snv[4];
            if (pn >= 4) {
#pragma unroll
                for (int m = 0; m < 4; ++m) { const unsigned j0 = (row0 + ai * HALF + m * 16) * 32u + 16 * (wc & 1) + 4 * fq; csv[m] = *(const f32x4*)(COS + j0); snv[m] = *(const f32x4*)(SIN + j0); } }
#pragma unroll
            for (int m = 0; m < 4; ++m) { const unsigned row = row0 + ai * HALF + m * 16; const float sc = scv[m];
                if (pn < 4) { const unsigned eo = row * 1024u + pn * BM + cw;
#pragma unroll
                    for (int bj = 0; bj < 2; ++bj) { if (ATT_FP8) *(u32x2*)((unsigned char*)Qn + eo + bj * HALF) = pack8_fp8(acc[ai][bj][m][0] * sc, acc[ai][bj][m][1] * sc); else *(u32x4*)(Qn + eo + bj * HALF) = pack8(acc[ai][bj][m][0] * sc, acc[ai][bj][m][1] * sc); }
                } else { const f32x4 cs = csv[m] * sc, sn = snv[m] * sc;
                    const unsigned eo = row * 512u + (pn - 4) * BM + cw;
#pragma unroll
                    for (int bj = 0; bj < 2; ++bj) { const f32x4 v0 = acc[ai][bj][m][0], v1 = acc[ai][bj][m][1];
                        if (ATT_FP8) *(u32x2*)((unsigned char*)Qr + eo + bj * HALF) = pack8_fp8(v0 * cs - v1 * sn, v0 * sn + v1 * cs); else *(u32x4*)(Qr + eo + bj * HALF) = pack8(v0 * cs - v1 * sn, v0 * sn + v1 * cs); } }
            }
            asm volatile("" ::: "memory");
        }
    }
};
struct EpiKV {
    static constexpr bool PERM = true;
    bf16_t *Kn, *Vv; const float* RS;
    __device__ __forceinline__ void operator()(const AccT& acc, const Unit& u, int wr, int wc, int fr, int fq) const {
        const unsigned row0 = u.pm * BM + wr * 64 + fr, pn = u.pn, cw = wc * 32 + 8 * fq;
        bf16_t* base = pn < 4 ? Kn : Vv; const unsigned ct = pn & 3;
        float scv[8];
#pragma unroll
        for (int q = 0; q < 8; ++q) { const float* rs = RS + (row0 + (q >> 2) * HALF + (q & 3) * 16) * 24u;
            const f32x4 r0 = *(const f32x4*)(rs + 12), r1 = *(const f32x4*)(rs + 16);
            scv[q] = __builtin_amdgcn_rsqf((((r0[0] + r0[1]) + (r0[2] + r0[3])) + ((r1[0] + r1[1]) + (r1[2] + r1[3]))) * (1.0f / KVLORA) + RMS_EPS); }
        asm volatile("" ::: "memory");
#pragma unroll
        for (int ai = 0; ai < 2; ++ai)
#pragma unroll
            for (int m = 0; m < 4; ++m) { const unsigned row = row0 + ai * HALF + m * 16; const float sc = scv[ai * 4 + m] * ((ATT_FP8 && pn < 4) ? K8MUL : 1.0f);
                const unsigned eo = row * 1024u + ct * BM + cw;
#pragma unroll
                for (int bj = 0; bj < 2; ++bj) { if (ATT_FP8 && pn < 4) *(u32x2*)((unsigned char*)Kn + eo + bj * HALF) = pack8_fp8(acc[ai][bj][m][0] * sc, acc[ai][bj][m][1] * sc); else *(u32x4*)(base + eo + bj * HALF) = pack8(acc[ai][bj][m][0] * sc, acc[ai][bj][m][1] * sc); }
                if (m & 1) asm volatile("" ::: "memory");
            }
    }
};
struct EpiVT {
    static constexpr bool PERM = true;
    unsigned char* VT; const float* RS;
    __device__ __forceinline__ void operator()(const AccT& acc, const Unit& u, int wr, int wc, int fr, int fq) const {
        const unsigned hd0 = u.pm * BM + wr * 64 + fr;
#pragma unroll
        for (int bj = 0; bj < 2; ++bj) { const unsigned tb = u.pn * BM + bj * HALF + wc * 32 + 8 * fq;
            float rs[8];
#pragma unroll
            for (int i = 0; i < 8; ++i) { const float* p = RS + (tb + i) * 24u + 12; const f32x4 r0 = *(const f32x4*)p, r1 = *(const f32x4*)(p + 4);
                rs[i] = __builtin_amdgcn_rsqf((((r0[0] + r0[1]) + (r0[2] + r0[3])) + ((r1[0] + r1[1]) + (r1[2] + r1[3]))) * (1.0f / KVLORA) + RMS_EPS); }
            const unsigned b = tb >> 13, s0 = tb & 8191u, k0 = s0 & 63u;
            const unsigned cbase = (s0 & ~63u) + 16u * (k0 >> 5) + 4u * ((k0 >> 3) & 3u);
#pragma unroll
            for (int ai = 0; ai < 2; ++ai)
#pragma unroll
                for (int m = 0; m < 4; ++m) { const unsigned hd = hd0 + ai * HALF + m * 16; unsigned char* dst = VT + ((size_t)(b * 1024u + hd) * 8192u + cbase);
                    const f32x4 v0 = acc[ai][bj][m][0], v1 = acc[ai][bj][m][1];
                    int a = __builtin_amdgcn_cvt_pk_fp8_f32(v0[0] * rs[0], v0[1] * rs[1], 0, false); a = __builtin_amdgcn_cvt_pk_fp8_f32(v0[2] * rs[2], v0[3] * rs[3], a, true);
                    int c = __builtin_amdgcn_cvt_pk_fp8_f32(v1[0] * rs[4], v1[1] * rs[5], 0, false); c = __builtin_amdgcn_cvt_pk_fp8_f32(v1[2] * rs[6], v1[3] * rs[7], c, true);
                    *(unsigned*)dst = (unsigned)a; *(unsigned*)(dst + 32) = (unsigned)c; }
            asm volatile("" ::: "memory"); }
    }
};
template <bool ADD> struct EpiGate {
    static constexpr bool PERM = true;
    bf16_t* O; const bf16_t* G; const bf16_t* Y; float ascale;
    __device__ __forceinline__ void operator()(const AccT& acc, const Unit& u, int wr, int wc, int fr, int fq) const {
        const unsigned row0 = u.pm * BM + wr * 64 + fr, cw = u.pn * BM + wc * 32 + 8 * fq;
#pragma unroll
        for (int ai = 0; ai < 2; ++ai) {
            u32x4 gv[4][2], yv[4][2];
#pragma unroll
            for (int m = 0; m < 4; ++m)
#pragma unroll
                for (int bj = 0; bj < 2; ++bj) { const unsigned ro = (row0 + ai * HALF + m * 16) * DM + cw + bj * HALF; gv[m][bj] = *(const u32x4*)(G + ro); if (ADD) yv[m][bj] = *(const u32x4*)(Y + ro); }
#pragma unroll
            for (int m = 0; m < 4; ++m)
#pragma unroll
                for (int bj = 0; bj < 2; ++bj) { const unsigned ro = (row0 + ai * HALF + m * 16) * DM + cw + bj * HALF; const u32x4 g = gv[m][bj]; f32x4 v0 = acc[ai][bj][m][0] * ascale, v1 = acc[ai][bj][m][1] * ascale;
                    v0[0] *= bf_lo(g.x); v0[1] *= bf_hi(g.x); v0[2] *= bf_lo(g.y); v0[3] *= bf_hi(g.y); v1[0] *= bf_lo(g.z); v1[1] *= bf_hi(g.z); v1[2] *= bf_lo(g.w); v1[3] *= bf_hi(g.w);
                    if (ADD) { const u32x4 y = yv[m][bj];
                        v0[0] += bf_lo(y.x); v0[1] += bf_hi(y.x); v0[2] += bf_lo(y.y); v0[3] += bf_hi(y.y); v1[0] += bf_lo(y.z); v1[1] += bf_hi(y.z); v1[2] += bf_lo(y.w); v1[3] += bf_hi(y.w); }
                    *(u32x4*)(O + ro) = pack8(v0, v1); }
            asm volatile("" ::: "memory");
        }
    }
};
struct EpiPre {
    static constexpr bool PERM = false;
    float* P; const float* X;
    __device__ __forceinline__ void operator()(const AccT& acc, const Unit& u, int wr, int wc, int fr, int fq) const {
        const int row0 = u.pm * BM + wr * 64 + fr, col0 = u.pn * BM + wc * 32 + 4 * fq;
#pragma unroll
        for (int ai = 0; ai < 2; ++ai)
#pragma unroll
            for (int m = 0; m < 4; ++m) { const size_t ro = (size_t)(row0 + ai * HALF + m * 16) * DM + col0;
#pragma unroll
                for (int bj = 0; bj < 2; ++bj)
#pragma unroll
                    for (int n = 0; n < 2; ++n) { const f32x4 xv = *(const f32x4*)(X + ro + bj * HALF + n * 16); *(f32x4*)(P + ro + bj * HALF + n * 16) = xv * DN_ALPHA + acc[ai][bj][m][n]; }
                if (m & 1) asm volatile("" ::: "memory"); }
    }
};
struct EpiF32 {
    static constexpr bool PERM = false;
    float* C; int ldc;
    __device__ __forceinline__ void operator()(const AccT& acc, const Unit& u, int wr, int wc, int fr, int fq) const {
        const int row0 = u.pm * BM + wr * 64 + fr, col0 = u.pn * BM + wc * 32 + 4 * fq;
#pragma unroll
        for (int ai = 0; ai < 2; ++ai)
#pragma unroll
            for (int m = 0; m < 4; ++m) { float* rowp = C + (size_t)(row0 + ai * HALF + m * 16) * ldc + col0;
#pragma unroll
                for (int bj = 0; bj < 2; ++bj)
#pragma unroll
                    for (int n = 0; n < 2; ++n) *(f32x4*)(rowp + bj * HALF + n * 16) = acc[ai][bj][m][n]; }
    }
};
template <bool GATH> struct MoeSched {
    static constexpr bool GATHER = GATH;
    const char* A; const char* Bt; size_t atile, bexp, btile; int npn, ntm, nwg, G, c, rep;
    const LAS int* tile2e; const LAS int* tbase; const LAS int* cntL; const int* list;
    __device__ __forceinline__ bool next(int i, Unit& u) const {
        long L = (long)i * G + c; if (L >= (long)nwg * rep) return false; if (L >= nwg) L -= nwg;
        const int wgid = xcd_remap((int)L, nwg);
        const int tile = wgid / npn, pn = wgid - tile * npn;
        int e, r0, cnt;
        if (tile < ntm) { e = __builtin_amdgcn_readfirstlane(tile2e[tile]); r0 = (tile - __builtin_amdgcn_readfirstlane(tbase[e])) * BM; cnt = __builtin_amdgcn_readfirstlane(cntL[e]) - r0; cnt = cnt > BM ? BM : cnt; u.a = GATH ? A : A + (size_t)tile * atile; }
        else { e = NE; r0 = 0; cnt = BM; u.a = A + (size_t)(GATH ? (tile - ntm) : tile) * atile; }
        u.b = Bt + (size_t)e * bexp + (size_t)pn * btile; u.pm = tile; u.pn = pn; u.e = e; u.cnt = cnt; u.r0 = r0; return true; }
    __device__ __forceinline__ void aoffs(const Unit& u, const int (&R)[2], const int (&C)[2], int lda, unsigned (&off)[2][2]) const {
#pragma unroll
        for (int h = 0; h < 2; ++h)
#pragma unroll
            for (int i = 0; i < 2; ++i) { const int row = h * HALF + R[i];
                if (u.e == NE) off[h][i] = (unsigned)(row * lda + C[i]) * 2u;
                else { const int rr = row < u.cnt ? row : 0; const int pair = list[(size_t)u.e * T + u.r0 + rr]; off[h][i] = (unsigned)((pair >> 3) * lda + C[i]) * 2u; } }
    }
};
struct EpiGU {
    static constexpr bool PERM = true;
    bf16_t* ACT;
    __device__ __forceinline__ void operator()(const AccT& acc, const Unit& u, int wr, int wc, int fr, int fq) const {
        const int row0 = u.pm * BM + wr * 64 + fr, cw = u.pn * HALF + wc * 32 + 8 * fq;
#pragma unroll
        for (int ai = 0; ai < 2; ++ai)
#pragma unroll
            for (int m = 0; m < 4; ++m) { f32x4 g0 = acc[ai][0][m][0], g1 = acc[ai][0][m][1]; const f32x4 u0 = acc[ai][1][m][0], u1 = acc[ai][1][m][1];
#pragma unroll
                for (int i = 0; i < 4; ++i) { const float ws_ = MOE_FP8 ? 1.0f / W8MUL : 1.0f; const float ga = g0[i] * ws_, gb = g1[i] * ws_; g0[i] = ga * sigmoid_f(ga) * (u0[i] * ws_); g1[i] = gb * sigmoid_f(gb) * (u1[i] * ws_); }
                if (MOE_FP8) *(u32x2*)((unsigned char*)ACT + (size_t)(row0 + ai * HALF + m * 16) * DE + cw) = pack8_fp8(g0, g1); else *(u32x4*)(ACT + (size_t)(row0 + ai * HALF + m * 16) * DE + cw) = pack8(g0, g1); }
    }
};
struct EpiDown {
    static constexpr bool PERM = true;
    unsigned char *YP, *YS; const int* list; const float* TOPW; int ntm;
    __device__ __forceinline__ void operator()(const AccT& acc, const Unit& u, int wr, int wc, int fr, int fq) const {
        const unsigned cw = u.pn * BM + wc * 32 + 8 * fq;
        const bool shared = (u.e == NE);
        unsigned char* base = shared ? YS + (size_t)(u.pm - ntm) * BM * DM : YP;
        const int* lst = list + (shared ? 0u : (unsigned)u.e * (unsigned)T + (unsigned)u.r0);
        unsigned drow[8]; float wv[8];
#pragma unroll
        for (int q = 0; q < 8; ++q) { const unsigned r = (q >> 2) * HALF + wr * 64 + (q & 3) * 16 + fr; drow[q] = r; if (!shared) drow[q] = (unsigned)lst[(int)r < u.cnt ? r : 0u]; }
        const float* lw = TOPW + (shared ? 0u : (unsigned)u.e * (unsigned)T + (unsigned)u.r0);
#pragma unroll
        for (int q = 0; q < 8; ++q) { const unsigned r = (q >> 2) * HALF + wr * 64 + (q & 3) * 16 + fr; wv[q] = (shared ? 1.0f : lw[(int)r < u.cnt ? r : 0u]) * (MOE_FP8 ? Y8MUL / W8MUL : Y8MUL); }
#pragma unroll
        for (int ai = 0; ai < 2; ++ai)
#pragma unroll
            for (int m = 0; m < 4; ++m) { const unsigned r = ai * HALF + wr * 64 + m * 16 + fr; const float w = wv[ai * 4 + m];
                if (shared || (int)r < u.cnt) { unsigned char* dst = base + (drow[ai * 4 + m] * 1024u + cw);
#pragma unroll
                    for (int bj = 0; bj < 2; ++bj) *(u32x2*)(dst + bj * HALF) = pack8_fp8(acc[ai][bj][m][0] * w, acc[ai][bj][m][1] * w); }
                if (m & 1) asm volatile("" ::: "memory"); }
    }
};
}

namespace att {
constexpr int NW = 8, QBLK = 32, KVBLK = 64;
constexpr int SHM_V = 16384, SHM_KN = 16384, SHM_KR = 8192;
constexpr int OFF_V = 0, OFF_KN = 2 * SHM_V, OFF_KR = OFF_KN + 2 * SHM_KN, OFF_WS = OFF_KR + 2 * SHM_KR, OFF_QR = OFF_WS + NW * 64 * 4, LDS_BYTES = OFF_QR + NW * 4096;
constexpr float THRL = 8.0f * LOG2E;
constexpr float THRL8 = 6.0f;
#define KSW(row, colB) ((row) * 256 + ((colB) ^ (((row) & 15) << 4)))
#define KRSW(row, ch) ((row) * 128 + ((((ch) ^ (((row) >> 1) & 7))) << 4))
#define SBAR() __builtin_amdgcn_sched_barrier(0)
__device__ __forceinline__ int crow(int r, int hi) { return (r & 3) + 8 * (r >> 2) + 4 * hi; }
__device__ __forceinline__ unsigned cvtpk(float lo, float hi) { unsigned r; asm volatile("v_cvt_pk_bf16_f32 %0, %1, %2" : "=v"(r) : "v"(lo), "v"(hi)); return r; }
__device__ __forceinline__ void partialSM(f32x16& p0, f32x16& p1, float& m_reg, float& mn, float& alpha) {
    float pmax = p0[0];
#pragma unroll
    for (int r = 1; r < 16; ++r) pmax = fmaxf(pmax, p0[r]);
#pragma unroll
    for (int r = 0; r < 16; ++r) pmax = fmaxf(pmax, p1[r]);
    { auto rr = __builtin_amdgcn_permlane32_swap(__float_as_uint(pmax), __float_as_uint(pmax), false, false); pmax = fmaxf(__uint_as_float(rr[0]), __uint_as_float(rr[1])); }
    if (__builtin_expect(__all(pmax - m_reg <= THRL), 1)) { mn = m_reg; alpha = 1.f; }
    else { mn = fmaxf(m_reg, pmax); alpha = __builtin_amdgcn_exp2f(m_reg - mn); m_reg = mn; }
#pragma unroll
    for (int r = 0; r < 16; ++r) p0[r] = p0[r] - mn;
#pragma unroll
    for (int r = 0; r < 16; ++r) p1[r] = p1[r] - mn;
#pragma unroll
    for (int r = 0; r < 16; ++r) p0[r] = __builtin_amdgcn_exp2f(p0[r]);
}
__device__ __forceinline__ void finishSM(f32x16& p0, f32x16& p1, float alpha, float& l_reg, bf16x8& pa0, bf16x8& pa1, bf16x8& pa2, bf16x8& pa3) {
#pragma unroll
    for (int r = 0; r < 16; ++r) p1[r] = __builtin_amdgcn_exp2f(p1[r]);
    float ps = 0;
#pragma unroll
    for (int r = 0; r < 16; ++r) ps += p0[r];
#pragma unroll
    for (int r = 0; r < 16; ++r) ps += p1[r];
    { auto rr = __builtin_amdgcn_permlane32_swap(__float_as_uint(ps), __float_as_uint(ps), false, false); ps = __uint_as_float(rr[0]) + __uint_as_float(rr[1]); }
    l_reg = l_reg * alpha + ps;
#define PK4(P, BASE, OUT) do { unsigned a0 = cvtpk(P[BASE + 0], P[BASE + 1]), a1 = cvtpk(P[BASE + 2], P[BASE + 3]);   \
    unsigned b0 = cvtpk(P[BASE + 4], P[BASE + 5]), b1 = cvtpk(P[BASE + 6], P[BASE + 7]);                              \
    auto r0 = __builtin_amdgcn_permlane32_swap(a0, b0, false, false); auto r1 = __builtin_amdgcn_permlane32_swap(a1, b1, false, false); \
    u32x4 w = {r0[0], r1[0], r0[1], r1[1]}; OUT = *reinterpret_cast<bf16x8*>(&w); } while (0)
    PK4(p0, 0, pa0); PK4(p0, 8, pa1); PK4(p1, 0, pa2); PK4(p1, 8, pa3);
#undef PK4
}
__device__ __forceinline__ void qkt(f32x16& p0, f32x16& p1, const char* Kn, const char* Kr, const bf16x8* qr, const char* qrl, int r32, int hi) {
    p0 = f32x16{}; p1 = f32x16{};
#pragma unroll
    for (int d0 = 0; d0 < 8; ++d0) { const int cb = (d0 * 16 + hi * 8) * 2;
        const bf16x8 b0 = *reinterpret_cast<const bf16x8*>(Kn + KSW(r32, cb));
        const bf16x8 b1 = *reinterpret_cast<const bf16x8*>(Kn + KSW(32 + r32, cb));
        p0 = __builtin_amdgcn_mfma_f32_32x32x16_bf16(b0, qr[d0], p0, 0, 0, 0);
        p1 = __builtin_amdgcn_mfma_f32_32x32x16_bf16(b1, qr[d0], p1, 0, 0, 0); }
#pragma unroll
    for (int d0 = 0; d0 < 4; ++d0) { const int ch = d0 * 2 + hi;
        const bf16x8 b0 = *reinterpret_cast<const bf16x8*>(Kr + KRSW(r32, ch));
        const bf16x8 b1 = *reinterpret_cast<const bf16x8*>(Kr + KRSW(32 + r32, ch));
        const bf16x8 qv = *reinterpret_cast<const bf16x8*>(qrl + d0 * 1024);
        p0 = __builtin_amdgcn_mfma_f32_32x32x16_bf16(b0, qv, p0, 0, 0, 0);
        p1 = __builtin_amdgcn_mfma_f32_32x32x16_bf16(b1, qv, p1, 0, 0, 0); }
}
__device__ __forceinline__ int v_st(int k, int c) { const int kk = (k & ~0xC) | ((k & 4) << 1) | ((k & 8) >> 1); return ((kk >> 3) * 4 + (c >> 5)) * 512 + ((kk & 7) * 32 + (c & 31)) * 2; }
__device__ __forceinline__ int v_rd_base(int lane) { return ((lane & 3) << 3) | (((lane >> 2) & 3) << 6) | (((lane >> 4) & 1) << 5) | (((lane >> 5) & 1) << 8); }
constexpr int v_rd_off(int d0, int ks, int half) { return d0 * 512 + ks * 4096 + half * 2048; }
template <int OFF> __device__ __forceinline__ s16x4 tr_read(int vb) { s16x4 r; asm volatile("ds_read_b64_tr_b16 %0, %1 offset:%2" : "=&v"(r) : "v"(vb), "i"(OFF) : "memory"); return r; }
template <int D0> __device__ __forceinline__ void pv_one(f32x16& od, int vb, bf16x8 pa0, bf16x8 pa1, bf16x8 pa2, bf16x8 pa3) {
    const s16x4 l0 = tr_read<v_rd_off(D0, 0, 0)>(vb), h0 = tr_read<v_rd_off(D0, 0, 1)>(vb), l1 = tr_read<v_rd_off(D0, 1, 0)>(vb), h1 = tr_read<v_rd_off(D0, 1, 1)>(vb);
    const s16x4 l2 = tr_read<v_rd_off(D0, 2, 0)>(vb), h2 = tr_read<v_rd_off(D0, 2, 1)>(vb), l3 = tr_read<v_rd_off(D0, 3, 0)>(vb), h3 = tr_read<v_rd_off(D0, 3, 1)>(vb);
    asm volatile("s_waitcnt lgkmcnt(0)" ::: "memory"); SBAR();
#define PK(L, H) (bf16x8){L[0], L[1], L[2], L[3], H[0], H[1], H[2], H[3]}
    od = __builtin_amdgcn_mfma_f32_32x32x16_bf16(pa0, PK(l0, h0), od, 0, 0, 0);
    od = __builtin_amdgcn_mfma_f32_32x32x16_bf16(pa1, PK(l1, h1), od, 0, 0, 0);
    od = __builtin_amdgcn_mfma_f32_32x32x16_bf16(pa2, PK(l2, h2), od, 0, 0, 0);
    od = __builtin_amdgcn_mfma_f32_32x32x16_bf16(pa3, PK(l3, h3), od, 0, 0, 0);
#undef PK
}
__device__ __forceinline__ void pv_d0(f32x16* o, int vb, bf16x8 pa0, bf16x8 pa1, bf16x8 pa2, bf16x8 pa3) {
    pv_one<0>(o[0], vb, pa0, pa1, pa2, pa3); pv_one<1>(o[1], vb, pa0, pa1, pa2, pa3); pv_one<2>(o[2], vb, pa0, pa1, pa2, pa3); pv_one<3>(o[3], vb, pa0, pa1, pa2, pa3);
}
typedef short v4i16_t __attribute__((ext_vector_type(4)));
typedef __attribute__((address_space(3))) const char* lcp;
#ifndef ATT_SD
#define ATT_SD 5
#endif
#ifndef ATT_PRIO_MFMA
#define ATT_PRIO_MFMA 1
#endif
#ifndef ATT_PRIO_VALU
#define ATT_PRIO_VALU 0
#endif
constexpr int SD = ATT_SD, NSL = ATT_SD + 1;
struct Seg1Regs { bf16x8 fa[NSL]; bf16x8 fq[2]; };
template <int I, bool PV, int VAR> __device__ __forceinline__ void seg1_read(Seg1Regs& R, lcp kn, lcp kr, lcp ql, lcp vp, unsigned kx, unsigned krx, int hi) {
    if constexpr (VAR == 3) { asm volatile("" : "=v"(R.fa[I % NSL])); if constexpr (I >= 16 && I < 24 && ((I & 1) == 0)) asm volatile("" : "=v"(R.fq[((I - 16) >> 1) & 1])); }
    else if constexpr (I < 16) { constexpr int d0 = I >> 1, wh = I & 1; R.fa[I % NSL] = *(const __attribute__((address_space(3))) bf16x8*)(kn + wh * 8192 + (((unsigned)(d0 * 32 + hi * 16)) ^ kx)); }
    else if constexpr (I < 24) { constexpr int d0 = (I - 16) >> 1, wh = (I - 16) & 1; R.fa[I % NSL] = *(const __attribute__((address_space(3))) bf16x8*)(kr + wh * 4096 + ((((unsigned)(d0 * 2 + hi)) ^ krx) << 4));
        if constexpr (wh == 0) R.fq[d0 & 1] = *(const __attribute__((address_space(3))) bf16x8*)(ql + d0 * 1024); }
    else if constexpr (I < 40) { if constexpr (PV) { constexpr int d0 = (I - 24) >> 2, ks = (I - 24) & 3;
        const s16x4 lo = __builtin_bit_cast(s16x4, __builtin_amdgcn_ds_read_tr16_b64_v4i16((__attribute__((address_space(3))) v4i16_t*)(vp + v_rd_off(d0, ks, 0))));
        const s16x4 hh = __builtin_bit_cast(s16x4, __builtin_amdgcn_ds_read_tr16_b64_v4i16((__attribute__((address_space(3))) v4i16_t*)(vp + v_rd_off(d0, ks, 1))));
        R.fa[I % NSL] = (bf16x8){lo[0], lo[1], lo[2], lo[3], hh[0], hh[1], hh[2], hh[3]}; } }
}
template <int I, bool PV, int VAR> __device__ __forceinline__ void seg1_mfma(Seg1Regs& R, f32x16& p0, f32x16& p1, f32x16* o, const bf16x8* qr, const bf16x8 (&pa)[4]) {
    if constexpr (VAR == 2) { asm volatile("" :: "v"(R.fa[I % NSL])); if constexpr (I >= 16 && I < 24) asm volatile("" :: "v"(R.fq[((I - 16) >> 1) & 1])); }
    else if constexpr (I < 16) { constexpr int d0 = I >> 1; if constexpr (I & 1) p1 = __builtin_amdgcn_mfma_f32_32x32x16_bf16(R.fa[I % NSL], qr[d0], p1, 0, 0, 0); else p0 = __builtin_amdgcn_mfma_f32_32x32x16_bf16(R.fa[I % NSL], qr[d0], p0, 0, 0, 0); }
    else if constexpr (I < 24) { constexpr int d0 = (I - 16) >> 1; if constexpr (I & 1) p1 = __builtin_amdgcn_mfma_f32_32x32x16_bf16(R.fa[I % NSL], R.fq[d0 & 1], p1, 0, 0, 0); else p0 = __builtin_amdgcn_mfma_f32_32x32x16_bf16(R.fa[I % NSL], R.fq[d0 & 1], p0, 0, 0, 0); }
    else if constexpr (PV) { constexpr int d0 = (I - 24) >> 2, ks = (I - 24) & 3; o[d0] = __builtin_amdgcn_mfma_f32_32x32x16_bf16(pa[ks], R.fa[I % NSL], o[d0], 0, 0, 0); }
}
template <int I, bool PV, int VAR> __device__ __forceinline__ void seg1_steps(Seg1Regs& R, f32x16& p0, f32x16& p1, f32x16* o, const bf16x8* qr, const bf16x8 (&pa)[4], lcp kn, lcp kr, lcp ql, lcp vp, unsigned kx, unsigned krx, int hi) {
    constexpr int NOPS = PV ? 40 : 24;
    if constexpr (I < NOPS) {
        if constexpr (I + SD < NOPS) seg1_read<I + SD, PV, VAR>(R, kn, kr, ql, vp, kx, krx, hi);
        seg1_mfma<I, PV, VAR>(R, p0, p1, o, qr, pa);
        SBAR();
        seg1_steps<I + 1, PV, VAR>(R, p0, p1, o, qr, pa, kn, kr, ql, vp, kx, krx, hi);
    }
}
template <bool PV, int VAR> __device__ __forceinline__ void seg1(f32x16& p0, f32x16& p1, f32x16* o, const bf16x8* qr, const bf16x8 (&pa)[4], lcp kn, lcp kr, lcp ql, lcp vp, unsigned kx, unsigned krx, int hi) {
    Seg1Regs R; p0 = f32x16{}; p1 = f32x16{};
    seg1_read<0, PV, VAR>(R, kn, kr, ql, vp, kx, krx, hi); seg1_read<1, PV, VAR>(R, kn, kr, ql, vp, kx, krx, hi); seg1_read<2, PV, VAR>(R, kn, kr, ql, vp, kx, krx, hi);
    if constexpr (SD > 3) seg1_read<3, PV, VAR>(R, kn, kr, ql, vp, kx, krx, hi); if constexpr (SD > 4) seg1_read<4, PV, VAR>(R, kn, kr, ql, vp, kx, krx, hi); if constexpr (SD > 5) seg1_read<5, PV, VAR>(R, kn, kr, ql, vp, kx, krx, hi);
    SBAR();
    seg1_steps<0, PV, VAR>(R, p0, p1, o, qr, pa, kn, kr, ql, vp, kx, krx, hi);
}
__device__ __forceinline__ void seg1_pv_only(f32x16* o, const bf16x8 (&pa)[4], lcp vp) {
#pragma unroll
    for (int d0 = 0; d0 < 4; ++d0) { bf16x8 vf[4];
#pragma unroll
        for (int ks = 0; ks < 4; ++ks) { const s16x4 lo = __builtin_bit_cast(s16x4, __builtin_amdgcn_ds_read_tr16_b64_v4i16((__attribute__((address_space(3))) v4i16_t*)(vp + v_rd_off(d0, ks, 0))));
            const s16x4 hh = __builtin_bit_cast(s16x4, __builtin_amdgcn_ds_read_tr16_b64_v4i16((__attribute__((address_space(3))) v4i16_t*)(vp + v_rd_off(d0, ks, 1))));
            vf[ks] = (bf16x8){lo[0], lo[1], lo[2], lo[3], hh[0], hh[1], hh[2], hh[3]}; }
#pragma unroll
        for (int ks = 0; ks < 4; ++ks) o[d0] = __builtin_amdgcn_mfma_f32_32x32x16_bf16(pa[ks], vf[ks], o[d0], 0, 0, 0); }
}
__device__ __forceinline__ void glds16(const void* gsrc, unsigned lds_dst) { unsigned keep;
    asm volatile("s_mov_b32 %0, m0\n\ts_mov_b32 m0, %2\n\ts_nop 0\n\tglobal_load_lds_dwordx4 %1, off\n\ts_mov_b32 m0, %0" : "=&s"(keep) : "v"(gsrc), "s"(lds_dst) : "memory"); }
__device__ __forceinline__ void glds16s(const char* sbase, unsigned voff, unsigned lds_dst) { unsigned keep;
    asm volatile("s_mov_b32 %0, m0\n\ts_mov_b32 m0, %3\n\ts_nop 0\n\tglobal_load_lds_dwordx4 %1, %2\n\ts_mov_b32 m0, %0" : "=&s"(keep) : "v"(voff), "s"(sbase), "s"(lds_dst) : "memory"); }
#define ABAR() asm volatile("s_waitcnt lgkmcnt(0)\n\ts_barrier" ::: "memory")
template <int VAR> __device__ __forceinline__ void softmax_tile(f32x16& p0, f32x16& p1, float& m_reg, float& l_reg, f32x16* o, float* al_l, int r32, int hi, bf16x8 (&pa)[4]) {
    float pm0 = fmaxf(p0[0], p0[1]), pm1 = fmaxf(p0[2], p0[3]);
#pragma unroll
    for (int r = 4; r < 16; r += 2) { pm0 = fmaxf(pm0, p0[r]); pm1 = fmaxf(pm1, p0[r + 1]); }
#pragma unroll
    for (int r = 0; r < 16; r += 2) { pm0 = fmaxf(pm0, p1[r]); pm1 = fmaxf(pm1, p1[r + 1]); }
    float pmax = fmaxf(pm0, pm1);
    { auto rr = __builtin_amdgcn_permlane32_swap(__float_as_uint(pmax), __float_as_uint(pmax), false, false); pmax = fmaxf(__uint_as_float(rr[0]), __uint_as_float(rr[1])); }
    float mn = m_reg, alpha = 1.f;
    if (!__builtin_expect(__all(pmax - m_reg <= THRL), 1)) { mn = fmaxf(m_reg, pmax); alpha = __builtin_amdgcn_exp2f(m_reg - mn); m_reg = mn; }
#pragma unroll
    for (int r = 0; r < 16; ++r) { if constexpr (VAR == 1) { p0[r] = p0[r] - mn; p1[r] = p1[r] - mn; } else { p0[r] = __builtin_amdgcn_exp2f(p0[r] - mn); p1[r] = __builtin_amdgcn_exp2f(p1[r] - mn); } }
    float s0 = p0[0] + p1[0], s1 = p0[1] + p1[1], s2 = p0[2] + p1[2], s3 = p0[3] + p1[3];
#pragma unroll
    for (int r = 4; r < 16; r += 4) { s0 += p0[r] + p1[r]; s1 += p0[r + 1] + p1[r + 1]; s2 += p0[r + 2] + p1[r + 2]; s3 += p0[r + 3] + p1[r + 3]; }
    float ps = (s0 + s1) + (s2 + s3);
    { auto rr = __builtin_amdgcn_permlane32_swap(__float_as_uint(ps), __float_as_uint(ps), false, false); ps = __uint_as_float(rr[0]) + __uint_as_float(rr[1]); }
    l_reg = l_reg * alpha + ps;
#define PK4(P, BASE, OUT) do { unsigned a0 = cvtpk(P[BASE + 0], P[BASE + 1]), a1 = cvtpk(P[BASE + 2], P[BASE + 3]);   \
    unsigned b0 = cvtpk(P[BASE + 4], P[BASE + 5]), b1 = cvtpk(P[BASE + 6], P[BASE + 7]);                              \
    auto r0 = __builtin_amdgcn_permlane32_swap(a0, b0, false, false); auto r1 = __builtin_amdgcn_permlane32_swap(a1, b1, false, false); \
    u32x4 w = {r0[0], r1[0], r0[1], r1[1]}; OUT = *reinterpret_cast<bf16x8*>(&w); } while (0)
    PK4(p0, 0, pa[0]); PK4(p0, 8, pa[1]); PK4(p1, 0, pa[2]); PK4(p1, 8, pa[3]);
#undef PK4
    if (__any(alpha < 1.f)) { if (hi == 0) al_l[r32] = alpha; asm volatile("s_waitcnt lgkmcnt(0)" ::: "memory");
#pragma unroll
        for (int d = 0; d < 4; ++d)
#pragma unroll
            for (int r = 0; r < 16; ++r) o[d][r] *= al_l[crow(r, hi)]; }
}
template <int VAR> __device__ __forceinline__ void attn_unit(const bf16_t* __restrict__ Qn, const bf16_t* __restrict__ Qr, const bf16_t* __restrict__ Kn, const bf16_t* __restrict__ KR, const bf16_t* __restrict__ Vv,
                                          bf16_t* __restrict__ O, long qrow0, long krow0, int h, int seq, LAS unsigned char* ldsl) {
    char* lds = (char*)ldsl;
    const int tid = threadIdx.x, wid = __builtin_amdgcn_readfirstlane(tid >> 6), lane = tid & 63, r32 = lane & 31, hi = lane >> 5;
    const int half = wid >> 2;
    char* V_lds = lds + OFF_V; char* Kn_lds = lds + OFF_KN; char* Kr_lds = lds + OFF_KR;
    float* ws = (float*)(lds + OFF_WS) + wid * 64; float* li_l = ws; float* al_l = ws + 32;
    float m_reg = -1e30f, l_reg = 0; f32x16 o[4] = {}; bf16x8 qr[8]; char* qrl = lds + OFF_QR + wid * 4096 + lane * 16;
    { const bf16_t* qn = Qn + (qrow0 + wid * QBLK + r32) * 1024 + h * 128 + hi * 8; const bf16_t* qp = Qr + (qrow0 + wid * QBLK + r32) * 512 + h * 64 + hi * 8;
#pragma unroll
      for (int d0 = 0; d0 < 8; ++d0) qr[d0] = *reinterpret_cast<const bf16x8*>(qn + d0 * 16);
#pragma unroll
      for (int d0 = 0; d0 < 4; ++d0) *reinterpret_cast<bf16x8*>(qrl + d0 * 1024) = *reinterpret_cast<const bf16x8*>(qp + d0 * 16);
#pragma unroll
      for (int d0 = 0; d0 < 8; ++d0) asm volatile("" :: "v"(qr[d0]));
    }
    const bf16_t* Kh = Kn + krow0 * 1024 + h * 128; const bf16_t* Vh = Vv + krow0 * 1024 + h * 128; const bf16_t* Rh = KR + krow0 * 64;
    unsigned kn_so[2], v_so[2], kr_so;
#pragma unroll
    for (int i = 0; i < 2; ++i) { const int p = 2 * wid + i;
        { const int row = 4 * p + (lane >> 4), pc = lane & 15, lc = pc ^ (row & 15); kn_so[i] = (unsigned)(row * 1024 + lc * 8); }
        { const int st = 2 * p + (lane >> 5), kk = (st >> 2) * 8 + ((lane & 31) >> 2), c = (st & 3) * 32 + (lane & 3) * 8; const int k = (kk & ~0xC) | ((kk & 4) << 1) | ((kk & 8) >> 1); v_so[i] = (unsigned)(k * 1024 + c); } }
    { const int row = 8 * wid + (lane >> 3), pc = lane & 7, lc = pc ^ ((row >> 1) & 7); kr_so = (unsigned)(row * 64 + lc * 8); }
    const int NT = seq / KVBLK;
    const unsigned lds0 = (unsigned)(uintptr_t)ldsl;
    const unsigned dk_ = (unsigned)__builtin_amdgcn_readfirstlane((int)(lds0 + OFF_KN + (2 * wid) * 1024)), dr_ = (unsigned)__builtin_amdgcn_readfirstlane((int)(lds0 + OFF_KR + wid * 1024)), dv_ = (unsigned)__builtin_amdgcn_readfirstlane((int)(lds0 + OFF_V + (2 * wid) * 1024));
#define DMA_K(t, b) do { const bf16_t* Kt_ = Kh + (size_t)(t) * (KVBLK * 1024); const bf16_t* Rt_ = Rh + (size_t)(t) * (KVBLK * 64); \
    glds16(Kt_ + kn_so[0], dk_ + (b) * SHM_KN); glds16(Kt_ + kn_so[1], dk_ + (b) * SHM_KN + 1024); glds16(Rt_ + kr_so, dr_ + (b) * SHM_KR); } while (0)
#define DMA_V(t, b) do { const bf16_t* Vt_ = Vh + (size_t)(t) * (KVBLK * 1024); \
    glds16(Vt_ + v_so[0], dv_ + (b) * SHM_V); glds16(Vt_ + v_so[1], dv_ + (b) * SHM_V + 1024); } while (0)
#define VMW() asm volatile("s_waitcnt vmcnt(0)" ::: "memory")
    f32x16 p0, p1; bf16x8 pa[4] = {};
    { const bf16x8 z = {}; *(bf16x8*)(V_lds + SHM_V + tid * 32) = z; *(bf16x8*)(V_lds + SHM_V + tid * 32 + 16) = z; }
    const lcp kn_l = (lcp)Kn_lds + r32 * 256, kr_l = (lcp)Kr_lds + r32 * 128, ql_l = (lcp)qrl, vp_l = (lcp)V_lds + v_rd_base(lane);
    const unsigned kx = (unsigned)(r32 & 15) << 4, krx = (unsigned)((r32 >> 1) & 7);
    DMA_K(0, 0); VMW();
    ABAR();
    if (half) { DMA_K(1, 1); DMA_V(0, 0); ABAR(); }
    for (int j = 0; j < NT; j += 2) {
        if constexpr (VAR != 4) { if (!half) { DMA_K(j + 1, 1); DMA_V(j, 0); } }
        SBAR(); __builtin_amdgcn_s_setprio(ATT_PRIO_MFMA);
        seg1<true, VAR>(p0, p1, o, qr, pa, kn_l, kr_l, ql_l, vp_l + SHM_V, kx, krx, hi);
        __builtin_amdgcn_s_setprio(ATT_PRIO_VALU); SBAR();
        if (half) VMW();
        ABAR();
        if constexpr (VAR != 4) { if (half) { if (j + 2 < NT) DMA_K(j + 2, 0); DMA_V(j + 1, 1); } }
        softmax_tile<VAR>(p0, p1, m_reg, l_reg, o, al_l, r32, hi, pa);
        if (!half) VMW();
        ABAR();
        if constexpr (VAR != 4) { if (!half) { if (j + 2 < NT) DMA_K(j + 2, 0); DMA_V(j + 1, 1); } }
        SBAR(); __builtin_amdgcn_s_setprio(ATT_PRIO_MFMA);
        seg1<true, VAR>(p0, p1, o, qr, pa, kn_l + SHM_KN, kr_l + SHM_KR, ql_l, vp_l, kx, krx, hi);
        __builtin_amdgcn_s_setprio(ATT_PRIO_VALU); SBAR();
        if (half) VMW();
        ABAR();
        if constexpr (VAR != 4) { if (half) { if (j + 3 < NT) DMA_K(j + 3, 1); if (j + 2 < NT) DMA_V(j + 2, 0); } }
        softmax_tile<VAR>(p0, p1, m_reg, l_reg, o, al_l, r32, hi, pa);
        if (!half) VMW();
        ABAR();
    }
    SBAR(); seg1_pv_only(o, pa, vp_l + SHM_V); SBAR();
    if (!half) ABAR();
    if (hi == 0) li_l[r32] = l_reg; asm volatile("s_waitcnt lgkmcnt(0)" ::: "memory");
    float rli[16];
#pragma unroll
    for (int r = 0; r < 16; ++r) rli[r] = __builtin_amdgcn_rcpf(li_l[crow(r, hi)]);
    bf16_t* Ow = O + (qrow0 + wid * QBLK) * 1024 + h * 128;
#pragma unroll
    for (int r = 0; r < 16; ++r) { const int orow = crow(r, hi);
#pragma unroll
        for (int d0 = 0; d0 < 4; ++d0) Ow[(long)orow * 1024 + d0 * 32 + r32] = (bf16_t)(cvtpk(o[d0][r] * rli[r], 0.f) & 0xffffu); }
    asm volatile("s_waitcnt vmcnt(0)" ::: "memory");
    __syncthreads();
#undef DMA_K
#undef DMA_V
#undef VMW
}
typedef int v8i __attribute__((ext_vector_type(8)));
constexpr int F_SHM_K = 12288, F_SHM_V = 8192, F_OFF_V = 0, F_OFF_K = 2 * F_SHM_V, F_OFF_WS = F_OFF_K + 2 * F_SHM_K, F_LDS_BYTES = F_OFF_WS + NW * 64 * 4;
constexpr int FOPS = 10;
#ifndef ATT_FD
#define ATT_FD 2
#endif
constexpr int FD = ATT_FD, FSL = ATT_FD + 1;
struct Seg1F { v8i fk[FSL]; };
template <int I> __device__ __forceinline__ void seg1f_read(Seg1F& R, lcp k8, lcp vp, unsigned x0, unsigned x1) {
    if constexpr (I < 6) { constexpr int c = I >> 1, wh = I & 1; const lcp b = k8 + c * 4096 + wh * 2048;
        const u32x4 lo = *(const __attribute__((address_space(3))) u32x4*)(b + x0), hh = *(const __attribute__((address_space(3))) u32x4*)(b + x1);
        R.fk[I % FSL] = (v8i){(int)lo.x, (int)lo.y, (int)lo.z, (int)lo.w, (int)hh.x, (int)hh.y, (int)hh.z, (int)hh.w}; }
    else if constexpr (I < FOPS) { constexpr int d0 = I - 6; const lcp b = vp + d0 * 2048;
        const u32x4 lo = *(const __attribute__((address_space(3))) u32x4*)(b + x0), hh = *(const __attribute__((address_space(3))) u32x4*)(b + x1);
        R.fk[I % FSL] = (v8i){(int)lo.x, (int)lo.y, (int)lo.z, (int)lo.w, (int)hh.x, (int)hh.y, (int)hh.z, (int)hh.w}; }
}
template <int I> __device__ __forceinline__ void seg1f_mfma(Seg1F& R, f32x16& p0, f32x16& p1, f32x16* o, const v8i (&q8)[3], const v8i& pa) {
    if constexpr (I == 0) asm volatile("v_mfma_f32_32x32x64_f8f6f4 %0, %1, %2, 0" : "=v"(p0) : "v"(R.fk[I % FSL]), "v"(q8[0]));
    else if constexpr (I == 1) asm volatile("v_mfma_f32_32x32x64_f8f6f4 %0, %1, %2, 0" : "=v"(p1) : "v"(R.fk[I % FSL]), "v"(q8[0]));
    else if constexpr (I < 6) { constexpr int c = I >> 1;
        if constexpr (I & 1) asm volatile("v_mfma_f32_32x32x64_f8f6f4 %0, %1, %2, %0" : "+v"(p1) : "v"(R.fk[I % FSL]), "v"(q8[c]));
        else asm volatile("v_mfma_f32_32x32x64_f8f6f4 %0, %1, %2, %0" : "+v"(p0) : "v"(R.fk[I % FSL]), "v"(q8[c])); }
    else { constexpr int d0 = I - 6; asm volatile("v_mfma_f32_32x32x64_f8f6f4 %0, %1, %2, %0" : "+v"(o[d0]) : "v"(pa), "v"(R.fk[I % FSL])); }
}
template <int I> __device__ __forceinline__ void seg1f_steps(Seg1F& R, f32x16& p0, f32x16& p1, f32x16* o, const v8i (&q8)[3], const v8i& pa, lcp k8, lcp vp, unsigned x0, unsigned x1) {
    if constexpr (I < FOPS) {
        if constexpr (I + FD < FOPS) seg1f_read<I + FD>(R, k8, vp, x0, x1);
        seg1f_mfma<I>(R, p0, p1, o, q8, pa);
        SBAR();
        seg1f_steps<I + 1>(R, p0, p1, o, q8, pa, k8, vp, x0, x1);
    }
}
__device__ __forceinline__ void seg1f(f32x16& p0, f32x16& p1, f32x16* o, const v8i (&q8)[3], const v8i& pa, lcp k8, lcp vp, unsigned x0, unsigned x1) {
    Seg1F R; p0 = f32x16{}; p1 = f32x16{};
    seg1f_read<0>(R, k8, vp, x0, x1); if constexpr (FD > 1) seg1f_read<1>(R, k8, vp, x0, x1); if constexpr (FD > 2) seg1f_read<2>(R, k8, vp, x0, x1); if constexpr (FD > 3) seg1f_read<3>(R, k8, vp, x0, x1); if constexpr (FD > 4) seg1f_read<4>(R, k8, vp, x0, x1); if constexpr (FD > 5) seg1f_read<5>(R, k8, vp, x0, x1);
    SBAR();
    seg1f_steps<0>(R, p0, p1, o, q8, pa, k8, vp, x0, x1);
}
template <int SINV8> __device__ __forceinline__ void softmax_tile_s(f32x16& p0, f32x16& p1, float& m_reg, float& l_reg, f32x16* o, float* al_l, int r32, int hi, v8i& pa) {
    constexpr float C = 1.0f / Q8MUL;
    float pm0 = fmaxf(p0[0], p0[1]), pm1 = fmaxf(p0[2], p0[3]);
#pragma unroll
    for (int r = 4; r < 16; r += 2) { pm0 = fmaxf(pm0, p0[r]); pm1 = fmaxf(pm1, p0[r + 1]); }
#pragma unroll
    for (int r = 0; r < 16; r += 2) { pm0 = fmaxf(pm0, p1[r]); pm1 = fmaxf(pm1, p1[r + 1]); }
    float pmax = fmaxf(pm0, pm1);
    { auto rr = __builtin_amdgcn_permlane32_swap(__float_as_uint(pmax), __float_as_uint(pmax), false, false); pmax = fmaxf(__uint_as_float(rr[0]), __uint_as_float(rr[1])); }
    float mn = m_reg, alpha = 1.f;
    if (!__builtin_expect(__all(pmax - m_reg <= THRL8 * Q8MUL), 1)) { mn = fmaxf(m_reg, pmax); alpha = __builtin_amdgcn_exp2f((m_reg - mn) * C); m_reg = mn; }
    const float mc = -mn * C;
#pragma unroll
    for (int r = 0; r < 16; ++r) { if constexpr (SINV8 == 2) { p0[r] = fmaf(p0[r], C, mc); p1[r] = fmaf(p1[r], C, mc); } else if constexpr (SINV8 == 3) { p0[r] = __builtin_amdgcn_exp2f(p0[r]); p1[r] = __builtin_amdgcn_exp2f(p1[r]); } else { p0[r] = __builtin_amdgcn_exp2f(fmaf(p0[r], C, mc)); p1[r] = __builtin_amdgcn_exp2f(fmaf(p1[r], C, mc)); } }
    float s0 = p0[0] + p1[0], s1 = p0[1] + p1[1], s2 = p0[2] + p1[2], s3 = p0[3] + p1[3];
#pragma unroll
    for (int r = 4; r < 16; r += 4) { s0 += p0[r] + p1[r]; s1 += p0[r + 1] + p1[r + 1]; s2 += p0[r + 2] + p1[r + 2]; s3 += p0[r + 3] + p1[r + 3]; }
    float ps = (s0 + s1) + (s2 + s3);
    { auto rr = __builtin_amdgcn_permlane32_swap(__float_as_uint(ps), __float_as_uint(ps), false, false); ps = __uint_as_float(rr[0]) + __uint_as_float(rr[1]); }
    l_reg = l_reg * alpha + ps;
#pragma unroll
    for (int j = 0; j < 4; ++j) { int a = __builtin_amdgcn_cvt_pk_fp8_f32(p0[4 * j], p0[4 * j + 1], 0, false); a = __builtin_amdgcn_cvt_pk_fp8_f32(p0[4 * j + 2], p0[4 * j + 3], a, true); pa[j] = a;
        int c = __builtin_amdgcn_cvt_pk_fp8_f32(p1[4 * j], p1[4 * j + 1], 0, false); c = __builtin_amdgcn_cvt_pk_fp8_f32(p1[4 * j + 2], p1[4 * j + 3], c, true); pa[4 + j] = c; }
    if (__any(alpha < 1.f)) { if (hi == 0) al_l[r32] = alpha; asm volatile("s_waitcnt lgkmcnt(0)" ::: "memory");
#pragma unroll
        for (int d = 0; d < 4; ++d)
#pragma unroll
            for (int r = 0; r < 16; ++r) o[d][r] *= al_l[crow(r, hi)]; }
}
template <int VARF> __device__ __forceinline__ void attn_unit_f8(const unsigned char* __restrict__ Qn8, const unsigned char* __restrict__ Qr8, const unsigned char* __restrict__ Kn8, const unsigned char* __restrict__ KR8, const unsigned char* __restrict__ VT8,
                                             bf16_t* __restrict__ O, long qrow0, long krow0, int h, int seq, LAS unsigned char* ldsl) {
    char* lds = (char*)ldsl;
    const int tid = threadIdx.x, wid = __builtin_amdgcn_readfirstlane(tid >> 6), lane = tid & 63, r32 = lane & 31, hi = lane >> 5;
    const int half = wid >> 2;
    char* V_lds = lds + F_OFF_V; char* K_lds = lds + F_OFF_K;
    float* ws = (float*)(lds + F_OFF_WS) + wid * 64; float* li_l = ws; float* al_l = ws + 32;
    float m_reg = -1e30f, l_reg = 0; f32x16 o[4] = {}; v8i q8[3];
    { const unsigned char* qn = Qn8 + (qrow0 + wid * QBLK + r32) * 1024 + h * 128 + hi * 32; const unsigned char* qp = Qr8 + (qrow0 + wid * QBLK + r32) * 512 + h * 64 + hi * 32;
#pragma unroll
      for (int c = 0; c < 3; ++c) { const unsigned char* s = c < 2 ? qn + c * 64 : qp; const u32x4 lo = *(const u32x4*)s, hh = *(const u32x4*)(s + 16);
          q8[c] = (v8i){(int)lo.x, (int)lo.y, (int)lo.z, (int)lo.w, (int)hh.x, (int)hh.y, (int)hh.z, (int)hh.w}; }
#pragma unroll
      for (int c = 0; c < 3; ++c) asm volatile("" :: "v"(q8[c]));
    }
    const unsigned char* Kh = Kn8 + krow0 * 1024 + h * 128; const unsigned char* Vh = VT8 + ((size_t)(krow0 >> 13) * 1024 + h * 128) * 8192; const unsigned char* Rh = KR8 + krow0 * 64;
    unsigned kso0, kso1, vso;
    { const int key = 16 * (wid & 3) + (lane >> 2), pc = lane & 3, lc = pc ^ ((key >> 2) & 3); kso0 = (unsigned)(key * 1024 + (wid >> 2) * 64 + lc * 16); kso1 = (unsigned)(key * 64 + lc * 16); }
    { const int d = 16 * wid + (lane >> 2), pc = lane & 3, lc = pc ^ ((d >> 2) & 3); vso = (unsigned)(d * 8192 + lc * 16); }
    const int NT = seq / KVBLK;
    const unsigned lds0 = (unsigned)(uintptr_t)ldsl;
    const unsigned dk_ = (unsigned)__builtin_amdgcn_readfirstlane((int)(lds0 + F_OFF_K + wid * 1024)), dv_ = (unsigned)__builtin_amdgcn_readfirstlane((int)(lds0 + F_OFF_V + wid * 1024));
#define DMA_K(t, b) do { glds16(Kh + (size_t)(t) * (KVBLK * 1024) + kso0, dk_ + (b) * F_SHM_K); if (wid < 4) glds16(Rh + (size_t)(t) * (KVBLK * 64) + kso1, dk_ + (b) * F_SHM_K + 8192); } while (0)
#define DMA_V(t, b) do { glds16(Vh + (size_t)(t) * KVBLK + vso, dv_ + (b) * F_SHM_V); } while (0)
#define VMW() asm volatile("s_waitcnt vmcnt(0)" ::: "memory")
    f32x16 p0, p1; v8i pa = {};
    { const bf16x8 z = {}; *(bf16x8*)(V_lds + F_SHM_V + tid * 16) = z; }
    const lcp k8_l = (lcp)K_lds + r32 * 64, vp_l = (lcp)V_lds + r32 * 64;
    const unsigned sw = (unsigned)((r32 >> 2) & 3), x0 = ((2u * hi) ^ sw) << 4, x1 = ((2u * hi + 1u) ^ sw) << 4;
    DMA_K(0, 0); VMW();
    ABAR();
    if (half) { DMA_K(1, 1); DMA_V(0, 0); ABAR(); }
    for (int j = 0; j < NT; j += 2) {
        if (!half) { DMA_K(j + 1, 1); DMA_V(j, 0); }
        SBAR(); __builtin_amdgcn_s_setprio(ATT_PRIO_MFMA);
        seg1f(p0, p1, o, q8, pa, k8_l, vp_l + F_SHM_V, x0, x1);
        __builtin_amdgcn_s_setprio(ATT_PRIO_VALU); SBAR();
        if (half) VMW();
        ABAR();
        if (half) { if (j + 2 < NT) DMA_K(j + 2, 0); DMA_V(j + 1, 1); }
        softmax_tile_s<VARF>(p0, p1, m_reg, l_reg, o, al_l, r32, hi, pa);
        if (!half) VMW();
        ABAR();
        if (!half) { if (j + 2 < NT) DMA_K(j + 2, 0); DMA_V(j + 1, 1); }
        SBAR(); __builtin_amdgcn_s_setprio(ATT_PRIO_MFMA);
        seg1f(p0, p1, o, q8, pa, k8_l + F_SHM_K, vp_l, x0, x1);
        __builtin_amdgcn_s_setprio(ATT_PRIO_VALU); SBAR();
        if (half) VMW();
        ABAR();
        if (half) { if (j + 3 < NT) DMA_K(j + 3, 1); if (j + 2 < NT) DMA_V(j + 2, 0); }
        softmax_tile_s<VARF>(p0, p1, m_reg, l_reg, o, al_l, r32, hi, pa);
        if (!half) VMW();
        ABAR();
    }
    SBAR();
#pragma unroll
    for (int d0 = 0; d0 < 4; ++d0) { const lcp b = vp_l + F_SHM_V + d0 * 2048; const u32x4 lo = *(const __attribute__((address_space(3))) u32x4*)(b + x0), hh = *(const __attribute__((address_space(3))) u32x4*)(b + x1);
        const v8i vf = (v8i){(int)lo.x, (int)lo.y, (int)lo.z, (int)lo.w, (int)hh.x, (int)hh.y, (int)hh.z, (int)hh.w}; o[d0] = __builtin_amdgcn_mfma_scale_f32_32x32x64_f8f6f4(pa, vf, o[d0], 0, 0, 0, 0, 0, 0); }
    SBAR();
    if (!half) ABAR();
    if (hi == 0) li_l[r32] = l_reg; asm volatile("s_waitcnt lgkmcnt(0)" ::: "memory");
    float rli[16];
#pragma unroll
    for (int r = 0; r < 16; ++r) rli[r] = __builtin_amdgcn_rcpf(li_l[crow(r, hi)]);
    bf16_t* Ow = O + (qrow0 + wid * QBLK) * 1024 + h * 128;
#pragma unroll
    for (int r = 0; r < 16; ++r) { const int orow = crow(r, hi);
#pragma unroll
        for (int d0 = 0; d0 < 4; ++d0) { if (OB_FP8) ((unsigned char*)O)[((qrow0 + wid * QBLK + orow) * 1024 + h * 128) + d0 * 32 + r32] = (unsigned char)(__builtin_amdgcn_cvt_pk_fp8_f32(o[d0][r] * rli[r] * O8MUL, 0.f, 0, false) & 0xff); else Ow[(long)orow * 1024 + d0 * 32 + r32] = (bf16_t)(cvtpk(o[d0][r] * rli[r], 0.f) & 0xffffu); } }
    asm volatile("s_waitcnt vmcnt(0)" ::: "memory");
    __syncthreads();
#undef DMA_K
#undef DMA_V
#undef VMW
}
constexpr int W_SHM_K = 2 * F_SHM_K, W_SHM_V = 2 * F_SHM_V, W_OFF_V = 0, W_OFF_K = 2 * W_SHM_V, W_OFF_WS = W_OFF_K + 2 * W_SHM_K, W_LDS_BYTES = W_OFF_WS + NW * 64 * 4;
constexpr int X_OFF_V = 0, X_OFF_K = 3 * W_SHM_V, X_OFF_WS = X_OFF_K + 3 * W_SHM_K, X_LDS_BYTES = X_OFF_WS + NW * 64 * 4;
constexpr int WOPS = 20;
template <int I> __device__ __forceinline__ void seg1w_read(Seg1F& R, lcp k8, lcp vp, unsigned x0, unsigned x1) {
    if constexpr (I < 12) { constexpr int sub = I / 6, c = (I % 6) >> 1, wh = I & 1; const lcp b = k8 + sub * F_SHM_K + c * 4096 + wh * 2048;
        const u32x4 lo = *(const __attribute__((address_space(3))) u32x4*)(b + x0), hh = *(const __attribute__((address_space(3))) u32x4*)(b + x1);
        R.fk[I % FSL] = (v8i){(int)lo.x, (int)lo.y, (int)lo.z, (int)lo.w, (int)hh.x, (int)hh.y, (int)hh.z, (int)hh.w}; }
    else if constexpr (I < WOPS) { constexpr int sub = (I - 12) >> 2, d0 = (I - 12) & 3; const lcp b = vp + sub * F_SHM_V + d0 * 2048;
        const u32x4 lo = *(const __attribute__((address_space(3))) u32x4*)(b + x0), hh = *(const __attribute__((address_space(3))) u32x4*)(b + x1);
        R.fk[I % FSL] = (v8i){(int)lo.x, (int)lo.y, (int)lo.z, (int)lo.w, (int)hh.x, (int)hh.y, (int)hh.z, (int)hh.w}; }
}
template <int I> __device__ __forceinline__ void seg1w_mfma(Seg1F& R, f32x16 (&s)[4], f32x16* o, const v8i (&q8)[3], const v8i (&pa)[2]) {
    if constexpr (I < 12) { constexpr int sub = I / 6, c = (I % 6) >> 1, wh = I & 1;
        if constexpr (c == 0) asm volatile("v_mfma_f32_32x32x64_f8f6f4 %0, %1, %2, 0" : "=v"(s[2 * sub + wh]) : "v"(R.fk[I % FSL]), "v"(q8[0]));
        else asm volatile("v_mfma_f32_32x32x64_f8f6f4 %0, %1, %2, %0" : "+v"(s[2 * sub + wh]) : "v"(R.fk[I % FSL]), "v"(q8[c])); }
    else { constexpr int sub = (I - 12) >> 2, d0 = (I - 12) & 3; asm volatile("v_mfma_f32_32x32x64_f8f6f4 %0, %1, %2, %0" : "+v"(o[d0]) : "v"(pa[sub]), "v"(R.fk[I % FSL])); }
}
template <int I> __device__ __forceinline__ void seg1w_steps(Seg1F& R, f32x16 (&s)[4], f32x16* o, const v8i (&q8)[3], const v8i (&pa)[2], lcp k8, lcp vp, unsigned x0, unsigned x1, float& pm0, float& pm1) {
    if constexpr (I < WOPS) {
        if constexpr (I + FD < WOPS) seg1w_read<I + FD>(R, k8, vp, x0, x1);
        seg1w_mfma<I>(R, s, o, q8, pa);
        if constexpr (I == 13 || I == 15 || I == 17 || I == 19) { constexpr int v = (I - 13) >> 1;
            if constexpr (v == 0) { pm0 = fmaxf(s[0][0], s[0][1]); pm1 = fmaxf(s[0][2], s[0][3]);
#pragma unroll
                for (int r = 4; r < 16; r += 2) { pm0 = fmaxf(pm0, s[0][r]); pm1 = fmaxf(pm1, s[0][r + 1]); } }
            else {
#pragma unroll
                for (int r = 0; r < 16; r += 2) { pm0 = fmaxf(pm0, s[v][r]); pm1 = fmaxf(pm1, s[v][r + 1]); } } }
        SBAR();
        seg1w_steps<I + 1>(R, s, o, q8, pa, k8, vp, x0, x1, pm0, pm1);
    }
}
__device__ __forceinline__ void seg1w(f32x16 (&s)[4], f32x16* o, const v8i (&q8)[3], const v8i (&pa)[2], lcp k8, lcp vp, unsigned x0, unsigned x1, float& pm0, float& pm1) {
    Seg1F R;
    seg1w_read<0>(R, k8, vp, x0, x1); if constexpr (FD > 1) seg1w_read<1>(R, k8, vp, x0, x1); if constexpr (FD > 2) seg1w_read<2>(R, k8, vp, x0, x1); if constexpr (FD > 3) seg1w_read<3>(R, k8, vp, x0, x1); if constexpr (FD > 4) seg1w_read<4>(R, k8, vp, x0, x1); if constexpr (FD > 5) seg1w_read<5>(R, k8, vp, x0, x1);
    SBAR();
    seg1w_steps<0>(R, s, o, q8, pa, k8, vp, x0, x1, pm0, pm1);
}
typedef short v2s_t __attribute__((ext_vector_type(2)));
__device__ __forceinline__ int cvt4_scale(float a, float b, float c, float d, float scale) {
    v2s_t x = {0, 0}; x = __builtin_amdgcn_cvt_scalef32_pk_fp8_f32(x, a, b, scale, false); x = __builtin_amdgcn_cvt_scalef32_pk_fp8_f32(x, c, d, scale, true);
    return __builtin_bit_cast(int, x); }
__device__ __forceinline__ void softmax_tile_w(f32x16 (&s)[4], float& m_reg, float& l_reg, f32x16* o, float* al_l, int r32, int hi, v8i (&pa)[2], float pm0, float pm1) {
    float pmax = fmaxf(pm0, pm1);
    { auto rr = __builtin_amdgcn_permlane32_swap(__float_as_uint(pmax), __float_as_uint(pmax), false, false); pmax = fmaxf(__uint_as_float(rr[0]), __uint_as_float(rr[1])); }
    float alpha = 1.f;
    if (!__builtin_expect(__all(pmax - m_reg <= THRL8), 1)) { const float mn = fmaxf(m_reg, __builtin_ceilf(pmax)); alpha = __builtin_amdgcn_exp2f(m_reg - mn); m_reg = mn; }
    float M = m_reg;
    if (!__builtin_expect(__all(fabsf(M) <= 90.f), 1)) {
#pragma unroll
        for (int v = 0; v < 4; ++v)
#pragma unroll
            for (int r = 0; r < 16; ++r) s[v][r] -= M;
        M = 0.f; }
    const int Mi = (int)M; const float scale = __uint_as_float((unsigned)(Mi + 127) << 23), iscale = __uint_as_float((unsigned)(127 - Mi) << 23);
#pragma unroll
    for (int v = 0; v < 4; ++v)
#pragma unroll
        for (int r = 0; r < 16; ++r) s[v][r] = __builtin_amdgcn_exp2f(s[v][r]);
    float s0 = 0.f, s1 = 0.f, s2 = 0.f, s3 = 0.f;
#pragma unroll
    for (int v = 0; v < 4; ++v)
#pragma unroll
        for (int r = 0; r < 16; r += 4) { s0 += s[v][r]; s1 += s[v][r + 1]; s2 += s[v][r + 2]; s3 += s[v][r + 3]; }
    float ps = ((s0 + s1) + (s2 + s3)) * iscale;
#pragma unroll
    for (int sub = 0; sub < 2; ++sub)
#pragma unroll
        for (int j = 0; j < 4; ++j) { const f32x16& a = s[2 * sub]; const f32x16& b = s[2 * sub + 1];
            pa[sub][j] = cvt4_scale(a[4 * j], a[4 * j + 1], a[4 * j + 2], a[4 * j + 3], scale); pa[sub][4 + j] = cvt4_scale(b[4 * j], b[4 * j + 1], b[4 * j + 2], b[4 * j + 3], scale); }
    { auto rr = __builtin_amdgcn_permlane32_swap(__float_as_uint(ps), __float_as_uint(ps), false, false); ps = __uint_as_float(rr[0]) + __uint_as_float(rr[1]); }
    l_reg = l_reg * alpha + ps;
    if (__any(alpha < 1.f)) { if (hi == 0) al_l[r32] = alpha; asm volatile("s_nop 15\n\ts_nop 15\n\ts_waitcnt lgkmcnt(0)" ::: "memory");
#pragma unroll
        for (int d = 0; d < 4; ++d)
#pragma unroll
            for (int r = 0; r < 16; ++r) o[d][r] *= al_l[crow(r, hi)]; }
}
__device__ __forceinline__ void attn_unit_f8w(const unsigned char* __restrict__ Qn8, const unsigned char* __restrict__ Qr8, const unsigned char* __restrict__ Kn8, const unsigned char* __restrict__ KR8, const unsigned char* __restrict__ VT8,
                                              bf16_t* __restrict__ O, long qrow0, long krow0, int h, int seq, LAS unsigned char* ldsl) {
    char* lds = (char*)ldsl;
    const int tid = threadIdx.x, wid = __builtin_amdgcn_readfirstlane(tid >> 6), lane = tid & 63, r32 = lane & 31, hi = lane >> 5;
    const int half = wid >> 2;
    char* V_lds = lds + X_OFF_V; char* K_lds = lds + X_OFF_K;
    float* ws = (float*)(lds + X_OFF_WS) + wid * 64; float* li_l = ws; float* al_l = ws + 32;
    float m_reg = -1e30f, l_reg = 0; f32x16 o[4] = {}; v8i q8[3];
    { const unsigned char* qn = Qn8 + (qrow0 + wid * QBLK + r32) * 1024 + h * 128 + hi * 32; const unsigned char* qp = Qr8 + (qrow0 + wid * QBLK + r32) * 512 + h * 64 + hi * 32;
#pragma unroll
      for (int c = 0; c < 3; ++c) { const unsigned char* s = c < 2 ? qn + c * 64 : qp; const u32x4 lo = *(const u32x4*)s, hh = *(const u32x4*)(s + 16);
          q8[c] = (v8i){(int)lo.x, (int)lo.y, (int)lo.z, (int)lo.w, (int)hh.x, (int)hh.y, (int)hh.z, (int)hh.w}; }
#pragma unroll
      for (int c = 0; c < 3; ++c) asm volatile("" :: "v"(q8[c]));
    }
    const unsigned char* Kh = Kn8 + krow0 * 1024 + h * 128; const unsigned char* Vh = VT8 + ((size_t)(krow0 >> 13) * 1024 + h * 128) * 8192; const unsigned char* Rh = KR8 + krow0 * 64;
    unsigned kso0, kso1, vso;
    { const int key = 16 * (wid & 3) + (lane >> 2), pc = lane & 3, lc = pc ^ ((key >> 2) & 3); kso0 = (unsigned)(key * 1024 + (wid >> 2) * 64 + lc * 16); kso1 = (unsigned)(key * 64 + lc * 16); }
    { const int d = 16 * wid + (lane >> 2), pc = lane & 3, lc = pc ^ ((d >> 2) & 3); vso = (unsigned)(d * 8192 + lc * 16); }
    const int NT = seq / (2 * KVBLK);
    const unsigned lds0 = (unsigned)(uintptr_t)ldsl;
    const unsigned dr_ = (unsigned)__builtin_amdgcn_readfirstlane((int)(lds0 + X_OFF_K + 8192 + (wid & 3) * 1024));
    const unsigned dk_ = (unsigned)__builtin_amdgcn_readfirstlane((int)(lds0 + X_OFF_K + wid * 1024)), dv_ = (unsigned)__builtin_amdgcn_readfirstlane((int)(lds0 + X_OFF_V + wid * 1024));
#define DMA_K(t, sl) do { _Pragma("unroll") for (int sb_ = 0; sb_ < 2; ++sb_) { glds16s((const char*)Kh + (size_t)(2 * (t) + sb_) * (KVBLK * 1024), kso0, dk_ + (sl) * W_SHM_K + sb_ * F_SHM_K); if ((wid >> 2) == sb_) glds16s((const char*)Rh + (size_t)(2 * (t) + sb_) * (KVBLK * 64), kso1, dr_ + (sl) * W_SHM_K + sb_ * F_SHM_K); } } while (0)
#define DMA_V(t, sl) do { _Pragma("unroll") for (int sb_ = 0; sb_ < 2; ++sb_) glds16s((const char*)Vh + (size_t)(2 * (t) + sb_) * KVBLK, vso, dv_ + (sl) * W_SHM_V + sb_ * F_SHM_V); } while (0)
    f32x16 s[4]; v8i pa[2] = {};
    { const bf16x8 z = {}; *(bf16x8*)(V_lds + 2 * W_SHM_V + tid * 32) = z; *(bf16x8*)(V_lds + 2 * W_SHM_V + tid * 32 + 16) = z; }
    const lcp k8_l = (lcp)K_lds + r32 * 64, vp_l = (lcp)V_lds + r32 * 64;
    const unsigned sw = (unsigned)((r32 >> 2) & 3), x0 = ((2u * hi) ^ sw) << 4, x1 = ((2u * hi + 1u) ^ sw) << 4;
    DMA_K(0, 0); DMA_K(1, 1); DMA_V(0, 0);
    asm volatile("s_waitcnt vmcnt(0)" ::: "memory");
    ABAR();
    if (half) ABAR();
    const int nkp = 3;
    int ks = 0, vs = 2;
    if (!half) __builtin_amdgcn_s_setprio(1);
    for (int j = 0; j < NT; ++j) {
        SBAR();
        float pm0, pm1;
        seg1w(s, o, q8, pa, k8_l + ks * W_SHM_K, vp_l + vs * W_SHM_V, x0, x1, pm0, pm1);
        SBAR();
        if (half) asm volatile("s_waitcnt vmcnt(0)" ::: "memory");
        ABAR();
        { int k2 = ks + 2; k2 = k2 >= 3 ? k2 - 3 : k2; int v2 = vs + 2; v2 = v2 >= 3 ? v2 - 3 : v2;
          const bool ik = j + 2 < NT, iv = j + 1 < NT;
          if (ik) DMA_K(j + 2, k2); if (iv) DMA_V(j + 1, v2);
          softmax_tile_w(s, m_reg, l_reg, o, al_l, r32, hi, pa, pm0, pm1);
          if (!half) { const int n = (ik ? nkp : 0) + (iv ? 2 : 0);
              if (n == 5) asm volatile("s_waitcnt vmcnt(5)" ::: "memory"); else if (n == 3) asm volatile("s_waitcnt vmcnt(3)" ::: "memory"); else if (n == 2) asm volatile("s_waitcnt vmcnt(2)" ::: "memory"); else asm volatile("s_waitcnt vmcnt(0)" ::: "memory"); } }
        ABAR();
        ks = ks + 1 >= 3 ? 0 : ks + 1; vs = vs + 1 >= 3 ? 0 : vs + 1;
    }
    __builtin_amdgcn_s_setprio(0);
    SBAR();
#pragma unroll
    for (int sub = 0; sub < 2; ++sub)
#pragma unroll
        for (int d0 = 0; d0 < 4; ++d0) { const lcp b = vp_l + vs * W_SHM_V + sub * F_SHM_V + d0 * 2048; const u32x4 lo = *(const __attribute__((address_space(3))) u32x4*)(b + x0), hh = *(const __attribute__((address_space(3))) u32x4*)(b + x1);
            const v8i vf = (v8i){(int)lo.x, (int)lo.y, (int)lo.z, (int)lo.w, (int)hh.x, (int)hh.y, (int)hh.z, (int)hh.w}; o[d0] = __builtin_amdgcn_mfma_scale_f32_32x32x64_f8f6f4(pa[sub], vf, o[d0], 0, 0, 0, 0, 0, 0); }
    SBAR();
    if (!half) ABAR();
    if (hi == 0) li_l[r32] = l_reg; asm volatile("s_waitcnt lgkmcnt(0)" ::: "memory");
    float rli[16];
#pragma unroll
    for (int r = 0; r < 16; ++r) rli[r] = __builtin_amdgcn_rcpf(li_l[crow(r, hi)]);
    bf16_t* Ow = O + (qrow0 + wid * QBLK) * 1024 + h * 128;
#pragma unroll
    for (int r = 0; r < 16; ++r) { const int orow = crow(r, hi);
#pragma unroll
        for (int d0 = 0; d0 < 4; ++d0) { if (OB_FP8) ((unsigned char*)O)[((qrow0 + wid * QBLK + orow) * 1024 + h * 128) + d0 * 32 + r32] = (unsigned char)(__builtin_amdgcn_cvt_pk_fp8_f32(o[d0][r] * rli[r] * O8MUL, 0.f, 0, false) & 0xff); else Ow[(long)orow * 1024 + d0 * 32 + r32] = (bf16_t)(cvtpk(o[d0][r] * rli[r], 0.f) & 0xffffu); } }
    asm volatile("s_waitcnt vmcnt(0)" ::: "memory");
    __syncthreads();
#undef DMA_K
#undef DMA_V
}
#undef ABAR
#undef SBAR
}

constexpr size_t MiB = 1u << 20;
constexpr size_t WS_CTL = 0, CTL_ZERO_BYTES = 1 * MiB;
constexpr size_t WS_WIN = 1 * MiB;
constexpr size_t WS_WA = 11 * MiB, WS_WB = 13 * MiB, WS_WO = 15 * MiB;
constexpr size_t WS_WUQ = 17 * MiB;
constexpr size_t WS_WUKV = 19 * MiB;
constexpr size_t WS_WR = 20 * MiB;
constexpr size_t WS_WS = 21 * MiB;
constexpr size_t WS_COS = 22 * MiB, WS_SIN = 24 * MiB;
constexpr size_t WS_RS = 26 * MiB;
constexpr size_t WS_TOPW = 28 * MiB;
constexpr size_t WS_LIST = 29 * MiB;
constexpr size_t WS_WGU = 45 * MiB;
constexpr size_t WS_WD = 302 * MiB;
constexpr size_t WS_PRE = 431 * MiB;
constexpr size_t WS_H1B = 495 * MiB;
constexpr size_t WS_LOG = 527 * MiB;
constexpr size_t WS_RB = 543 * MiB;
constexpr size_t WS_YA = WS_RB, WS_O = WS_RB + 32 * MiB, WS_M = WS_RB + 64 * MiB, WS_ACT = WS_RB;
constexpr size_t WS_RA = 647 * MiB;
constexpr size_t WS_XB = WS_RA, WS_U = WS_RA + 32 * MiB, WS_VG = WS_RA + 64 * MiB, WS_GA = WS_RA + 96 * MiB, WS_GB = WS_RA + 128 * MiB;
constexpr size_t WS_C3 = WS_RA + 160 * MiB, WS_KR = WS_RA + 184 * MiB, WS_QN = WS_RA + 186 * MiB, WS_QR = WS_RA + 218 * MiB;
constexpr size_t WS_KN = WS_RA + 234 * MiB, WS_VV = WS_RA + 266 * MiB, WS_SG = WS_RA + 298 * MiB;
constexpr size_t WS_YP = WS_RA, WS_YS = WS_RA + 256 * MiB;
constexpr size_t WS_END = WS_RA + 330 * MiB;
static_assert(WS_END <= 1024 * MiB, "d_ws map");
constexpr int CW_CNT = 65536, CNT_STRIDE = 64;
constexpr int CW_BAR = 4096;

constexpr int RING_BYTES = 131072;
constexpr int LDSCTL_OFF = RING_BYTES, MISC_OFF = LDSCTL_OFF + 320;
constexpr int TAB_OFF = RING_BYTES + 512;
constexpr int LDS_BYTES = 147456;

typedef GAS unsigned gu32;
#define RLX_AGENT __ATOMIC_RELAXED, __HIP_MEMORY_SCOPE_AGENT

#define XB_TMO      128
#define XB_XCNT(j)  (256  + 64 * (j))
#define XB_XSUB(j)  (1280 + 64 * (j))
#define XB_XGEN(j)  (2304 + 64 * (j))
#define XB_TOP      3328
#define XB_TOPGEN   3392
#define XCD_BAR_WORDS 3456
#define XB_SPIN_CAP (1u << 22)
__device__ __forceinline__ unsigned xb_ld(unsigned* p)              { return __hip_atomic_load(p, __ATOMIC_RELAXED, __HIP_MEMORY_SCOPE_AGENT); }
__device__ __forceinline__ unsigned xb_add(unsigned* p, unsigned v) { return __hip_atomic_fetch_add(p, v, __ATOMIC_RELAXED, __HIP_MEMORY_SCOPE_AGENT); }
__device__ __forceinline__ unsigned xb_xcc_id() { return (unsigned)__builtin_amdgcn_s_getreg((3 << 11) | 20) & 0xFu; }
#define XB_SPIN(cond, bar) do { unsigned _sp = 0; while (cond) { __builtin_amdgcn_s_sleep(1); \
    if ((++_sp & 255u) == 0u) { if (xb_ld(&(bar)[XB_TMO])) break; if (_sp > XB_SPIN_CAP) { atomicAdd(&(bar)[XB_TMO], 1u); break; } } } } while (0)
struct XcdBarrier { unsigned* bar; unsigned x; volatile LAS unsigned* st; };
__device__ __forceinline__ XcdBarrier xcd_barrier_post(unsigned* bar, volatile LAS unsigned* st) {
    XcdBarrier b; b.bar = bar; b.x = xb_xcc_id(); b.st = st;
    if (threadIdx.x == 0) (void)xb_add(&bar[XB_XCNT(b.x)], 1u);
    return b;
}
__device__ __forceinline__ void xcd_barrier_complete(unsigned* bar, unsigned x, unsigned& nloc, unsigned& nx) {
    const unsigned G = gridDim.x * gridDim.y * gridDim.z;
    unsigned sum, cnt, mine, sp = 0u;
    for (;;) {
        sum = 0u; cnt = 0u; mine = 0u;
#pragma unroll
        for (unsigned j = 0; j < 16; ++j) { const unsigned c = xb_ld(&bar[XB_XCNT(j)]); sum += c; cnt += (c > 0u) ? 1u : 0u; mine = (j == x) ? c : mine; }
        if (sum == G) break;
        __builtin_amdgcn_s_sleep(1);
        if ((++sp & 255u) == 0u) { if (xb_ld(&bar[XB_TMO])) break; if (sp > XB_SPIN_CAP) { atomicAdd(&bar[XB_TMO], 1u); break; } }
    }
    nloc = mine > 0u ? mine : 1u; nx = cnt > 0u ? cnt : 1u;
}
__device__ __forceinline__ void xcd_barrier(const XcdBarrier& b) {
    asm volatile("s_waitcnt vmcnt(0)" ::: "memory");
    __syncthreads();
    if (threadIdx.x == 0) {
        unsigned* bar = b.bar;
        __builtin_amdgcn_s_waitcnt(0);
        unsigned nloc = b.st[0], nx = b.st[1];
        if (nloc == 0u) { xcd_barrier_complete(bar, b.x, nloc, nx); b.st[0] = nloc; b.st[1] = nx; }
        const unsigned old = xb_add(&bar[XB_XSUB(b.x)], 1u);
        const unsigned gen = old / nloc;
        if (old + 1u == (gen + 1u) * nloc) {
            __builtin_amdgcn_fence(__ATOMIC_RELEASE, "agent");
            asm volatile("s_waitcnt vmcnt(0)" ::: "memory");
            const unsigned og = xb_add(&bar[XB_TOP], 1u);
            const unsigned tg = og / nx;
            if (og + 1u == (tg + 1u) * nx) xb_add(&bar[XB_TOPGEN], 1u);
            else XB_SPIN(xb_ld(&bar[XB_TOPGEN]) == tg, bar);
            __builtin_amdgcn_fence(__ATOMIC_ACQUIRE, "agent");
            xb_add(&bar[XB_XGEN(b.x)], 1u);
            asm volatile("s_waitcnt vmcnt(0)" ::: "memory");
        } else {
            XB_SPIN(xb_ld(&bar[XB_XGEN(b.x)]) == gen, bar);
            __builtin_amdgcn_fence(__ATOMIC_ACQUIRE, "agent");
            asm volatile("s_waitcnt vmcnt(0)" ::: "memory");
        }
    }
    __syncthreads();
}

__device__ __forceinline__ float wave_sum(float v) {
#pragma unroll
    for (int o = 1; o < 64; o <<= 1) v += __shfl_xor(v, o);
    return v;
}
__device__ __forceinline__ float half_max(float v) {
#pragma unroll
    for (int o = 1; o < 32; o <<= 1) v = fmaxf(v, __shfl_xor(v, o));
    return v;
}
__device__ __forceinline__ int half_min_i(int v) {
#pragma unroll
    for (int o = 1; o < 32; o <<= 1) { const int w = __shfl_xor(v, o); v = w < v ? w : v; }
    return v;
}
__device__ __forceinline__ void tr_item(const float* W, size_t ldw, int k0, int sc, bf16_t* D, size_t ldd, int n0, const float* kscale, LAS float* scr, int lane) {
    { const float* wp = W + (size_t)(k0 + (lane >> 5)) * ldw + (sc >= 0 ? sc : 0); float v[32];
#pragma unroll
      for (int i = 0; i < 32; ++i) v[i] = wp[(size_t)(2 * i) * ldw];
#pragma unroll
      for (int i = 0; i < 32; ++i) { const int kk = 2 * i + (lane >> 5); float t = sc >= 0 ? v[i] : 0.f; if (kscale) t *= kscale[k0 + kk]; scr[kk * 33 + (lane & 31)] = t; } }
    asm volatile("s_waitcnt lgkmcnt(0)" ::: "memory");
    const int c = lane & 7;
#pragma unroll
    for (int j = 0; j < 4; ++j) { const int n = (lane >> 3) + 8 * j; const LAS float* s = scr + (8 * c) * 33 + n;
        u32x4 o; o.x = cvt_pk_bf16(s[0 * 33], s[1 * 33]); o.y = cvt_pk_bf16(s[2 * 33], s[3 * 33]); o.z = cvt_pk_bf16(s[4 * 33], s[5 * 33]); o.w = cvt_pk_bf16(s[6 * 33], s[7 * 33]);
        *(u32x4*)(D + (size_t)(n0 + n) * ldd + k0 + 8 * c) = o; }
    asm volatile("s_waitcnt lgkmcnt(0)" ::: "memory");
}
__device__ __forceinline__ void tr_item8(const float* W, size_t ldw, int k0, int sc, unsigned char* D, size_t ldd, int n0, float mul, LAS float* scr, int lane) {
    { const float* wp = W + (size_t)(k0 + (lane >> 5)) * ldw + sc; float v[32];
#pragma unroll
      for (int i = 0; i < 32; ++i) v[i] = wp[(size_t)(2 * i) * ldw];
#pragma unroll
      for (int i = 0; i < 32; ++i) { const int kk = 2 * i + (lane >> 5); scr[kk * 33 + (lane & 31)] = v[i] * mul; } }
    asm volatile("s_waitcnt lgkmcnt(0)" ::: "memory");
    const int c = lane & 7;
#pragma unroll
    for (int j = 0; j < 4; ++j) { const int n = (lane >> 3) + 8 * j; const LAS float* s = scr + (8 * c) * 33 + n;
        int a = __builtin_amdgcn_cvt_pk_fp8_f32(s[0 * 33], s[1 * 33], 0, false); a = __builtin_amdgcn_cvt_pk_fp8_f32(s[2 * 33], s[3 * 33], a, true);
        int b = __builtin_amdgcn_cvt_pk_fp8_f32(s[4 * 33], s[5 * 33], 0, false); b = __builtin_amdgcn_cvt_pk_fp8_f32(s[6 * 33], s[7 * 33], b, true);
        u32x2 o; o.x = (unsigned)a; o.y = (unsigned)b; *(u32x2*)(D + (size_t)(n0 + n) * ldd + k0 + 8 * c) = o; }
    asm volatile("s_waitcnt lgkmcnt(0)" ::: "memory");
}
__device__ __forceinline__ void tr_item8w(const float* W, size_t ldw, int k0, int sc4, unsigned char* D, size_t ldd, int n0, float mul, LAS float* scr, int lane) {
    { const float* wp = W + (size_t)(k0 + (lane >> 3)) * ldw + sc4; f32x4 v[16];
#pragma unroll
      for (int i = 0; i < 16; ++i) v[i] = __builtin_nontemporal_load((const f32x4*)(wp + (size_t)(8 * i) * ldw));
#pragma unroll
      for (int i = 0; i < 16; ++i) { const int kk = 8 * i + (lane >> 3); *(LAS f32x4*)(scr + kk * 32 + ((4 * (lane & 7)) ^ ((kk >> 4) << 2))) = v[i] * mul; } }
    asm volatile("s_waitcnt lgkmcnt(0)" ::: "memory");
    const int c = lane & 7;
#pragma unroll
    for (int j = 0; j < 4; ++j) { const int n = (lane >> 3) + 8 * j; const LAS float* s = scr + (16 * c) * 32 + (n ^ (c << 2));
        u32x4 o;
#pragma unroll
        for (int q = 0; q < 4; ++q) { int a = __builtin_amdgcn_cvt_pk_fp8_f32(s[(4 * q) * 32], s[(4 * q + 1) * 32], 0, false); a = __builtin_amdgcn_cvt_pk_fp8_f32(s[(4 * q + 2) * 32], s[(4 * q + 3) * 32], a, true); o[q] = (unsigned)a; }
        __builtin_nontemporal_store(o, (u32x4*)(D + (size_t)(n0 + n) * ldd + k0 + 16 * c)); }
    asm volatile("s_waitcnt lgkmcnt(0)" ::: "memory");
}
__device__ __forceinline__ int map_in(int n) { if (n < 2688) return n; if (n < 2752) return 2688 + rope_orig(n - 2688); if (n < 2816) return -1; return n - 64; }
__device__ __forceinline__ int map_in2(int n) { if (n < 2048) return n; if (n < 3072) return 2752 + (n - 2048); const int m = n - 3072; if (m < 768) return map_in(2048 + m); return 3776 + (m - 768); }
__device__ __forceinline__ int map_q(int n) { if (n < 1024) return (n >> 7) * 192 + (n & 127); const int q = n - 1024; return (q >> 6) * 192 + 128 + rope_orig(q & 63); }

struct Args { const void* in[27]; float* out; unsigned char* ws; int ph_lo, ph_hi, li, pad; };
constexpr int PER_PHASE = 12;
constexpr int N_LAUNCHES = MK_N_LAUNCHES;

#define WinT ((bf16_t*)(ws + WS_WIN))
#define WaT ((bf16_t*)(ws + WS_WA))
#define WbT ((bf16_t*)(ws + WS_WB))
#define WoT ((bf16_t*)(ws + WS_WO))
#define WuqT ((bf16_t*)(ws + WS_WUQ))
#define WukvT ((bf16_t*)(ws + WS_WUKV))
#define WrT ((bf16_t*)(ws + WS_WR))
#define WsB ((bf16_t*)(ws + WS_WS))
#define COS ((float*)(ws + WS_COS))
#define SIN ((float*)(ws + WS_SIN))
#define RS ((float*)(ws + WS_RS))
#define TOPW ((float*)(ws + WS_TOPW))
#define LIST ((int*)(ws + WS_LIST))
#define WguT ((bf16_t*)(ws + WS_WGU))
#define WdT ((bf16_t*)(ws + WS_WD))
#define PRE ((float*)(ws + WS_PRE))
#define H1b ((bf16_t*)(ws + WS_H1B))
#define LOG ((float*)(ws + WS_LOG))
#define YA ((bf16_t*)(ws + WS_YA))
#define Ob ((bf16_t*)(ws + WS_O))
#define Mb ((bf16_t*)(ws + WS_M))
#define ACT ((bf16_t*)(ws + WS_ACT))
#define Xb ((bf16_t*)(ws + WS_XB))
#define U ((bf16_t*)(ws + WS_U))
#define Vg ((bf16_t*)(ws + WS_VG))
#define GA ((bf16_t*)(ws + WS_GA))
#define GB ((bf16_t*)(ws + WS_GB))
#define C3 ((bf16_t*)(ws + WS_C3))
#define KR ((bf16_t*)(ws + WS_KR))
#define Qn ((bf16_t*)(ws + WS_QN))
#define Qr ((bf16_t*)(ws + WS_QR))
#define Kn ((bf16_t*)(ws + WS_KN))
#define Vv ((bf16_t*)(ws + WS_VV))
#define Sg ((bf16_t*)(ws + WS_SG))
#define YP ((bf16_t*)(ws + WS_YP))
#define YS ((bf16_t*)(ws + WS_YS))
#define CNT ((int*)(ws + WS_CTL))
#define CNT ((int*)(ws + WS_CTL) + CW_CNT)
__global__ void __launch_bounds__(NWAVES * 64, 2) mega_fwd(Args args) {
    extern __shared__ __attribute__((aligned(16))) unsigned char lds[];
    LAS unsigned char* ldsa = (LAS unsigned char*)lds;
    volatile LAS unsigned* MISC = (volatile LAS unsigned*)(ldsa + MISC_OFF);
    const int tid = threadIdx.x, lane = tid & 63, wave = __builtin_amdgcn_readfirstlane(tid >> 6);
    const int G = gridDim.x; const int bx = blockIdx.x; const int vcu = (G % 8 == 0) ? (bx % 8) * (G / 8) + bx / 8 : bx;
    const int gw = vcu * NWAVES + wave, NGW = G * NWAVES;
    unsigned char* ws = args.ws;
    gu32* ctl = (gu32*)(ws + WS_CTL);
    const __attribute__((address_space(4))) char* const kp0 = (const __attribute__((address_space(4))) char*)__builtin_amdgcn_kernarg_segment_ptr();
#define KARG(TYPE, NAME, i) const __attribute__((address_space(4))) char* kp_##NAME = kp0; asm volatile("" : "+s"(kp_##NAME)); TYPE NAME = (TYPE)(*(void* const __attribute__((address_space(4)))*)(kp_##NAME + 8 * (i)))
    for (int u = tid; u < (LDS_BYTES - LDSCTL_OFF) / 4; u += NWAVES * 64) ((LAS unsigned*)(ldsa + LDSCTL_OFF))[u] = 0u;
    __syncthreads();
    XcdBarrier bar; bar.bar = (unsigned*)(ctl + CW_BAR); bar.x = 0; bar.st = nullptr;
    if (N_LAUNCHES != PER_PHASE) bar = xcd_barrier_post((unsigned*)(ctl + CW_BAR), MISC + 8);
#define GRID_BAR() do { if (N_LAUNCHES != PER_PHASE) xcd_barrier(bar); } while (0)
    const int lo = args.ph_lo, hi = args.ph_hi;
#ifndef PH_MASK
#define PH_MASK 0xFFF
#endif
#ifndef REP_MASK
#define REP_MASK 0
#endif
#define IN(k) (((PH_MASK >> (k)) & 1) && lo <= (k) && (k) < hi)
#define REPF(k) ((((REP_MASK) >> (k)) & 1) ? 2 : 1)
#define REPS(k) for (int rep_ = 0; rep_ < (((REP_MASK >> (k)) & 1) ? 2 : 1); ++rep_)
#define BOTH(k) (IN(k) && IN((k) + 1))

    if (IN(0)) REPS(0) {
        KARG(const float*, x, 0); KARG(const int*, positions, 1); KARG(const float*, w_in, 2); KARG(const float*, w_spatial, 5); KARG(const float*, w_a_proj, 7); KARG(const float*, q_norm_g, 8); KARG(const float*, w_uq, 9); KARG(const float*, kv_norm_g, 10);
        KARG(const float*, w_uk, 11); KARG(const float*, w_uv, 12); KARG(const float*, w_b_proj, 13); KARG(const float*, w_out, 14); KARG(const float*, w_router, 17); KARG(const float*, w_gate, 19); KARG(const float*, w_up, 20); KARG(const float*, w_down, 21);
        KARG(const float*, w_sh_gate, 22); KARG(const float*, w_sh_up, 23); KARG(const float*, w_sh_down, 24);
        LAS float* scr = (LAS float*)(ldsa + wave * 16384);
        constexpr int I_IN = 16 * (IN_PAD / 32), I_SQ = 16 * 32, I_UQ = 6 * 48, I_UKV = 4 * 32, I_R = 16 * 8, I_GU1 = MOE_FP8 ? 16 * 8 : 16 * 16, I_D1 = MOE_FP8 ? 2 * 32 : 4 * 32;
        constexpr int I_GU = NE * I_GU1, I_D = NE * I_D1;
        constexpr int NITEMS = I_IN + 3 * I_SQ + I_UQ + 2 * I_UKV + I_R + I_GU + I_D + I_GU1 + I_D1;
        for (int it = gw; it < NITEMS; it += NGW) {
            int r = it; const int l31 = lane & 31;
            if (r < I_IN) { const int nb = r % (IN_PAD / 32), kb = r / (IN_PAD / 32);
                if (!INP_FP8) tr_item(w_in, IN_TOTAL, 64 * kb, map_in(32 * nb + l31), WinT, 1024, 32 * nb, nullptr, scr, lane);
                else if (32 * nb < 3072) tr_item(w_in, IN_TOTAL, 64 * kb, map_in2(32 * nb + l31), WinT, 1024, 32 * nb, nullptr, scr, lane);
                else { const int sc_ = map_in2(32 * nb + l31); const bool zr_ = sc_ < 0; tr_item8(w_in, IN_TOTAL, 64 * kb, zr_ ? 0 : sc_, (unsigned char*)WinT + (size_t)3072 * 2048, 1024, 32 * nb - 3072, zr_ ? 0.f : W8MUL, scr, lane); }
                continue; } r -= I_IN;
            if (r < 3 * I_SQ) { const int which = r / I_SQ; r -= which * I_SQ; const int nb = r % 32, kb = r / 32; const float* W = which == 0 ? w_a_proj : which == 1 ? w_b_proj : w_out; bf16_t* Dd = which == 0 ? WaT : which == 1 ? WbT : WoT;
                if (OB_FP8 && which == 1) tr_item8(W, 1024, 64 * kb, 32 * nb + l31, (unsigned char*)Dd, 1024, 32 * nb, W8MUL, scr, lane); else tr_item(W, 1024, 64 * kb, 32 * nb + l31, Dd, 1024, 32 * nb, nullptr, scr, lane); continue; } r -= 3 * I_SQ;
            if (r < I_UQ) { const int nb = r % 48, kb = r / 48; tr_item(w_uq, 1536, 64 * kb, map_q(32 * nb + l31), WuqT, QLORA, 32 * nb, q_norm_g, scr, lane); continue; } r -= I_UQ;
            if (r < 2 * I_UKV) { const int which = r / I_UKV; r -= which * I_UKV; const int nb = r % 32, kb = r / 32; tr_item(which ? w_uv : w_uk, 1024, 64 * kb, 32 * nb + l31, WukvT + (size_t)which * 1024 * KVLORA, KVLORA, 32 * nb, kv_norm_g, scr, lane); continue; } r -= 2 * I_UKV;
            if (r < I_R) { const int nb = r % 8, kb = r / 8; tr_item(w_router, 256, 64 * kb, 32 * nb + l31, WrT, 1024, 32 * nb, nullptr, scr, lane); continue; } r -= I_R;
            if (r < I_GU + I_GU1) { const int e = r / I_GU1; r -= e * I_GU1; const int nb = r % 16, kb = r / 16; const int n = 32 * nb + l31; const int bj = (n >> 7) & 1, pn = n >> 8, j = n & 127;
                const float* W = e < NE ? ((bj ? w_up : w_gate) + (size_t)e * DM * DE) : (bj ? w_sh_up : w_sh_gate);
                if (MOE_FP8) tr_item8w(W, DE, 128 * kb, 128 * pn + ((32 * nb) & 127) + 4 * (lane & 7), (unsigned char*)WguT + (size_t)e * 512 * DM, DM, 32 * nb, W8MUL, scr, lane); else tr_item(W, DE, 64 * kb, 128 * pn + j, WguT + (size_t)e * 512 * DM, DM, 32 * nb, nullptr, scr, lane); continue; } r -= I_GU + I_GU1;
            { const int e = r / I_D1; r -= e * I_D1; const int nb = r % 32, kb = r / 32; const float* W = e < NE ? (w_down + (size_t)e * DE * DM) : w_sh_down;
                if (MOE_FP8) tr_item8w(W, DM, 128 * kb, 32 * nb + 4 * (lane & 7), (unsigned char*)WdT + (size_t)e * DM * DE, DE, 32 * nb, W8MUL, scr, lane); else tr_item(W, DM, 64 * kb, 32 * nb + l31, WdT + (size_t)e * DM * DE, DE, 32 * nb, nullptr, scr, lane); }
        }
        for (size_t i = (size_t)bx * 512 + tid; i < (size_t)T * DM / 8; i += (size_t)G * 512) { const f32x4 a = __builtin_nontemporal_load((const f32x4*)(x + i * 8)), b = __builtin_nontemporal_load((const f32x4*)(x + i * 8 + 4)); *(u32x4*)(Xb + i * 8) = pg8::pack8(a, b);
            if (INP_FP8) *(u32x2*)((unsigned char*)LOG + i * 8) = pack8_fp8(a, b); }
        for (int i = bx * 512 + tid; i < 8 * 128 * 128 / 8; i += G * 512) { const f32x4 a = *(const f32x4*)(w_spatial + (size_t)i * 8), b = *(const f32x4*)(w_spatial + (size_t)i * 8 + 4); *(u32x4*)(WsB + (size_t)i * 8) = pg8::pack8(a, b); }
        for (int i = bx * 512 + tid; i < T * 32; i += G * 512) { const int t = i >> 5, j = i & 31; const float freq = powf(10000.0f, -(float)j * (1.0f / 32.0f)); const float ang = (float)positions[t] * freq;
            float sv_, cv_; sincosf(ang, &sv_, &cv_); COS[i] = cv_; SIN[i] = sv_; }
        if (BOTH(0)) GRID_BAR();
    }

    if (IN(1)) {
        if (!INP_FP8) { pg8::DenseSched S; S.init(Xb, DM, WinT, DM, T, IN_PAD, G, bx, REPF(1));
          pg8::EpiInProj E{U, Vg, C3, KR, GA, GB, RS, COS, SIN, 0, 1.0f};
          pg8::gemm_phase<pg8::EpiInProj, pg8::DenseSched, true>(ldsa, DM, DM, DM, S, E); }
        else {
          { pg8::DenseSched S; S.init(Xb, DM, WinT, DM, T, 3072, G, bx, REPF(1));
            pg8::EpiInProj E{U, Vg, C3, KR, GA, GB, RS, COS, SIN, 1, 1.0f};
            pg8::gemm_phase<pg8::EpiInProj, pg8::DenseSched, true>(ldsa, DM, DM, DM, S, E); }
          { pg8::DenseSched S; S.init(LOG, DM / 2, (const unsigned char*)WinT + (size_t)3072 * 2048, DM / 2, T, 1792, G, bx, REPF(1));
            pg8::EpiInProj E{U, Vg, C3, KR, GA, GB, RS, COS, SIN, 2, 1.0f / W8MUL};
            pg8::gemm_phase<pg8::EpiInProj, pg8::DenseSched, true, true>(ldsa, DM / 2, DM / 2, DM / 2, S, E); } }
        if (BOTH(1)) GRID_BAR();
    }

    if (IN(2)) {
        KARG(const float*, gmlp_ln_g, 3); KARG(const float*, gmlp_ln_b, 4); KARG(const float*, b_spatial, 6);
#ifndef NO_P2A
        { pg8::DenseSched S; S.init(C3, 768, WuqT, QLORA, T, 1536, G, bx, REPF(2)); pg8::EpiQ E{Qn, Qr, RS, COS, SIN};
          pg8::gemm_phase<pg8::EpiQ, pg8::DenseSched, true>(ldsa, QLORA, 768, QLORA, S, E); }
#endif
#ifndef NO_P2B
        { pg8::DenseSched S; S.init(C3 + QLORA, 768, WukvT, KVLORA, T, ATT_FP8 ? 1024 : 2048, G, bx, REPF(2)); pg8::EpiKV E{Kn, Vv, RS};
          pg8::gemm_phase<pg8::EpiKV, pg8::DenseSched, true>(ldsa, KVLORA, 768, KVLORA, S, E); }
        if (ATT_FP8) { pg8::DenseSched S; S.init(WukvT + (size_t)1024 * KVLORA, KVLORA, C3 + QLORA, 768, 1024, T, G, bx, REPF(2)); pg8::EpiVT E{(unsigned char*)Vv, RS};
          pg8::gemm_phase<pg8::EpiVT, pg8::DenseSched, true>(ldsa, KVLORA, KVLORA, 768, S, E); }
#endif
#ifndef NO_P2C
        {
            constexpr int LDT = 136;
            LAS bf16_t* Wl = (LAS bf16_t*)ldsa;
            LAS bf16_t* Vl = (LAS bf16_t*)(ldsa + 128 * LDT * 2);
            const int fr = lane & 15, fq = lane >> 4;
            const bool ws_once = (G & 7) == 0;
            for (int un0 = vcu; un0 < 1024 * REPF(13); un0 += G) { const int un = un0 & 1023;
                const int ch = un >> 3, hg = un & 7;
                if (!ws_once || un0 == vcu) for (int i = tid; i < 128 * 16; i += 512) { const int p = i >> 4, c8 = (i & 15) * 8; *(LAS u32x4*)(Wl + p * LDT + c8) = *(const u32x4*)(WsB + (size_t)hg * 16384 + p * 128 + c8); }
                { const int q = tid >> 2, d0 = (tid & 3) * 32; const bf16_t* vp = Vg + (size_t)(ch * 128 + q) * DM + hg * 128 + d0;
                  float v[32];
#pragma unroll
                  for (int j = 0; j < 4; ++j) { const u32x4 w = *(const u32x4*)(vp + j * 8); v[j * 8 + 0] = bf_lo(w.x); v[j * 8 + 1] = bf_hi(w.x); v[j * 8 + 2] = bf_lo(w.y); v[j * 8 + 3] = bf_hi(w.y); v[j * 8 + 4] = bf_lo(w.z); v[j * 8 + 5] = bf_hi(w.z); v[j * 8 + 6] = bf_lo(w.w); v[j * 8 + 7] = bf_hi(w.w); }
                  float s = 0.f;
#pragma unroll
                  for (int j = 0; j < 32; ++j) s += v[j];
                  s += __shfl_xor(s, 1); s += __shfl_xor(s, 2);
                  const float mu = s * (1.0f / 128.0f); float q2 = 0.f;
#pragma unroll
                  for (int j = 0; j < 32; ++j) { v[j] -= mu; q2 += v[j] * v[j]; }
                  q2 += __shfl_xor(q2, 1); q2 += __shfl_xor(q2, 2);
                  const float rstd = 1.0f / sqrtf(q2 * (1.0f / 128.0f) + LN_EPS);
#pragma unroll
                  for (int j = 0; j < 32; ++j) { const float o = v[j] * rstd * gmlp_ln_g[hg * 128 + d0 + j] + gmlp_ln_b[hg * 128 + d0 + j]; Vl[(d0 + j) * LDT + q] = (bf16_t)(cvt_pk_bf16(o, 0.f) & 0xffffu); }
                }
                __syncthreads();
                f32x4 acc[8];
#pragma unroll
                for (int n = 0; n < 8; ++n) acc[n] = (f32x4){0.f, 0.f, 0.f, 0.f};
#pragma unroll
                for (int ks = 0; ks < 4; ++ks) { const bf16x8 b = *(const LAS bf16x8*)(Wl + (16 * wave + fr) * LDT + 32 * ks + 8 * fq);
#pragma unroll
                    for (int n = 0; n < 8; ++n) { const bf16x8 a = *(const LAS bf16x8*)(Vl + (16 * n + fr) * LDT + 32 * ks + 8 * fq); acc[n] = __builtin_amdgcn_mfma_f32_16x16x32_bf16(a, b, acc[n], 0, 0, 0); } }
                { const int p = 16 * wave + fr; const float bsp = b_spatial[hg * 128 + p]; const unsigned ro = (unsigned)(ch * 128 + p) * DM + hg * 128 + 4 * fq;
                  u32x2 uv[8];
#pragma unroll
                  for (int n = 0; n < 8; ++n) uv[n] = *(const u32x2*)(U + ro + 16 * n);
#pragma unroll
                  for (int n = 0; n < 8; ++n) { u32x2 w; w.x = cvt_pk_bf16(bf_lo(uv[n].x) * (acc[n][0] + bsp), bf_hi(uv[n].x) * (acc[n][1] + bsp)); w.y = cvt_pk_bf16(bf_lo(uv[n].y) * (acc[n][2] + bsp), bf_hi(uv[n].y) * (acc[n][3] + bsp));
                      *(u32x2*)(Sg + ro + 16 * n) = w; } }
                __syncthreads();
            }
        }
#endif
        if (BOTH(2)) GRID_BAR();
    }

    if (IN(3)) {
#ifndef NO_P3A
        { pg8::DenseSched S; S.init(Sg, DM, WaT, DM, T, DM, G, bx, REPF(12)); pg8::EpiGate<false> E{YA, GA, nullptr, 1.0f};
          pg8::gemm_phase<pg8::EpiGate<false>, pg8::DenseSched, true>(ldsa, DM, DM, DM, S, E); }
#endif
#ifndef NO_P3B
        for (int i0 = 0; i0 * G + vcu < 512 * REPF(3); ++i0) { const int i = (G == 256) ? (i0 & 1) : i0; const int un = (i0 * G + vcu) & 511; int bh, qb;
            if (G == 256) { bh = i * 8 + (vcu >> 5); qb = vcu & 31; } else { bh = un >> 5; qb = un & 31; }
            const int b = bh >> 3, h = bh & 7;
            if (ATT_FP8 == 3) att::attn_unit_f8w((const unsigned char*)Qn, (const unsigned char*)Qr, (const unsigned char*)Kn, (const unsigned char*)KR, (const unsigned char*)Vv, Ob, (long)b * SEQ + qb * 256, (long)b * SEQ, h, SEQ, ldsa);
            else if (ATT_FP8) att::attn_unit_f8<1>((const unsigned char*)Qn, (const unsigned char*)Qr, (const unsigned char*)Kn, (const unsigned char*)KR, (const unsigned char*)Vv, Ob, (long)b * SEQ + qb * 256, (long)b * SEQ, h, SEQ, ldsa);
            else att::attn_unit<0>(Qn, Qr, Kn, KR, Vv, Ob, (long)b * SEQ + qb * 256, (long)b * SEQ, h, SEQ, ldsa); }
#ifdef ATTF_PROBE
        for (int i = 0; i * G + vcu < 512; ++i) { int bh, qb; const int un = i * G + vcu;
            if (G == 256) { bh = i * 8 + (vcu >> 5); qb = vcu & 31; } else { bh = un >> 5; qb = un & 31; }
            const int b = bh >> 3, h = bh & 7;
            att::attn_unit_f8<ATTF_PROBE>((const unsigned char*)Qn, (const unsigned char*)Qr, (const unsigned char*)Kn, (const unsigned char*)KR, (const unsigned char*)Vv, H1b, (long)b * SEQ + qb * 256, (long)b * SEQ, h, SEQ, ldsa); }
#endif
#ifdef ATT_PROBE
        for (int i = 0; i * G + vcu < 512; ++i) { int bh, qb; const int un = i * G + vcu;
            if (G == 256) { bh = i * 8 + (vcu >> 5); qb = vcu & 31; } else { bh = un >> 5; qb = un & 31; }
            const int b = bh >> 3, h = bh & 7;
            att::attn_unit<ATT_PROBE>(Qn, Qr, Kn, KR, Vv, H1b, (long)b * SEQ + qb * 256, (long)b * SEQ, h, SEQ, ldsa); }
#endif
#endif
        if (BOTH(3)) GRID_BAR();
    }

    if (IN(4)) {
        constexpr int KB = OB_FP8 ? DM / 2 : DM;
        pg8::DenseSched S; S.init(Ob, KB, WbT, KB, T, DM, G, bx, REPF(4)); pg8::EpiGate<true> E{Mb, GB, YA, OB_FP8 ? 1.0f / (W8MUL * O8MUL) : 1.0f};
        pg8::gemm_phase<pg8::EpiGate<true>, pg8::DenseSched, true, OB_FP8 != 0>(ldsa, KB, KB, KB, S, E);
        if (BOTH(4)) GRID_BAR();
    }

    if (IN(5)) {
        KARG(const float*, x, 0);
        pg8::DenseSched S; S.init(Mb, DM, WoT, DM, T, DM, G, bx, REPF(5)); pg8::EpiPre E{PRE, x};
        pg8::gemm_phase<pg8::EpiPre, pg8::DenseSched, true>(ldsa, DM, DM, DM, S, E);
        if (BOTH(5)) GRID_BAR();
    }

    if (IN(6)) {
        KARG(const float*, ln1_g, 15); KARG(const float*, ln1_b, 16); KARG(const float*, router_bias, 18);
        const int half = lane >> 5, l31 = lane & 31, fr = lane & 15, fq = lane >> 4;
        constexpr int LST = 260;
        float rb[4];
#pragma unroll
        for (int j = 0; j < 4; ++j) rb[j] = router_bias[lane + 64 * j];
        for (int grp = vcu; grp < T / 64; grp += G) {
            const int t0 = grp * 64;
#pragma unroll 2
            for (int i = 0; i < 8; ++i) { const int r = 8 * wave + i, m = t0 + r;
                f32x4* xr = (f32x4*)(PRE + (size_t)m * DM) + lane; f32x4 v[4]; float s = 0.f;
#pragma unroll
                for (int j = 0; j < 4; ++j) { v[j] = xr[64 * j]; s += (v[j].x + v[j].y) + (v[j].z + v[j].w); }
                const float mean = wave_sum(s) * (1.f / DM); float s2 = 0.f;
#pragma unroll
                for (int j = 0; j < 4; ++j) { v[j] = v[j] - mean; s2 += (v[j].x * v[j].x + v[j].y * v[j].y) + (v[j].z * v[j].z + v[j].w * v[j].w); }
                const float rstd = 1.f / sqrtf(wave_sum(s2) * (1.f / DM) + LN_EPS);
                u32x2* o8 = (u32x2*)(H1b + (size_t)m * DM) + lane;
#pragma unroll
                for (int j = 0; j < 4; ++j) { const f32x4 g = *((const f32x4*)ln1_g + lane + 64 * j), bb = *((const f32x4*)ln1_b + lane + 64 * j); const f32x4 o = v[j] * rstd * g + bb;
                    u32x2 w; w.x = cvt_pk_bf16(o.x, o.y); w.y = cvt_pk_bf16(o.z, o.w); ((u32x2*)(Mb + (size_t)m * DM))[lane + 64 * j] = w;
                    if (MOE_FP8) { int a = __builtin_amdgcn_cvt_pk_fp8_f32(o.x, o.y, 0, false); a = __builtin_amdgcn_cvt_pk_fp8_f32(o.z, o.w, a, true); ((unsigned*)((unsigned char*)H1b + (size_t)m * DM))[lane + 64 * j] = (unsigned)a; } else o8[64 * j] = w;
                    const int chunk = (lane + 64 * j) >> 1; *(LAS u32x2*)(ldsa + r * 2048 + ((chunk ^ (r & 7)) << 4) + (lane & 1) * 8) = w; }
            }
            __syncthreads();
            f32x4 acc[2][4];
#pragma unroll
            for (int eb = 0; eb < 2; ++eb)
#pragma unroll
                for (int tb = 0; tb < 4; ++tb) acc[eb][tb] = (f32x4){0.f, 0.f, 0.f, 0.f};
            const bf16_t* wr0 = WrT + (size_t)(32 * wave + fr) * DM + 8 * fq;
#pragma unroll 4
            for (int ks = 0; ks < 32; ++ks) {
                bf16x8 a[2], b[4];
#pragma unroll
                for (int eb = 0; eb < 2; ++eb) a[eb] = *(const bf16x8*)(wr0 + (size_t)eb * 16 * DM + 32 * ks);
#pragma unroll
                for (int tb = 0; tb < 4; ++tb) { const int r = 16 * tb + fr; b[tb] = *(const LAS bf16x8*)(ldsa + r * 2048 + (((4 * ks + fq) ^ (r & 7)) << 4)); }
#pragma unroll
                for (int eb = 0; eb < 2; ++eb)
#pragma unroll
                    for (int tb = 0; tb < 4; ++tb) acc[eb][tb] = __builtin_amdgcn_mfma_f32_16x16x32_bf16(a[eb], b[tb], acc[eb][tb], 0, 0, 0);
            }
            __syncthreads();
            LAS float* L = (LAS float*)ldsa;
#pragma unroll
            for (int eb = 0; eb < 2; ++eb)
#pragma unroll
                for (int tb = 0; tb < 4; ++tb) *(LAS f32x4*)(L + (16 * tb + fr) * LST + 32 * wave + 16 * eb + 4 * fq) = acc[eb][tb];
            __syncthreads();
            { const int ts = lane >> 3, g = lane & 7, tl = 8 * wave + ts, t = t0 + tl;
              LAS float* Lrow = L + tl * LST + 32 * g; float b[32];
#pragma unroll
              for (int q = 0; q < 8; ++q) { const f32x4 lg = *(LAS f32x4*)(Lrow + 4 * q); const f32x4 bi = *(const f32x4*)(router_bias + 32 * g + 4 * q); f32x4 s;
#pragma unroll
                  for (int c = 0; c < 4; ++c) { s[c] = 1.0f / (1.0f + expf(-lg[c])); b[4 * q + c] = s[c] + bi[c]; }
                  *(LAS f32x4*)(Lrow + 4 * q) = s; }
              float m1 = -INFINITY, m2 = -INFINITY;
#pragma unroll
              for (int i = 0; i < 32; ++i) { const float x = b[i]; const bool gt = x > m1; m2 = gt ? m1 : fmaxf(m2, x); m1 = gt ? x : m1; }
              const float gsum = m1 + m2; int rank = 0;
#pragma unroll
              for (int k = 0; k < 8; ++k) { const float o = __shfl(gsum, (lane & ~7) + k); rank += (o > gsum || (o == gsum && k < g)) ? 1 : 0; }
              const bool sel = rank < 4;
              float lv[8]; int li[8];
#pragma unroll
              for (int p = 0; p < 8; ++p) { float bv = -INFINITY; int bi = 0;
#pragma unroll
                  for (int i = 0; i < 32; ++i) if (b[i] > bv) { bv = b[i]; bi = i; }
                  lv[p] = sel ? bv : -INFINITY; li[p] = 32 * g + bi;
#pragma unroll
                  for (int i = 0; i < 32; ++i) b[i] = (i == bi) ? -INFINITY : b[i]; }
              int mye = 0;
#pragma unroll
              for (int k = 0; k < TOPK; ++k) { float v = lv[0]; int e = li[0];
#pragma unroll
                  for (int off = 1; off < 8; off <<= 1) { const float ov = __shfl_xor(v, off); const int oe = __shfl_xor(e, off); if (ov > v || (ov == v && oe < e)) { v = ov; e = oe; } }
                  if (g == k) mye = e;
                  if (li[0] == e) {
#pragma unroll
                      for (int p = 0; p < 7; ++p) { lv[p] = lv[p + 1]; li[p] = li[p + 1]; }
                      lv[7] = -INFINITY; } }
              const float s = L[tl * LST + mye]; float ssum = s;
#pragma unroll
              for (int off = 1; off < 8; off <<= 1) ssum += __shfl_xor(ssum, off);
              const int pair = t * TOPK + g; const float gwv = s / ssum * 2.5f; TOPW[pair] = gwv; const int slot = atomicAdd(&CNT[mye * CNT_STRIDE], 1); LIST[(size_t)mye * T + slot] = pair; LOG[(size_t)mye * T + slot] = gwv;
            }
            __syncthreads();
        }
        if (BOTH(6)) GRID_BAR();
    }

    if (IN(9) || IN(10)) {
        LAS int* cntL = (LAS int*)(ldsa + TAB_OFF); LAS int* tbase = cntL + 256; LAS int* tile2e = tbase + 260;
        if (tid < 256) cntL[tid] = __hip_atomic_load(&CNT[tid * CNT_STRIDE], RLX_AGENT);
        __syncthreads();
        if (tid == 0) { int s = 0; for (int e = 0; e < NE; ++e) { tbase[e] = s; s += (cntL[e] + 255) >> 8; } tbase[NE] = s; }
        __syncthreads();
        if (tid < 256) { const int t0 = tbase[tid], t1 = tbase[tid + 1]; for (int q = t0; q < t1; ++q) tile2e[q] = tid; }
        __syncthreads();
        const int ntm = tbase[NE];
        if (IN(9)) {
            constexpr int KE = MOE_FP8 ? DM / 2 : DM;
            pg8::MoeSched<true> S; S.A = (const char*)H1b; S.Bt = (const char*)WguT; S.atile = (size_t)256 * KE * 2; S.bexp = (size_t)512 * KE * 2; S.btile = (size_t)256 * KE * 2; S.npn = 2; S.ntm = ntm; S.nwg = (ntm + 64) * 2; S.G = G; S.c = bx; S.rep = REPF(9);
            S.tile2e = tile2e; S.tbase = tbase; S.cntL = cntL; S.list = LIST;
            pg8::EpiGU E{ACT};
            pg8::gemm_phase<pg8::EpiGU, pg8::MoeSched<true>, true, MOE_FP8 != 0>(ldsa, KE, KE, KE, S, E);
            if (BOTH(9)) GRID_BAR();
        }
        if (IN(10)) {
            constexpr int KD = MOE_FP8 ? DE / 2 : DE;
            pg8::MoeSched<false> S; S.A = (const char*)ACT; S.Bt = (const char*)WdT; S.atile = (size_t)256 * KD * 2; S.bexp = (size_t)DM * KD * 2; S.btile = (size_t)256 * KD * 2; S.npn = 4; S.ntm = ntm; S.nwg = (ntm + 64) * 4; S.G = G; S.c = bx; S.rep = REPF(10);
            S.tile2e = tile2e; S.tbase = tbase; S.cntL = cntL; S.list = LIST;
            pg8::EpiDown E{(unsigned char*)YP, (unsigned char*)YS, LIST, LOG, ntm};
            pg8::gemm_phase<pg8::EpiDown, pg8::MoeSched<false>, true, MOE_FP8 != 0>(ldsa, KD, KD, KD, S, E);
            if (BOTH(10)) GRID_BAR();
        }
    }

    if (IN(11)) REPS(11) {
        KARG(const float*, ln2_g, 25); KARG(const float*, ln2_b, 26); KARG(float*, out, 27);
        const unsigned char* YP8 = (const unsigned char*)YP; const unsigned char* YS8 = (const unsigned char*)YS;
        for (int m = gw; m < T; m += NGW) {
            const u32x4* xr = (const u32x4*)(Mb + (size_t)m * DM) + 2 * lane; f32x4 v[4];
            u32x4 yw[TOPK + 1];
#pragma unroll
            for (int k = 0; k < TOPK + 1; ++k) yw[k] = *(const u32x4*)((k < TOPK ? YP8 + (size_t)(m * TOPK + k) * DM : YS8 + (size_t)m * DM) + 16 * lane);
#pragma unroll
            for (int j = 0; j < 2; ++j) { const u32x4 w = xr[j]; v[2 * j] = (f32x4){bf_lo(w.x), bf_hi(w.x), bf_lo(w.y), bf_hi(w.y)} * DN_ALPHA; v[2 * j + 1] = (f32x4){bf_lo(w.z), bf_hi(w.z), bf_lo(w.w), bf_hi(w.w)} * DN_ALPHA; }
#pragma unroll
            for (int k = 0; k < TOPK + 1; ++k) {
#pragma unroll
                for (int j = 0; j < 4; ++j) { const int w = (int)yw[k][j]; const auto lo = __builtin_amdgcn_cvt_pk_f32_fp8(w, false), hh = __builtin_amdgcn_cvt_pk_f32_fp8(w, true);
                    v[j].x += lo[0] * (1.0f / Y8MUL); v[j].y += lo[1] * (1.0f / Y8MUL); v[j].z += hh[0] * (1.0f / Y8MUL); v[j].w += hh[1] * (1.0f / Y8MUL); } }
            float s = 0.f;
#pragma unroll
            for (int j = 0; j < 4; ++j) s += (v[j].x + v[j].y) + (v[j].z + v[j].w);
            const float mean = wave_sum(s) * (1.f / DM); float s2 = 0.f;
#pragma unroll
            for (int j = 0; j < 4; ++j) { v[j] = v[j] - mean; s2 += (v[j].x * v[j].x + v[j].y * v[j].y) + (v[j].z * v[j].z + v[j].w * v[j].w); }
            const float rstd = 1.f / sqrtf(wave_sum(s2) * (1.f / DM) + LN_EPS);
            f32x4* orow = (f32x4*)(out + (size_t)m * DM) + 4 * lane;
#pragma unroll
            for (int j = 0; j < 4; ++j) { const f32x4 g = *((const f32x4*)ln2_g + 4 * lane + j), bb = *((const f32x4*)ln2_b + 4 * lane + j); orow[j] = v[j] * rstd * g + bb; }
        }
    }
#undef IN
#undef BOTH
#undef GRID_BAR
}

#undef WinT
#undef WaT
#undef WbT
#undef WoT
#undef WuqT
#undef WukvT
#undef WrT
#undef WsB
#undef COS
#undef SIN
#undef RS
#undef TOPW
#undef LIST
#undef WguT
#undef WdT
#undef PRE
#undef H1b
#undef LOG
#undef YA
#undef Ob
#undef Mb
#undef ACT
#undef Xb
#undef U
#undef Vg
#undef GA
#undef GB
#undef C3
#undef KR
#undef Qn
#undef Qr
#undef Kn
#undef Vv
#undef Sg
#undef YP
#undef YS
#undef CNT
#undef CNT
extern "C" void kernel_launch(void* const* d_in, const int* in_sizes, int n_in, void* d_out, int out_size, void* d_ws, size_t ws_size, hipStream_t stream) {
    static int grid = 0;
    if (grid == 0) {
        if (n_in != 27 || in_sizes[0] != T * DM || out_size != T * DM || ws_size < WS_END) { fprintf(stderr, "kernel_launch: unexpected shapes: n_in %d in0 %d out %d ws %zu (need %zu)\n", n_in, n_in > 0 ? in_sizes[0] : -1, out_size, ws_size, (size_t)WS_END); grid = -1; return; }
        int dev = 0, cus = 0, per_cu = 0;
        if (hipGetDevice(&dev) != hipSuccess || hipDeviceGetAttribute(&cus, hipDeviceAttributeMultiprocessorCount, dev) != hipSuccess) { grid = -1; return; }
        if (hipFuncSetAttribute((const void*)mega_fwd, hipFuncAttributeMaxDynamicSharedMemorySize, LDS_BYTES) != hipSuccess) { fprintf(stderr, "kernel_launch: hipFuncSetAttribute failed\n"); grid = -1; return; }
        if (hipOccupancyMaxActiveBlocksPerMultiprocessor(&per_cu, (const void*)mega_fwd, NWAVES * 64, LDS_BYTES) != hipSuccess || per_cu < 1) { fprintf(stderr, "kernel_launch: occupancy query says %d blocks per CU\n", per_cu); grid = -1; return; }
        (void)hipGetLastError();
        grid = cus;
    }
    if (grid < 0) return;
    if (hipMemsetAsync((char*)d_ws + WS_CTL, 0, CTL_ZERO_BYTES, stream) != hipSuccess) return;
    Args a{};
    for (int i = 0; i < 27; ++i) a.in[i] = d_in[i];
    a.out = (float*)d_out; a.ws = (unsigned char*)d_ws;
    for (int li = 0; li < N_LAUNCHES; ++li) {
        if (N_LAUNCHES == PER_PHASE) { a.ph_lo = li; a.ph_hi = li + 1; } else { a.ph_lo = 0; a.ph_hi = PER_PHASE; }
        a.li = li;
        hipLaunchKernelGGL(mega_fwd, dim3(grid), dim3(NWAVES * 64), LDS_BYTES, stream, a);
        const hipError_t le = hipPeekAtLastError();
        if (le != hipSuccess) { fprintf(stderr, "kernel_launch: launch %d failed: %s\n", li, hipGetErrorName(le)); break; }
    }
}
```
